# Optimizing an MI355X kernel written in HIP

```python
import jax, jax.numpy as jnp
from jax import lax
import numpy as np

D_MODEL = 1024
BATCH = 4
SEQ = 8192
DEPTH = 1

MEM_LEN = 256
MLA_HEADS = 8
MLA_NOPE_DIM = 64
MLA_ROPE_DIM = 32
MLA_V_DIM = 64
MLA_Q_LORA = 384
MLA_KV_LORA = 256
FOX_HEADS = 8
FOX_HEAD_DIM = 64
MEM_HEADS = 4
MEM_HEAD_DIM = 128
N_BRANCHES = 3
D_FF = 2816
BLOCK_Q = 128
ROPE_THETA = 10000.0
LN_EPS = 1e-5
RMS_EPS = 1e-6
DEEPNORM_ALPHA = (2.0 * DEPTH) ** 0.25
DEEPNORM_BETA = (8.0 * DEPTH) ** -0.25
MLA_W = MLA_HEADS * MLA_V_DIM
FOX_W = FOX_HEADS * FOX_HEAD_DIM
MEM_W = MEM_HEADS * MEM_HEAD_DIM
IN_COLS = MLA_Q_LORA + MLA_KV_LORA + MLA_ROPE_DIM + 3 * FOX_W + FOX_HEADS + MEM_W + N_BRANCHES * D_MODEL

kernel_name = "hybrid_mla_fox_memxattn_macaron_deepnorm"


def layer_norm(x, g, b):
    xf = x.astype(jnp.float32)
    mu = jnp.mean(xf, axis=-1, keepdims=True)
    var = jnp.mean(jnp.square(xf - mu), axis=-1, keepdims=True)
    y = (xf - mu) * lax.rsqrt(var + LN_EPS)
    return (y * g.astype(jnp.float32) + b.astype(jnp.float32)).astype(x.dtype)


def rms_norm(x, g):
    xf = x.astype(jnp.float32)
    y = xf * lax.rsqrt(jnp.mean(jnp.square(xf), axis=-1, keepdims=True) + RMS_EPS)
    return (y * g.astype(jnp.float32)).astype(x.dtype)


def apply_rope(x, positions):
    half = x.shape[-1] // 2
    inv_freq = ROPE_THETA ** (-jnp.arange(half, dtype=jnp.float32) / half)
    ang = positions.astype(jnp.float32)[..., None] * inv_freq
    cos = jnp.cos(ang)[:, :, None, :].astype(x.dtype)
    sin = jnp.sin(ang)[:, :, None, :].astype(x.dtype)
    x1, x2 = x[..., :half], x[..., half:]
    return jnp.concatenate([x1 * cos - x2 * sin, x2 * cos + x1 * sin], axis=-1)


def swiglu_ffn(x, w_in, w_down):
    a, b = jnp.split(x @ w_in, 2, axis=-1)
    return (jax.nn.silu(a) * b) @ w_down


def causal_block_attention(q, k, v, scale, fcum=None):
    b, h, s, dk = q.shape
    dv = v.shape[-1]
    nb = s // BLOCK_Q
    q_blocks = q.reshape(b, h, nb, BLOCK_Q, dk).transpose(2, 0, 1, 3, 4)
    key_pos = jnp.arange(s)
    xs = (jnp.arange(nb), q_blocks)
    if fcum is not None:
        xs = xs + (fcum.reshape(b, h, nb, BLOCK_Q).transpose(2, 0, 1, 3),)

    def attend_block(blk):
        i, q_i = blk[0], blk[1]
        logits = jnp.einsum('bhqd,bhkd->bhqk', q_i, k, preferred_element_type=jnp.float32) * scale
        if fcum is not None:
            logits = logits + (blk[2][..., :, None] - fcum[..., None, :])
        q_pos = i * BLOCK_Q + jnp.arange(BLOCK_Q)
        causal = key_pos[None, :] <= q_pos[:, None]
        logits = jnp.where(causal, logits, -jnp.inf)
        p = jax.nn.softmax(logits, axis=-1)
        return jnp.einsum('bhqk,bhkd->bhqd', p.astype(v.dtype), v)

    out = lax.map(attend_block, xs)
    return out.transpose(1, 2, 0, 3, 4).reshape(b, h, s, dv)


def hybrid_mixer(h, mem, positions, w_in, b_gate, mla_q_norm, mla_w_uq, mla_kv_norm, mla_w_ukv,
                 fox_b_f, mem_w_kv, w_br_mla, w_br_fox, w_br_mem, w_out):
    B, S, _ = h.shape
    sizes = (MLA_Q_LORA, MLA_KV_LORA, MLA_ROPE_DIM, FOX_W, FOX_W, FOX_W, FOX_HEADS, MEM_W)
    splits = np.cumsum(sizes).tolist()
    proj = h @ w_in
    c_q, c_kv, k_pe, fq, fk, fv, f_logit, mq, gates = jnp.split(proj, splits, axis=-1)

    q = (rms_norm(c_q, mla_q_norm) @ mla_w_uq).reshape(B, S, MLA_HEADS, MLA_NOPE_DIM + MLA_ROPE_DIM)
    q = jnp.concatenate([q[..., :MLA_NOPE_DIM], apply_rope(q[..., MLA_NOPE_DIM:], positions)], axis=-1)
    kv = (rms_norm(c_kv, mla_kv_norm) @ mla_w_ukv).reshape(B, S, MLA_HEADS, MLA_NOPE_DIM + MLA_V_DIM)
    k_nope, v_mla = kv[..., :MLA_NOPE_DIM], kv[..., MLA_NOPE_DIM:]
    k_rope = apply_rope(k_pe[:, :, None, :], positions)
    k = jnp.concatenate([k_nope, jnp.broadcast_to(k_rope, (B, S, MLA_HEADS, MLA_ROPE_DIM))], axis=-1)
    o_mla = causal_block_attention(q.transpose(0, 2, 1, 3), k.transpose(0, 2, 1, 3),
                                   v_mla.transpose(0, 2, 1, 3),
                                   (MLA_NOPE_DIM + MLA_ROPE_DIM) ** -0.5)
    o_mla = o_mla.transpose(0, 2, 1, 3).reshape(B, S, MLA_W)

    log_f = jax.nn.log_sigmoid((f_logit + fox_b_f).astype(jnp.float32))
    fcum = jnp.cumsum(log_f, axis=1).transpose(0, 2, 1)
    to_heads = lambda t: t.reshape(B, S, FOX_HEADS, FOX_HEAD_DIM).transpose(0, 2, 1, 3)
    o_fox = causal_block_attention(to_heads(fq), to_heads(fk), to_heads(fv),
                                   FOX_HEAD_DIM ** -0.5, fcum)
    o_fox = o_fox.transpose(0, 2, 1, 3).reshape(B, S, FOX_W)

    mk, mv = jnp.split(mem @ mem_w_kv, 2, axis=-1)
    mk = mk.reshape(B, MEM_LEN, MEM_HEADS, MEM_HEAD_DIM)
    mv = mv.reshape(B, MEM_LEN, MEM_HEADS, MEM_HEAD_DIM)
    mqh = mq.reshape(B, S, MEM_HEADS, MEM_HEAD_DIM)
    m_logits = jnp.einsum('bshd,bmhd->bhsm', mqh, mk, preferred_element_type=jnp.float32) * MEM_HEAD_DIM ** -0.5
    m_p = jax.nn.softmax(m_logits, axis=-1).astype(mv.dtype)
    o_mem = jnp.einsum('bhsm,bmhd->bshd', m_p, mv).reshape(B, S, MEM_W)

    g = jax.nn.sigmoid(gates + b_gate).reshape(B, S, N_BRANCHES, D_MODEL)
    merged = (g[:, :, 0] * (o_mla @ w_br_mla)
              + g[:, :, 1] * (o_fox @ w_br_fox)
              + g[:, :, 2] * (o_mem @ w_br_mem))
    return merged @ w_out


def setup_inputs(seed: int = 0) -> dict:
    key = jax.random.key(seed)
    ks = jax.random.split(key, 32)
    L = DEPTH

    def nrm(k, shape, scale):
        return jax.random.normal(k, shape, jnp.float32) * scale

    x = nrm(ks[0], (BATCH, SEQ, D_MODEL), 1.0)
    mem = nrm(ks[1], (BATCH, MEM_LEN, D_MODEL), 1.0)
    start = jax.random.randint(ks[2], (BATCH, 1), 0, 1024, dtype=jnp.int32)
    positions = (start + jnp.arange(SEQ, dtype=jnp.int32)[None, :]).astype(jnp.int32)
    return {
        "x": x,
        "mem": mem,
        "positions": positions,
        "ln1_g": 1.0 + nrm(ks[3], (L, D_MODEL), 0.02),
        "ln1_b": nrm(ks[4], (L, D_MODEL), 0.02),
        "ffn1_w_in": nrm(ks[5], (L, D_MODEL, 2 * D_FF), D_MODEL ** -0.5),
        "ffn1_w_down": nrm(ks[6], (L, D_FF, D_MODEL), D_FF ** -0.5 * DEEPNORM_BETA),
        "w_in": nrm(ks[7], (L, D_MODEL, IN_COLS), D_MODEL ** -0.5),
        "b_gate": nrm(ks[8], (L, N_BRANCHES * D_MODEL), 0.01),
        "mla_q_norm": 1.0 + nrm(ks[9], (L, MLA_Q_LORA), 0.02),
        "mla_w_uq": nrm(ks[10], (L, MLA_Q_LORA, MLA_HEADS * (MLA_NOPE_DIM + MLA_ROPE_DIM)), MLA_Q_LORA ** -0.5),
        "mla_kv_norm": 1.0 + nrm(ks[11], (L, MLA_KV_LORA), 0.02),
        "mla_w_ukv": nrm(ks[12], (L, MLA_KV_LORA, MLA_HEADS * (MLA_NOPE_DIM + MLA_V_DIM)), MLA_KV_LORA ** -0.5),
        "fox_b_f": 2.0 + nrm(ks[13], (L, FOX_HEADS), 0.5),
        "mem_w_kv": nrm(ks[14], (L, D_MODEL, 2 * MEM_W), D_MODEL ** -0.5),
        "w_br_mla": nrm(ks[15], (L, MLA_W, D_MODEL), MLA_W ** -0.5),
        "w_br_fox": nrm(ks[16], (L, FOX_W, D_MODEL), FOX_W ** -0.5),
        "w_br_mem": nrm(ks[17], (L, MEM_W, D_MODEL), MEM_W ** -0.5),
        "w_out": nrm(ks[18], (L, D_MODEL, D_MODEL), D_MODEL ** -0.5 * DEEPNORM_BETA),
        "ln2_g": 1.0 + nrm(ks[19], (L, D_MODEL), 0.02),
        "ln2_b": nrm(ks[20], (L, D_MODEL), 0.02),
        "ffn2_w_in": nrm(ks[21], (L, D_MODEL, 2 * D_FF), D_MODEL ** -0.5),
        "ffn2_w_down": nrm(ks[22], (L, D_FF, D_MODEL), D_FF ** -0.5 * DEEPNORM_BETA),
        "ln3_g": 1.0 + nrm(ks[23], (L, D_MODEL), 0.02),
        "ln3_b": nrm(ks[24], (L, D_MODEL), 0.02),
    }


def reference(x, mem, positions, ln1_g, ln1_b, ffn1_w_in, ffn1_w_down, w_in, b_gate,
              mla_q_norm, mla_w_uq, mla_kv_norm, mla_w_ukv, fox_b_f, mem_w_kv,
              w_br_mla, w_br_fox, w_br_mem, w_out, ln2_g, ln2_b,
              ffn2_w_in, ffn2_w_down, ln3_g, ln3_b):
    for l in range(DEPTH):
        x = layer_norm(DEEPNORM_ALPHA * x + 0.5 * swiglu_ffn(x, ffn1_w_in[l], ffn1_w_down[l]),
                       ln1_g[l], ln1_b[l])
        mix = hybrid_mixer(x, mem, positions, w_in[l], b_gate[l], mla_q_norm[l], mla_w_uq[l],
                           mla_kv_norm[l], mla_w_ukv[l], fox_b_f[l], mem_w_kv[l],
                           w_br_mla[l], w_br_fox[l], w_br_mem[l], w_out[l])
        x = layer_norm(DEEPNORM_ALPHA * x + mix, ln2_g[l], ln2_b[l])
        x = layer_norm(DEEPNORM_ALPHA * x + 0.5 * swiglu_ffn(x, ffn2_w_in[l], ffn2_w_down[l]),
                       ln3_g[l], ln3_b[l])
    return x
```

```cpp
#include <hip/hip_runtime.h>
#include <hip/hip_cooperative_groups.h>
#include <cstdio>
#include <cstdint>
#include <cmath>
namespace cg = cooperative_groups;
namespace pg8 {
#define PG8_LAS __attribute__((address_space(3)))
typedef unsigned short bf16_t;
typedef short bf16x8 __attribute__((ext_vector_type(8)));
typedef float f32x4 __attribute__((ext_vector_type(4)));
typedef unsigned u32x4 __attribute__((ext_vector_type(4)));
constexpr int BM = 256, BK = 64, HALF = 128, HTB = HALF * BK * 2  , STAGE_BYTES = 8 * HTB, NXCD = 8, WGM = 8;

__host__ __device__ __forceinline__ int lds_byte(int r, int c) { const int st = (r >> 4) * 2 + (c >> 5), rr = r & 15, cc = c & 31, ob = rr * 64 + cc * 2; return st * 1024 + (ob ^ (((ob >> 9) & 1) << 5)); }
__host__ __device__ __forceinline__ void stage_rc(int b, int& R, int& C) { const int st = b / 1024, sb = b % 1024, swz = sb ^ (((sb >> 9) & 1) << 5); R = (st >> 1) * 16 + swz / 64; C = (st & 1) * 32 + (swz % 64) / 2; }
__host__ __device__ __forceinline__ int perm32(int rho) { const int n = rho >> 4, i = rho & 15; return 8 * (i >> 2) + 4 * n + (i & 3); }

struct Unit { int pm, pn, am, bn, seg; };
struct Gemm { const bf16_t* A; const bf16_t* Bt; int M, N, K; };

struct StaticOrder {
    int nM, nN, nwg, G, c;
    __host__ __device__ void init(int M, int N, int G_, int c_) { nM = M / BM; nN = N / BM; nwg = nM * nN; G = G_; c = c_; }
    __host__ __device__ bool next(int i, Unit& u) const {
        const long L = (long)i * G + c; if (L >= nwg) return false;
        int wgid = (int)L; { const int q = nwg / NXCD, r = nwg % NXCD, xcd = wgid % NXCD, off = wgid / NXCD; wgid = (xcd < r ? xcd * (q + 1) : r * (q + 1) + (xcd - r) * q) + off; }
        const int nig = WGM * nN, gid = wgid / nig, fm = gid * WGM, gsz = (nM - fm) < WGM ? (nM - fm) : WGM;
        u.pm = fm + ((wgid % nig) % gsz); u.pn = (wgid % nig) / gsz; u.am = u.pm; u.bn = u.pn; u.seg = 0; return true;
    }
};

__device__ __forceinline__ unsigned cvt_pk_bf16(float lo, float hi) { unsigned r; asm volatile("v_cvt_pk_bf16_f32 %0, %1, %2" : "=v"(r) : "v"(lo), "v"(hi)); return r; }
typedef float f32x2 __attribute__((ext_vector_type(2)));
template <class Epi, class Sched, bool ALIGN_EPI = false, bool SP2 = true>
__device__ __forceinline__ void gemm_phase(PG8_LAS unsigned char* lds, const Gemm g, const Sched& S, const Epi& E) {
    int tid_ = threadIdx.x; asm volatile("" : "+v"(tid_));
    const int tid = tid_, wid = __builtin_amdgcn_readfirstlane(tid >> 6), lane = tid & 63, wr = wid >> 2, wc = wid & 3, fr = lane & 15, fq = lane >> 4;
    const int K = g.K, nt = K / BK;
    unsigned voffA[2], voffB[2];
#pragma unroll
    for (int i = 0; i < 2; ++i) { int R, C; stage_rc(tid * 16 + i * 8192, R, C); const int Rb = Epi::PERM ? ((R & ~31) + perm32(R & 31)) : R;
        voffA[i] = (unsigned)(R * K + C) * 2u; voffB[i] = (unsigned)(Rb * K + C) * 2u; }
    const size_t kstep = (size_t)(BK * 2);
    const size_t hstep = (size_t)HALF * K * 2;
    const size_t tstep = 2 * hstep;
    const unsigned ldsw = (unsigned)wid * 1024u;
    const int aoff = lds_byte(wr * 64 + fr, fq * 8), boff = lds_byte(wc * 32 + fr, fq * 8);
#define PG8_SA(b, h) (((b) * 2 + (h)) * HTB)
#define PG8_SB(b, h) ((4 + (b) * 2 + (h)) * HTB)
#define PG8_STAGE(bufoff, gbase, voff) do { _Pragma("unroll") for (int _i = 0; _i < 2; ++_i) \
        __builtin_amdgcn_global_load_lds((const unsigned*)((const char*)(gbase) + (voff)[_i]), (PG8_LAS unsigned*)(lds + (bufoff) + ldsw + _i * 8192), 16, 0, 0); } while (0)
#define PG8_LDA(dst, b, h) do { _Pragma("unroll") for (int m = 0; m < 4; ++m) _Pragma("unroll") for (int k = 0; k < 2; ++k) dst[m][k] = *(const PG8_LAS bf16x8*)(lds + PG8_SA(b, h) + aoff + m * 2048 + k * 1024); } while (0)
#define PG8_LDB(dst, b, h) do { _Pragma("unroll") for (int n = 0; n < 2; ++n) _Pragma("unroll") for (int k = 0; k < 2; ++k) dst[n][k] = *(const PG8_LAS bf16x8*)(lds + PG8_SB(b, h) + boff + n * 2048 + k * 1024); } while (0)
#define PG8_MMA(ai, bj, At, Bt) do { __builtin_amdgcn_s_setprio(1); _Pragma("unroll") for (int m = 0; m < 4; ++m) _Pragma("unroll") for (int n = 0; n < 2; ++n) _Pragma("unroll") for (int k = 0; k < 2; ++k) \
        acc[ai][bj][m][n] = __builtin_amdgcn_mfma_f32_16x16x32_bf16(Bt[n][k], At[m][k], acc[ai][bj][m][n], 0, 0, 0); __builtin_amdgcn_s_setprio(0); } while (0)
#define PG8_WAIT_V(n) asm volatile("s_waitcnt vmcnt(" #n ")" ::: "memory")
#define PG8_WAIT_L(n) asm volatile("s_waitcnt lgkmcnt(" #n ")" ::: "memory")
#define PG8_BAR __builtin_amdgcn_s_barrier()
#define PG8_SCHED __builtin_amdgcn_sched_barrier(0)
    Unit cur, nxt; int ui = 0;
    if (!S.next(0, cur)) return;
    f32x4 acc[2][2][4][2];
#pragma unroll
    for (int a = 0; a < 2; ++a)
#pragma unroll
        for (int b = 0; b < 2; ++b)
#pragma unroll
            for (int m = 0; m < 4; ++m)
#pragma unroll
                for (int n = 0; n < 2; ++n) acc[a][b][m][n] = (f32x4){0.f, 0.f, 0.f, 0.f};
    bf16x8 At[4][2], B0[2][2], B1[2][2];
    const char* cA = (const char*)g.A + (size_t)cur.am * tstep; const char* cB = (const char*)g.Bt + (size_t)cur.bn * tstep;
    if constexpr (SP2) {
        PG8_STAGE(PG8_SB(0, 0), cB, voffB); PG8_STAGE(PG8_SB(0, 1), cB + hstep, voffB); PG8_STAGE(PG8_SA(0, 0), cA, voffA); PG8_STAGE(PG8_SA(0, 1), cA + hstep, voffA);
        if (wr == 1) PG8_BAR;
        PG8_WAIT_V(2); PG8_BAR;
        PG8_STAGE(PG8_SB(1, 0), cB + kstep, voffB); PG8_STAGE(PG8_SA(1, 0), cA + kstep, voffA); PG8_STAGE(PG8_SB(1, 1), cB + hstep + kstep, voffB);
        PG8_WAIT_V(6); PG8_BAR;
    } else {
        PG8_STAGE(PG8_SB(0, 0), cB, voffB); PG8_STAGE(PG8_SA(0, 0), cA, voffA); PG8_STAGE(PG8_SB(0, 1), cB + hstep, voffB); PG8_STAGE(PG8_SA(0, 1), cA + hstep, voffA);
        if (wr == 1) PG8_BAR;
        PG8_WAIT_V(4); PG8_BAR;
        PG8_STAGE(PG8_SB(1, 0), cB + kstep, voffB); PG8_STAGE(PG8_SA(1, 0), cA + kstep, voffA); PG8_STAGE(PG8_SB(1, 1), cB + hstep + kstep, voffB);
        PG8_WAIT_V(6); PG8_BAR;
    }
    for (;;) {
        const bool has_next = S.next(ui + 1, nxt);
        const char* nA = has_next ? (const char*)g.A + (size_t)nxt.am * tstep : cA; const char* nB = has_next ? (const char*)g.Bt + (size_t)nxt.bn * tstep : cB;
#pragma nounroll
        for (int t = 0; t < nt; t += 2) {
            const bool last = (t == nt - 2);
            const char* a1 = cA + (size_t)(t + 1) * kstep;
            const char* a2 = last ? nA : cA + (size_t)(t + 2) * kstep; const char* b2 = last ? nB : cB + (size_t)(t + 2) * kstep;
            const char* a3 = a2 + kstep; const char* b3 = b2 + kstep;
            if constexpr (SP2) {
            PG8_LDB(B0, 0, 0); PG8_LDB(B1, 0, 1); PG8_SCHED; PG8_LDA(At, 0, 0); PG8_STAGE(PG8_SA(1, 1), a1 + hstep, voffA);
            PG8_WAIT_V(8); PG8_WAIT_L(0); PG8_BAR; PG8_MMA(0, 0, At, B0); PG8_MMA(0, 1, At, B1); PG8_BAR; PG8_SCHED;
            PG8_LDA(At, 0, 1); PG8_STAGE(PG8_SB(0, 0), b2, voffB); PG8_STAGE(PG8_SB(0, 1), b2 + hstep, voffB); PG8_STAGE(PG8_SA(0, 0), a2, voffA);
            PG8_WAIT_V(8); PG8_WAIT_L(0); PG8_BAR; PG8_MMA(1, 0, At, B0); PG8_MMA(1, 1, At, B1); PG8_BAR; PG8_SCHED;
            PG8_LDB(B0, 1, 0); PG8_LDB(B1, 1, 1); PG8_SCHED; PG8_LDA(At, 1, 0); PG8_STAGE(PG8_SA(0, 1), a2 + hstep, voffA);
            PG8_WAIT_V(8); PG8_WAIT_L(0); PG8_BAR; PG8_MMA(0, 0, At, B0); PG8_MMA(0, 1, At, B1); PG8_BAR; PG8_SCHED;
            PG8_LDA(At, 1, 1); PG8_STAGE(PG8_SB(1, 0), b3, voffB); PG8_STAGE(PG8_SB(1, 1), b3 + hstep, voffB); PG8_STAGE(PG8_SA(1, 0), a3, voffA);
            PG8_WAIT_V(8); PG8_WAIT_L(0); PG8_BAR; PG8_MMA(1, 0, At, B0); PG8_MMA(1, 1, At, B1); PG8_BAR; PG8_SCHED;
            } else {
            PG8_LDB(B0, 0, 0); PG8_SCHED; PG8_LDA(At, 0, 0); PG8_STAGE(PG8_SA(1, 1), a1 + hstep, voffA);
            PG8_WAIT_L(8); PG8_BAR; PG8_WAIT_L(0); PG8_MMA(0, 0, At, B0); PG8_BAR; PG8_SCHED;
            PG8_LDB(B1, 0, 1); PG8_STAGE(PG8_SB(0, 0), b2, voffB);
            PG8_BAR; PG8_WAIT_L(0); PG8_MMA(0, 1, At, B1); PG8_BAR;
            PG8_LDA(At, 0, 1); PG8_STAGE(PG8_SA(0, 0), a2, voffA);
            PG8_BAR; PG8_WAIT_L(0); PG8_MMA(1, 0, At, B0); PG8_BAR; PG8_SCHED;
            PG8_STAGE(PG8_SB(0, 1), b2 + hstep, voffB);
            PG8_WAIT_V(6); PG8_BAR; PG8_MMA(1, 1, At, B1); PG8_BAR;
            PG8_LDB(B0, 1, 0); PG8_SCHED; PG8_LDA(At, 1, 0); PG8_STAGE(PG8_SA(0, 1), a2 + hstep, voffA);
            PG8_WAIT_L(8); PG8_BAR; PG8_WAIT_L(0); PG8_MMA(0, 0, At, B0); PG8_BAR; PG8_SCHED;
            PG8_LDB(B1, 1, 1); PG8_STAGE(PG8_SB(1, 0), b3, voffB);
            PG8_BAR; PG8_WAIT_L(0); PG8_MMA(0, 1, At, B1); PG8_BAR;
            PG8_LDA(At, 1, 1); PG8_STAGE(PG8_SA(1, 0), a3, voffA);
            PG8_BAR; PG8_WAIT_L(0); PG8_MMA(1, 0, At, B0); PG8_BAR; PG8_SCHED;
            PG8_STAGE(PG8_SB(1, 1), b3 + hstep, voffB);
            PG8_WAIT_V(6); PG8_BAR; PG8_MMA(1, 1, At, B1); PG8_BAR;
            }
        }
        if constexpr (ALIGN_EPI) { if (wr == 0) PG8_BAR; }
        E(acc, cur, wr, wc, fr, fq);
        if (!has_next) break;
        if (!Epi::keep(cur)) {
#pragma unroll
        for (int a = 0; a < 2; ++a)
#pragma unroll
            for (int b = 0; b < 2; ++b)
#pragma unroll
                for (int m = 0; m < 4; ++m)
#pragma unroll
                    for (int n = 0; n < 2; ++n) acc[a][b][m][n] = (f32x4){0.f, 0.f, 0.f, 0.f};
        }
        cur = nxt; cA = nA; cB = nB; ++ui;
        if constexpr (ALIGN_EPI) { if (wr == 1) PG8_BAR; }
    }
    PG8_WAIT_V(0);
    if constexpr (!ALIGN_EPI) { if (wr == 0) PG8_BAR; }
    PG8_BAR;
#undef PG8_SA
#undef PG8_SB
#undef PG8_STAGE
#undef PG8_LDA
#undef PG8_LDB
#undef PG8_MMA
#undef PG8_WAIT_V
#undef PG8_WAIT_L
#undef PG8_BAR
#undef PG8_SCHED
}

struct SegOrder {
    StaticOrder b; int nseg, aM, bN;
    __device__ void init(int M, int N, int G_, int c_, int nseg_) { b.init(M, N, G_, c_); nseg = nseg_; aM = M / BM; bN = N / BM; }
    __device__ bool next(int i, Unit& u) const { if (!b.next(i / nseg, u)) return false; const int s = i % nseg; u.seg = s; u.am = u.pm + s * aM; u.bn = u.pn + s * bN; return true; }
};

constexpr float LOG2E = 1.4426950408889634f;
__device__ __forceinline__ float sigm(float x) { return __builtin_amdgcn_rcpf(1.f + __expf(-x)); }
__device__ __forceinline__ u32x4 pack8(const f32x4 v0, const f32x4 v1) { u32x4 w; w.x = cvt_pk_bf16(v0[0], v0[1]); w.y = cvt_pk_bf16(v0[2], v0[3]); w.z = cvt_pk_bf16(v1[0], v1[1]); w.w = cvt_pk_bf16(v1[2], v1[3]); return w; }
__device__ __forceinline__ void unpack8(const u32x4 w, f32x4& v0, f32x4& v1) {
    v0[0] = __uint_as_float(w.x << 16); v0[1] = __uint_as_float(w.x & 0xffff0000u); v0[2] = __uint_as_float(w.y << 16); v0[3] = __uint_as_float(w.y & 0xffff0000u);
    v1[0] = __uint_as_float(w.z << 16); v1[1] = __uint_as_float(w.z & 0xffff0000u); v1[2] = __uint_as_float(w.w << 16); v1[3] = __uint_as_float(w.w & 0xffff0000u); }

struct EpiPlain {
    static constexpr bool PERM = true; static __device__ __forceinline__ bool keep(const Unit&) { return false; }
    bf16_t* O; int ldc; float sc;
    __device__ __forceinline__ void operator()(f32x4 (&acc)[2][2][4][2], const Unit& u, int wr, int wc, int fr, int fq) const {
        const int row0 = u.pm * BM + wr * 64 + fr, col0 = u.pn * BM + wc * 32 + 8 * fq;
#pragma unroll
        for (int ai = 0; ai < 2; ++ai)
#pragma unroll
            for (int m = 0; m < 4; ++m) { bf16_t* rowp = O + (size_t)(row0 + ai * HALF + m * 16) * ldc + col0;
#pragma unroll
                for (int bj = 0; bj < 2; ++bj) *(u32x4*)(rowp + bj * HALF) = pack8(acc[ai][bj][m][0] * sc, acc[ai][bj][m][1] * sc); }
    }
};
struct EpiSwiglu {
    static constexpr bool PERM = true; static __device__ __forceinline__ bool keep(const Unit&) { return false; }
    bf16_t* H; int ldh;
    __device__ __forceinline__ void operator()(f32x4 (&acc)[2][2][4][2], const Unit& u, int wr, int wc, int fr, int fq) const {
        const int row0 = u.pm * BM + wr * 64 + fr, col0 = u.pn * HALF + wc * 32 + 8 * fq;
#pragma unroll
        for (int ai = 0; ai < 2; ++ai)
#pragma unroll
            for (int m = 0; m < 4; ++m) {
                f32x4 v0, v1;
#pragma unroll
                for (int i = 0; i < 4; ++i) { const float a0 = acc[ai][0][m][0][i], a1 = acc[ai][0][m][1][i];
                    v0[i] = a0 * sigm(a0) * acc[ai][1][m][0][i]; v1[i] = a1 * sigm(a1) * acc[ai][1][m][1][i]; }
                *(u32x4*)(H + (size_t)(row0 + ai * HALF + m * 16) * ldh + col0) = pack8(v0, v1); }
    }
};
struct EpiRes {
    static constexpr bool PERM = false; static __device__ __forceinline__ bool keep(const Unit&) { return false; }
    const float* res; float* out; float alpha, beta;
    __device__ __forceinline__ void operator()(f32x4 (&acc)[2][2][4][2], const Unit& u, int wr, int wc, int fr, int fq) const {
        const int row0 = u.pm * BM + wr * 64 + fr, col0 = u.pn * BM + wc * 32 + 4 * fq;
#pragma unroll
        for (int ai = 0; ai < 2; ++ai)
#pragma unroll
            for (int m = 0; m < 4; ++m) { const size_t off = (size_t)(row0 + ai * HALF + m * 16) * 1024 + col0;
#pragma unroll
                for (int bj = 0; bj < 2; ++bj)
#pragma unroll
                    for (int n = 0; n < 2; ++n) { const f32x4 r = *(const f32x4*)(res + off + bj * HALF + n * 16); *(f32x4*)(out + off + bj * HALF + n * 16) = r * alpha + acc[ai][bj][m][n] * beta; } }
    }
};
struct EpiProj {
    static constexpr bool PERM = true; static __device__ __forceinline__ bool keep(const Unit&) { return false; }
    bf16_t *G, *FQ, *FK, *FV, *MQ, *CQ, *CKV; float* SIDE; const float* bgate;
    __device__ __forceinline__ void operator()(f32x4 (&acc)[2][2][4][2], const Unit& u, int wr, int wc, int fr, int fq) const {
        const int row0 = u.pm * BM + wr * 64 + fr, pn = u.pn;
#pragma unroll
        for (int bj = 0; bj < 2; ++bj) {
            const int col = pn * BM + bj * HALF + wc * 32 + 8 * fq;
            bf16_t* base; int ld, dcol; float sc = 1.f; bool gate = false;
            if (pn < 12) { base = G; ld = 3072; dcol = col; gate = true; }
            else if (pn < 14) { const int c = col - 3072; base = FQ; ld = 768; dcol = (c >> 6) * 96 + (c & 63); sc = 0.125f * LOG2E; }
            else if (pn < 16) { const int c = col - 3584; base = FK; ld = 640; dcol = (c >> 6) * 80 + (c & 63); }
            else if (pn < 18) { base = FV; ld = 512; dcol = col - 4096; }
            else if (pn < 20) { base = MQ; ld = 768; dcol = col - 4608; sc = 0.08838834764831845f * LOG2E; }
            else { const int bc = col - 5120;
                if (bc < 384) { base = CQ; ld = 384; dcol = bc; } else if (bc < 640) { base = CKV; ld = 256; dcol = bc - 384; } else { base = nullptr; ld = 0; dcol = bc; } }
            f32x4 b0 = (f32x4){0.f, 0.f, 0.f, 0.f}, b1 = b0;
            if (gate) { b0 = *(const f32x4*)(bgate + col); b1 = *(const f32x4*)(bgate + col + 4); }
            const bool side = (pn == 22) && (bj == 1) && (wc == 0 || (wc == 1 && fq == 0));
#pragma unroll
            for (int ai = 0; ai < 2; ++ai)
#pragma unroll
                for (int m = 0; m < 4; ++m) { const size_t row = (size_t)(row0 + ai * HALF + m * 16);
                    f32x4 v0 = acc[ai][bj][m][0], v1 = acc[ai][bj][m][1];
                    if (gate) {
#pragma unroll
                        for (int i = 0; i < 4; ++i) { v0[i] = sigm(v0[i] + b0[i]); v1[i] = sigm(v1[i] + b1[i]); } }
                    else { v0 = v0 * sc; v1 = v1 * sc; }
                    if (base) *(u32x4*)(base + row * ld + dcol) = pack8(v0, v1);
                    if (side) { float* sp = SIDE + row * 40 + (dcol - 640); *(f32x4*)sp = v0; *(f32x4*)(sp + 4) = v1; } }
        }
    }
};
struct EpiKvup {
    static constexpr bool PERM = true; static __device__ __forceinline__ bool keep(const Unit&) { return false; }
    bf16_t* KN; bf16_t* VM;
    __device__ __forceinline__ void operator()(f32x4 (&acc)[2][2][4][2], const Unit& u, int wr, int wc, int fr, int fq) const {
        const int row0 = u.pm * BM + wr * 64 + fr; bf16_t* base = ((wc < 2) ? KN : VM) + (2 * u.pn) * 64 + (wc & 1) * 32 + 8 * fq;
#pragma unroll
        for (int ai = 0; ai < 2; ++ai)
#pragma unroll
            for (int m = 0; m < 4; ++m) { bf16_t* rowp = base + (size_t)(row0 + ai * HALF + m * 16) * 512;
#pragma unroll
                for (int bj = 0; bj < 2; ++bj) *(u32x4*)(rowp + bj * 64) = pack8(acc[ai][bj][m][0], acc[ai][bj][m][1]); }
    }
};
struct EpiBranch {
    static constexpr bool PERM = true; static __device__ __forceinline__ bool keep(const Unit& u) { return u.seg < 2; }
    const bf16_t* G; bf16_t* MG;
    __device__ __forceinline__ void operator()(f32x4 (&acc)[2][2][4][2], const Unit& u, int wr, int wc, int fr, int fq) const {
        const int row0 = u.pm * BM + wr * 64 + fr, col0 = u.pn * BM + wc * 32 + 8 * fq, seg = u.seg;
#pragma unroll
        for (int ai = 0; ai < 2; ++ai)
#pragma unroll
            for (int m = 0; m < 4; ++m) { const size_t row = (size_t)(row0 + ai * HALF + m * 16);
#pragma unroll
                for (int bj = 0; bj < 2; ++bj) { const int col = col0 + bj * HALF;
                    f32x4 ga0, ga1; unpack8(*(const u32x4*)(G + row * 3072 + seg * 1024 + col), ga0, ga1);
                    if (seg < 2) { f32x4 gb0, gb1; unpack8(*(const u32x4*)(G + row * 3072 + (seg + 1) * 1024 + col), gb0, gb1);
#pragma unroll
                        for (int i = 0; i < 4; ++i) { acc[ai][bj][m][0][i] *= fmaxf(ga0[i], 1e-30f) / fmaxf(gb0[i], 1e-30f); acc[ai][bj][m][1][i] *= fmaxf(ga1[i], 1e-30f) / fmaxf(gb1[i], 1e-30f); } }
                    else { f32x4 v0, v1;
#pragma unroll
                        for (int i = 0; i < 4; ++i) { v0[i] = acc[ai][bj][m][0][i] * fmaxf(ga0[i], 1e-30f); v1[i] = acc[ai][bj][m][1][i] * fmaxf(ga1[i], 1e-30f); }
                        *(u32x4*)(MG + row * 1024 + col) = pack8(v0, v1); } } }
    }
};
}

namespace att {
using pg8::bf16_t;
typedef short bf16x8 __attribute__((ext_vector_type(8)));
typedef short s16x4 __attribute__((ext_vector_type(4)));
typedef float f32x16 __attribute__((ext_vector_type(16)));
typedef unsigned u32x4 __attribute__((ext_vector_type(4)));
typedef unsigned u32x2 __attribute__((ext_vector_type(2)));
typedef float f32x4 __attribute__((ext_vector_type(4)));
#define ATT_LAS __attribute__((address_space(3)))
struct Args {
    const bf16_t* Q; int qp;
    const bf16_t* KA; int kap;
    const bf16_t* KB; int kbp;
    const bf16_t* V; int vp;
    bf16_t* O; int op;
    const float* RC; const float* RSN;
};
__device__ __forceinline__ unsigned cvtpk(float lo, float hi) { unsigned r; asm volatile("v_cvt_pk_bf16_f32 %0, %1, %2" : "=v"(r) : "v"(lo), "v"(hi)); return r; }
__device__ __forceinline__ s16x4 vtr(const ATT_LAS unsigned char* p) { return __builtin_bit_cast(s16x4, __builtin_amdgcn_ds_read_tr16_b64_v4i16((ATT_LAS s16x4*)p)); }

template <int DKC, int DVB, bool CAUSAL, bool ROPE>
__device__ __forceinline__ void attn_unit(const Args a, long qrow0, long krow0, int q0, int NT, ATT_LAS unsigned char* lds) {
    int tid_ = threadIdx.x; asm volatile("" : "+v"(tid_));
    const int tid = tid_, lane = tid & 63, r32 = lane & 31, hi = lane >> 5;
    const int wid = __builtin_amdgcn_readfirstlane(tid >> 6);
    constexpr int KSLOT = DKC * 2048, VSLOT = DVB * 4096, NKC = 2 * DKC, KL = (NKC + 7) / 8, VL = (DVB * 4 + 7) / 8;
    ATT_LAS unsigned char* Kb = lds; ATT_LAS unsigned char* Vb = lds + 2 * KSLOT;
    bf16x8 qr[DKC];
    { const bf16_t* qrow = a.Q + (size_t)(qrow0 + wid * 32 + r32) * a.qp + hi * 8;
#pragma unroll
      for (int c = 0; c < DKC; ++c) qr[c] = *(const bf16x8*)(qrow + c * 16); }
    if constexpr (ROPE) {
        const size_t trow = (size_t)(qrow0 + wid * 32 + r32) * 16 + 8 * hi;
        const f32x4 c0 = *(const f32x4*)(a.RC + trow), c1 = *(const f32x4*)(a.RC + trow + 4), s0 = *(const f32x4*)(a.RSN + trow), s1 = *(const f32x4*)(a.RSN + trow + 4);
        bf16x8 x1 = qr[4], x2 = qr[5];
#pragma unroll
        for (int j = 0; j < 8; ++j) { const float cc = j < 4 ? c0[j & 3] : c1[j & 3], ss = j < 4 ? s0[j & 3] : s1[j & 3];
            const float a1 = __uint_as_float((unsigned)(unsigned short)x1[j] << 16), a2 = __uint_as_float((unsigned)(unsigned short)x2[j] << 16);
            const float r1 = a1 * cc - a2 * ss, r2 = a2 * cc + a1 * ss;
            x1[j] = (short)(cvtpk(r1, 0.f) & 0xffffu); x2[j] = (short)(cvtpk(r2, 0.f) & 0xffffu); }
        qr[4] = x1; qr[5] = x2;
    }
    u32x4 kreg[KL], vreg[VL];
#define ATT_GLOAD(t) do { const size_t kr_ = (size_t)(krow0 + 64 * (t)); \
    _Pragma("unroll") for (int j = 0; j < KL; ++j) { const int c8 = wid + 8 * j; if (c8 < NKC) { \
        const bf16_t* src = (c8 < 8) ? (a.KA + (kr_ + lane) * a.kap + c8 * 8) : (a.KB + (kr_ + lane) * a.kbp + (c8 - 8) * 8); kreg[j] = *(const u32x4*)src; } } \
    _Pragma("unroll") for (int j = 0; j < VL; ++j) { const int pc = wid + 8 * j; if (pc < DVB * 4) { \
        vreg[j] = *(const u32x4*)(a.V + (kr_ + 16 * (pc & 3) + (lane >> 2)) * a.vp + 32 * (pc >> 2) + (lane & 3) * 8); } } } while (0)
#define ATT_LSTORE(buf) do { \
    _Pragma("unroll") for (int j = 0; j < KL; ++j) { const int c8 = wid + 8 * j; if (c8 < NKC) *(ATT_LAS u32x4*)(Kb + (buf) * KSLOT + c8 * 1024 + lane * 16) = kreg[j]; } \
    _Pragma("unroll") for (int j = 0; j < VL; ++j) { const int pc = wid + 8 * j; if (pc < DVB * 4) *(ATT_LAS u32x4*)(Vb + (buf) * VSLOT + pc * 1024 + lane * 16) = vreg[j]; } } while (0)
    ATT_GLOAD(0); ATT_LSTORE(0);
    __syncthreads();
    f32x16 o[DVB];
#pragma unroll
    for (int d = 0; d < DVB; ++d)
#pragma unroll
        for (int r = 0; r < 16; ++r) o[d][r] = 0.f;
    float mrun = -1e30f, lrun = 0.f;
    const int qpos = q0 + wid * 32 + r32;
    const int koff = hi * 1024 + r32 * 16;
    const int voff = ((lane >> 4) & 1) * 32 + (lane & 3) * 8 + (4 * hi + ((lane & 15) >> 2)) * 64;
    for (int t = 0; t < NT; ++t) {
        const int buf = t & 1;
        if (t + 1 < NT) ATT_GLOAD(t + 1);
        const bool active = !CAUSAL || (64 * t <= q0 + wid * 32 + 31);
        if (active) {
            f32x16 s0, s1;
#pragma unroll
            for (int r = 0; r < 16; ++r) { s0[r] = 0.f; s1[r] = 0.f; }
            const ATT_LAS unsigned char* kp = Kb + buf * KSLOT + koff;
#pragma unroll
            for (int c = 0; c < DKC; ++c) {
                const bf16x8 k0 = *(const ATT_LAS bf16x8*)(kp + c * 2048), k1 = *(const ATT_LAS bf16x8*)(kp + c * 2048 + 512);
                s0 = __builtin_amdgcn_mfma_f32_32x32x16_bf16(k0, qr[c], s0, 0, 0, 0);
                s1 = __builtin_amdgcn_mfma_f32_32x32x16_bf16(k1, qr[c], s1, 0, 0, 0);
            }
            if (CAUSAL && (64 * t + 63 > q0 + wid * 32)) {
                const int kb = 64 * t + 4 * hi;
#pragma unroll
                for (int r = 0; r < 16; ++r) { const int kv = kb + (r & 3) + 8 * (r >> 2); if (kv > qpos) s0[r] = -INFINITY; if (kv + 32 > qpos) s1[r] = -INFINITY; }
            }
            float rm = fmaxf(s0[0], s1[0]);
#pragma unroll
            for (int r = 1; r < 16; ++r) rm = fmaxf(rm, fmaxf(s0[r], s1[r]));
            rm = fmaxf(rm, __shfl_xor(rm, 32));
            const float mn = fmaxf(mrun, rm);
            const float alpha = __builtin_amdgcn_exp2f(mrun - mn);
            mrun = mn;
            float sum = 0.f;
#pragma unroll
            for (int r = 0; r < 16; ++r) { s0[r] = __builtin_amdgcn_exp2f(s0[r] - mn); s1[r] = __builtin_amdgcn_exp2f(s1[r] - mn); sum += s0[r] + s1[r]; }
            lrun = lrun * alpha + sum;
#pragma unroll
            for (int d = 0; d < DVB; ++d)
#pragma unroll
                for (int r = 0; r < 16; ++r) o[d][r] *= alpha;
            u32x4 pw[4];
#pragma unroll
            for (int i = 0; i < 4; ++i) { pw[0][i] = cvtpk(s0[2 * i], s0[2 * i + 1]); pw[1][i] = cvtpk(s0[8 + 2 * i], s0[9 + 2 * i]); pw[2][i] = cvtpk(s1[2 * i], s1[2 * i + 1]); pw[3][i] = cvtpk(s1[8 + 2 * i], s1[9 + 2 * i]); }
            const ATT_LAS unsigned char* vpp = Vb + buf * VSLOT + voff;
#pragma unroll
            for (int d = 0; d < DVB; ++d)
#pragma unroll
                for (int ks = 0; ks < 4; ++ks) {
                    const s16x4 lo = vtr(vpp + d * 4096 + ks * 1024), hh = vtr(vpp + d * 4096 + ks * 1024 + 512);
                    const bf16x8 vf = (bf16x8){lo[0], lo[1], lo[2], lo[3], hh[0], hh[1], hh[2], hh[3]};
                    o[d] = __builtin_amdgcn_mfma_f32_32x32x16_bf16(vf, __builtin_bit_cast(bf16x8, pw[ks]), o[d], 0, 0, 0);
                }
        }
        if (t + 1 < NT) ATT_LSTORE(buf ^ 1);
        __syncthreads();
    }
    lrun += __shfl_xor(lrun, 32);
    const float inv = 1.f / lrun;
    bf16_t* orow = a.O + (size_t)(qrow0 + wid * 32 + r32) * a.op + 4 * hi;
#pragma unroll
    for (int d = 0; d < DVB; ++d)
#pragma unroll
        for (int g = 0; g < 4; ++g) { u32x2 w; w.x = cvtpk(o[d][4 * g] * inv, o[d][4 * g + 1] * inv); w.y = cvtpk(o[d][4 * g + 2] * inv, o[d][4 * g + 3] * inv);
            *(u32x2*)(orow + 32 * d + 8 * g) = w; }
#undef ATT_GLOAD
#undef ATT_LSTORE
}
}

using pg8::bf16_t; using pg8::f32x4; using pg8::u32x4;
#define LAS __attribute__((address_space(3)))
constexpr int NB = 4, S = 8192, T = NB * S, D = 1024, FF = 2816, NPROJ = 5888, NWAVES = 8;
constexpr float ALPHA = 1.189207115002721f;
constexpr size_t MiB = 1u << 20;
constexpr size_t WS_RS = 2 * MiB;
constexpr size_t WS_RC = 3 * MiB;
constexpr size_t WS_RSN = 5 * MiB;
constexpr size_t WS_SIDE = 7 * MiB;
constexpr size_t WS_MEMB = 12 * MiB;
constexpr size_t WS_MEMKV = 14 * MiB;
constexpr size_t WS_WIN = 16 * MiB;
constexpr size_t WS_WUQ = 28 * MiB;
constexpr size_t WS_WUKV = 29 * MiB;
constexpr size_t WS_WMKV = 30 * MiB;
constexpr size_t WS_KR = 32 * MiB;
constexpr size_t WS_XB = 34 * MiB;
constexpr size_t WS_QM = 34 * MiB;
constexpr size_t WS_WBR = 82 * MiB;
constexpr size_t WS_WOUT = 87 * MiB;
constexpr size_t WS_H = 98 * MiB;
constexpr size_t WS_G = 98 * MiB;
constexpr size_t WS_SLOT0 = 290 * MiB;
constexpr size_t WS_FQ = 338 * MiB;
constexpr size_t WS_MQ = 386 * MiB;
constexpr size_t WS_FK = 434 * MiB;
constexpr size_t WS_FV = 474 * MiB;
constexpr size_t WS_KN = 434 * MiB;
constexpr size_t WS_VM = 466 * MiB;
constexpr size_t WS_MG = 434 * MiB;
constexpr size_t WS_WA = 480 * MiB;
constexpr size_t WS_WD = 491 * MiB;
constexpr size_t WS_END = 512 * MiB;
static_assert(WS_FV + (size_t)T * 512 * 2 <= WS_END && WS_WD + (size_t)1024 * 2816 * 2 <= WS_END && WS_FQ - WS_SLOT0 == (size_t)T * 768 * 2 && WS_MQ - WS_FQ == (size_t)T * 768 * 2, "ws map");
constexpr int LDS_BYTES = 147456;

__device__ __forceinline__ unsigned f2bf(float f) { unsigned u = __builtin_bit_cast(unsigned, f); return (u + 0x7fffu + ((u >> 16) & 1u)) >> 16; }
__device__ __forceinline__ unsigned pk2(float lo, float hi) { return f2bf(lo) | (f2bf(hi) << 16); }
__device__ __forceinline__ float bf2f(unsigned b) { return __uint_as_float(b << 16); }
__device__ __forceinline__ float wave_sum(float v) {
#pragma unroll
    for (int o = 1; o < 64; o <<= 1) v += __shfl_xor(v, o);
    return v;
}
#define LDS_WAIT() asm volatile("s_waitcnt lgkmcnt(0)" ::: "memory")

__device__ __forceinline__ int map_ffn(int c) { return c < FF ? ((c >> 7) << 8) + (c & 127) : (((c - FF) >> 7) << 8) + 128 + ((c - FF) & 127); }
__device__ __forceinline__ int map_win(int c) {
    if (c < 384) return 5120 + c;
    if (c < 640) return 5504 + (c - 384);
    if (c < 672) return 5760 + (c - 640);
    if (c < 1184) return 3072 + (c - 672);
    if (c < 1696) return 3584 + (c - 1184);
    if (c < 2208) return 4096 + (c - 1696);
    if (c < 2216) return 5792 + (c - 2208);
    if (c < 2728) return 4608 + (c - 2216);
    return c - 2728;
}
template <int MODE>
__device__ __forceinline__ void tr_mat(const float* __restrict__ W, int K, int N, const float* __restrict__ ks, bf16_t* WT, int ldt, int kmul, LAS float* scr, int gw, int NGW, int lane) {
    const int nblk = (N + 31) / 32, items = (K / 64) * nblk;
    for (int it = gw; it < items; it += NGW) {
        const int kb = it / nblk, nb = it % nblk, k0 = 64 * kb, n0 = 32 * nb;
        const int nn = n0 + (lane & 31); const bool ok = nn < N;
#pragma unroll 8
        for (int i = 0; i < 32; ++i) { const int kk = 2 * i + (lane >> 5); float v = ok ? W[(size_t)(k0 + kk) * N + nn] : 0.f; if (ks) v *= ks[k0 + kk]; scr[kk * 33 + (lane & 31)] = v; }
        LDS_WAIT(); asm volatile("" ::: "memory");
        const int c = lane & 7, dc = kb * kmul + 8 * c;
#pragma unroll
        for (int j = 0; j < 4; ++j) { const int n = (lane >> 3) + 8 * j, sc = n0 + n;
            if (sc < N) { const LAS float* s = scr + (8 * c) * 33 + n;
                u32x4 o; o.x = pk2(s[0 * 33], s[1 * 33]); o.y = pk2(s[2 * 33], s[3 * 33]); o.z = pk2(s[4 * 33], s[5 * 33]); o.w = pk2(s[6 * 33], s[7 * 33]);
                const int dr = MODE == 1 ? map_ffn(sc) : (MODE == 2 ? map_win(sc) : sc);
                *(u32x4*)(WT + (size_t)dr * ldt + dc) = o; } }
        LDS_WAIT(); asm volatile("" ::: "memory");
    }
}
__device__ __forceinline__ void cvt_copy(const float* __restrict__ src, bf16_t* dst, size_t n, size_t gt, size_t NTH) {
    for (size_t i = gt * 8; i < n; i += NTH * 8) { const f32x4 a = *(const f32x4*)(src + i), b = *(const f32x4*)(src + i + 4);
        u32x4 o; o.x = pk2(a[0], a[1]); o.y = pk2(a[2], a[3]); o.z = pk2(b[0], b[1]); o.w = pk2(b[2], b[3]); *(u32x4*)(dst + i) = o; }
}
__device__ __forceinline__ void ln_row(const float* xrow, const float* __restrict__ g, const float* __restrict__ b, float* outf, bf16_t* outb, int lane) {
    f32x4 v[4]; float s = 0.f;
#pragma unroll
    for (int j = 0; j < 4; ++j) { v[j] = *(const f32x4*)(xrow + 4 * lane + 256 * j); s += (v[j][0] + v[j][1]) + (v[j][2] + v[j][3]); }
    const float mean = wave_sum(s) * (1.f / D); float s2 = 0.f;
#pragma unroll
    for (int j = 0; j < 4; ++j) { v[j] = v[j] - mean; s2 += (v[j][0] * v[j][0] + v[j][1] * v[j][1]) + (v[j][2] * v[j][2] + v[j][3] * v[j][3]); }
    const float rstd = 1.f / sqrtf(wave_sum(s2) * (1.f / D) + 1e-5f);
#pragma unroll
    for (int j = 0; j < 4; ++j) { const f32x4 gg = *(const f32x4*)(g + 4 * lane + 256 * j), bb = *(const f32x4*)(b + 4 * lane + 256 * j);
        const f32x4 y = v[j] * rstd * gg + bb;
        if (outf) *(f32x4*)(outf + 4 * lane + 256 * j) = y;
        if (outb) { unsigned long long w = (unsigned long long)pk2(y[0], y[1]) | ((unsigned long long)pk2(y[2], y[3]) << 32); *(unsigned long long*)(outb + 4 * lane + 256 * j) = w; } }
}

#ifndef PH_MASK
#define PH_MASK 0xFFFF
#endif
struct Params { const float* in[25]; float* out; unsigned char* ws; };

__global__ void __launch_bounds__(NWAVES * 64) mega_fwd(Params p) {
    extern __shared__ __attribute__((aligned(16))) unsigned char lds_raw[];
    cg::grid_group grid = cg::this_grid();
    LAS unsigned char* lds = (LAS unsigned char*)lds_raw;
    const int tid = threadIdx.x, lane = tid & 63, wave = __builtin_amdgcn_readfirstlane(tid >> 6);
    const int G = gridDim.x, bx = blockIdx.x;
    const int gw = bx * NWAVES + wave, NGW = G * NWAVES;
    const size_t gt = (size_t)bx * (NWAVES * 64) + tid, NTH = (size_t)G * (NWAVES * 64);
    unsigned char* ws = p.ws;
    const float* x = p.in[0]; const float* mem = p.in[1]; const int* positions = (const int*)p.in[2];
    float* R = p.out;
    float* RS = (float*)(ws + WS_RS); float* RC = (float*)(ws + WS_RC); float* RSN = (float*)(ws + WS_RSN); float* SIDE = (float*)(ws + WS_SIDE);
    bf16_t* MEMB = (bf16_t*)(ws + WS_MEMB); bf16_t* MEMKV = (bf16_t*)(ws + WS_MEMKV);
    bf16_t* WIN = (bf16_t*)(ws + WS_WIN); bf16_t* WUQ = (bf16_t*)(ws + WS_WUQ); bf16_t* WUKV = (bf16_t*)(ws + WS_WUKV); bf16_t* WMKV = (bf16_t*)(ws + WS_WMKV);
    bf16_t* KR = (bf16_t*)(ws + WS_KR); bf16_t* XB = (bf16_t*)(ws + WS_XB); bf16_t* QM = (bf16_t*)(ws + WS_QM); bf16_t* WBR = (bf16_t*)(ws + WS_WBR); bf16_t* WOUT = (bf16_t*)(ws + WS_WOUT);
    bf16_t* HB = (bf16_t*)(ws + WS_H); bf16_t* GB = (bf16_t*)(ws + WS_G); bf16_t* SLOT0 = (bf16_t*)(ws + WS_SLOT0); bf16_t* CQ = SLOT0; bf16_t* CKV = SLOT0 + (size_t)T * 384; bf16_t* FQ = (bf16_t*)(ws + WS_FQ); bf16_t* MQ = (bf16_t*)(ws + WS_MQ);
    bf16_t* FK = (bf16_t*)(ws + WS_FK); bf16_t* FV = (bf16_t*)(ws + WS_FV); bf16_t* KN = (bf16_t*)(ws + WS_KN); bf16_t* VM = (bf16_t*)(ws + WS_VM); bf16_t* MG = (bf16_t*)(ws + WS_MG);
    bf16_t* WA = (bf16_t*)(ws + WS_WA); bf16_t* WD = (bf16_t*)(ws + WS_WD);
    LAS float* scr = (LAS float*)(lds + wave * 16384);

#if (PH_MASK >> 0) & 1
    tr_mat<1>(p.in[5], D, 2 * FF, nullptr, WA, D, 64, scr, gw, NGW, lane);
    tr_mat<0>(p.in[6], FF, D, nullptr, WD, FF, 64, scr, gw, NGW, lane);
    tr_mat<2>(p.in[7], D, 5800, nullptr, WIN, D, 64, scr, gw, NGW, lane);
    tr_mat<0>(p.in[10], 384, 768, p.in[9], WUQ, 384, 64, scr, gw, NGW, lane);
    tr_mat<0>(p.in[12], 256, 1024, p.in[11], WUKV, 256, 64, scr, gw, NGW, lane);
    tr_mat<0>(p.in[14], D, 1024, nullptr, WMKV, D, 64, scr, gw, NGW, lane);
    for (size_t i = gt * 8; i < (size_t)88 * D; i += NTH * 8) *(u32x4*)(WIN + (size_t)5800 * D + i) = (u32x4){0u, 0u, 0u, 0u};
    cvt_copy(x, XB, (size_t)T * D, gt, NTH);
    cvt_copy(mem, MEMB, (size_t)NB * 256 * D, gt, NTH);
    for (size_t i = gt; i < (size_t)T * 16; i += NTH) {
        const int row = (int)(i >> 4), f = (int)(i & 15);
        const float invf = (float)exp2(-(double)f * (13.287712379549449 / 16.0));
        const float ang = (float)positions[row] * invf;
        const double rev = (double)ang * 0.15915494309189535; const float fr = (float)(rev - __builtin_rint(rev));
        RC[i] = __builtin_amdgcn_cosf(fr); RSN[i] = __builtin_amdgcn_sinf(fr);
    }
#endif
    grid.sync();

#if (PH_MASK >> 1) & 1
    { pg8::Gemm g{XB, WA, T, 2 * FF, D}; pg8::StaticOrder so; so.init(T, 2 * FF, G, bx);
      pg8::EpiSwiglu E{HB, FF}; pg8::gemm_phase<pg8::EpiSwiglu, pg8::StaticOrder, true>(lds, g, so, E); }
#endif
    grid.sync();
#if (PH_MASK >> 2) & 1
    { pg8::Gemm g{HB, WD, T, D, FF}; pg8::StaticOrder so; so.init(T, D, G, bx);
      pg8::EpiRes E{x, R, ALPHA, 0.5f}; pg8::gemm_phase<pg8::EpiRes, pg8::StaticOrder, true>(lds, g, so, E); }
#endif
    grid.sync();
#if (PH_MASK >> 3) & 1
    for (int m = gw; m < T; m += NGW) ln_row(R + (size_t)m * D, p.in[3], p.in[4], R + (size_t)m * D, XB + (size_t)m * D, lane);
    { pg8::Gemm g{MEMB, WMKV, NB * 256, 1024, D}; pg8::StaticOrder so; so.init(NB * 256, 1024, G, (bx + 128) % G);
      pg8::EpiPlain E{MEMKV, 1024, 1.f}; pg8::gemm_phase<pg8::EpiPlain, pg8::StaticOrder, true>(lds, g, so, E); }
#endif
    grid.sync();
#if (PH_MASK >> 4) & 1
    { pg8::Gemm g{XB, WIN, T, NPROJ, D}; pg8::StaticOrder so; so.init(T, NPROJ, G, bx);
      pg8::EpiProj E{GB, FQ, FK, FV, MQ, CQ, CKV, SIDE, p.in[8]}; pg8::gemm_phase<pg8::EpiProj, pg8::StaticOrder, true>(lds, g, so, E); }
#endif
    grid.sync();
#if (PH_MASK >> 5) & 1
    if (bx < 32) {
        const int b = bx >> 3, h = bx & 7; LAS double* sh = (LAS double*)lds;
        const float bfh = p.in[13][h]; float lf[16]; double loc = 0.0;
#pragma unroll
        for (int j = 0; j < 16; ++j) { const float xx = SIDE[((size_t)b * S + 16 * tid + j) * 40 + 32 + h] + bfh; lf[j] = fminf(xx, 0.f) - log1pf(__expf(-fabsf(xx))); loc += (double)lf[j]; }
        sh[tid] = loc; __syncthreads();
        double run = 0.0; for (int j = 0; j < tid; ++j) run += sh[j];
#pragma unroll
        for (int j = 0; j < 16; ++j) { run += (double)lf[j];
            const float f2 = (float)(run * 1.4426950408889634);
            const unsigned h1 = f2bf(f2); const float r1 = f2 - bf2f(h1); const unsigned h2 = f2bf(r1); const float r2 = r1 - bf2f(h2); const unsigned h3 = f2bf(r2);
            const size_t row = (size_t)b * S + 16 * tid + j; const unsigned one = 0x3f80u, z = 0u;
            u32x4* qd = (u32x4*)(FQ + row * 768 + h * 96 + 64);
            qd[0] = (u32x4){one | (one << 16), one | (h1 << 16), h2 | (h3 << 16), z}; qd[1] = (u32x4){z, z, z, z}; qd[2] = (u32x4){z, z, z, z}; qd[3] = (u32x4){z, z, z, z};
            u32x4* kd = (u32x4*)(FK + row * 640 + h * 80 + 64);
            const unsigned n1 = h1 ^ 0x8000u, n2 = h2 ^ 0x8000u, n3 = h3 ^ 0x8000u;
            kd[0] = (u32x4){n1 | (n2 << 16), n3 | (one << 16), one | (one << 16), z}; kd[1] = (u32x4){z, z, z, z}; }
        __syncthreads();
    }
    for (int m = gw; m < T; m += NGW) {
        f32x4 a0, a1, c0, c1; float sq = 0.f, sq2 = 0.f;
        if (lane < 48) { pg8::unpack8(*(const u32x4*)(CQ + (size_t)m * 384 + lane * 8), a0, a1);
#pragma unroll
            for (int i = 0; i < 4; ++i) sq += a0[i] * a0[i] + a1[i] * a1[i]; }
        if (lane < 32) { pg8::unpack8(*(const u32x4*)(CKV + (size_t)m * 256 + lane * 8), c0, c1);
#pragma unroll
            for (int i = 0; i < 4; ++i) sq2 += c0[i] * c0[i] + c1[i] * c1[i]; }
        const float rq = 1.f / sqrtf(wave_sum(sq) * (1.f / 384.f) + 1e-6f), rkv = 1.f / sqrtf(wave_sum(sq2) * (1.f / 256.f) + 1e-6f);
        if (lane < 48) *(u32x4*)(CQ + (size_t)m * 384 + lane * 8) = pg8::pack8(a0 * rq, a1 * rq);
        if (lane < 32) *(u32x4*)(CKV + (size_t)m * 256 + lane * 8) = pg8::pack8(c0 * rkv, c1 * rkv);
        if (lane < 16) { const float x1 = SIDE[(size_t)m * 40 + lane], x2 = SIDE[(size_t)m * 40 + 16 + lane], c = RC[(size_t)m * 16 + lane], s = RSN[(size_t)m * 16 + lane];
            KR[(size_t)m * 32 + lane] = (bf16_t)f2bf(x1 * c - x2 * s); KR[(size_t)m * 32 + 16 + lane] = (bf16_t)f2bf(x2 * c + x1 * s); }
        if (lane < 32) *(u32x4*)(MQ + (size_t)m * 768 + 512 + lane * 8) = (u32x4){0u, 0u, 0u, 0u};
    }
    tr_mat<0>(p.in[15], 512, D, nullptr, WBR, 768, 96, scr, gw, NGW, lane);
    tr_mat<0>(p.in[16], 512, D, nullptr, WBR + (size_t)1024 * 768, 768, 96, scr, gw, NGW, lane);
    tr_mat<0>(p.in[17], 512, D, nullptr, WBR + (size_t)2048 * 768, 768, 64, scr, gw, NGW, lane);
    tr_mat<0>(p.in[18], D, D, nullptr, WOUT, D, 64, scr, gw, NGW, lane);
    for (size_t i = gt; i < (size_t)3 * 1024 * 32; i += NTH) {
        const int r = (int)(i >> 5), c = (int)(i & 31); bf16_t* rowp = WBR + (size_t)r * 768;
        const int col = (r < 2048) ? ((c >> 2) * 96 + 64 + (c & 3) * 8) : (512 + c * 8);
        *(u32x4*)(rowp + col) = (u32x4){0u, 0u, 0u, 0u};
    }
    __syncthreads();
    for (int u = bx; u < NB * 4 * 32; u += G) {
        const int b = u >> 7, hm = (u >> 5) & 3, qb = u & 31;
        att::Args a{MQ + hm * 128, 768, MEMKV + hm * 128, 1024, MEMKV + hm * 128 + 64, 1024, MEMKV + 512 + hm * 128, 1024, MQ + hm * 128, 768, nullptr, nullptr};
        att::attn_unit<8, 4, false, false>(a, (long)b * S + qb * 256, (long)b * 256, 0, 4, lds);
    }
#endif
    grid.sync();
#if (PH_MASK >> 6) & 1
    for (int u = bx; u < 1024; u += G) {
        const int v = u & 255, i = u >> 8, vcu = (v & 7) * 32 + (v >> 3), bh = vcu >> 3, s = vcu & 7;
        const int qb = (i == 0) ? s : (i == 1) ? 15 - s : (i == 2) ? 16 + s : 31 - s; const int b = bh >> 3, h = bh & 7;
        att::Args a{FQ + h * 96, 768, FK + h * 80, 640, FK + h * 80 + 64, 640, FV + h * 64, 512, FQ + h * 96, 768, nullptr, nullptr};
        att::attn_unit<5, 2, true, false>(a, (long)b * S + qb * 256, (long)b * S, qb * 256, 4 * (qb + 1), lds);
    }
#endif
    grid.sync();
#if (PH_MASK >> 7) & 1
    { pg8::Gemm g{CQ, WUQ, T, 768, 384}; pg8::StaticOrder so; so.init(T, 768, G, bx);
      pg8::EpiPlain E{QM, 768, 0.10206207261596577f * pg8::LOG2E}; pg8::gemm_phase<pg8::EpiPlain, pg8::StaticOrder, true>(lds, g, so, E); }
    { pg8::Gemm g{CKV, WUKV, T, 1024, 256}; pg8::StaticOrder so; so.init(T, 1024, G, bx);
      pg8::EpiKvup E{KN, VM}; pg8::gemm_phase<pg8::EpiKvup, pg8::StaticOrder, true>(lds, g, so, E); }
#endif
    grid.sync();
#if (PH_MASK >> 8) & 1
    for (int u = bx; u < 1024; u += G) {
        const int v = u & 255, i = u >> 8, vcu = (v & 7) * 32 + (v >> 3), bh = vcu >> 3, s = vcu & 7;
        const int qb = (i == 0) ? s : (i == 1) ? 15 - s : (i == 2) ? 16 + s : 31 - s; const int b = bh >> 3, h = bh & 7;
        att::Args a{QM + h * 96, 768, KN + h * 64, 512, KR, 32, VM + h * 64, 512, SLOT0 + h * 96, 768, RC, RSN};
        att::attn_unit<6, 2, true, true>(a, (long)b * S + qb * 256, (long)b * S, qb * 256, 4 * (qb + 1), lds);
    }
#endif
    grid.sync();
#if (PH_MASK >> 9) & 1
    { pg8::Gemm g{SLOT0, WBR, T, D, 768}; pg8::SegOrder so; so.init(T, D, G, bx, 3);
      pg8::EpiBranch E{GB, MG}; pg8::gemm_phase<pg8::EpiBranch, pg8::SegOrder, true>(lds, g, so, E); }
#endif
    grid.sync();
#if (PH_MASK >> 10) & 1
    { pg8::Gemm g{MG, WOUT, T, D, D}; pg8::StaticOrder so; so.init(T, D, G, bx);
      pg8::EpiRes E{R, R, ALPHA, 1.f}; pg8::gemm_phase<pg8::EpiRes, pg8::StaticOrder, true>(lds, g, so, E); }
#endif
    grid.sync();
#if (PH_MASK >> 11) & 1
    for (int m = gw; m < T; m += NGW) ln_row(R + (size_t)m * D, p.in[19], p.in[20], R + (size_t)m * D, XB + (size_t)m * D, lane);
    tr_mat<1>(p.in[21], D, 2 * FF, nullptr, WA, D, 64, scr, gw, NGW, lane);
    tr_mat<0>(p.in[22], FF, D, nullptr, WD, FF, 64, scr, gw, NGW, lane);
#endif
    grid.sync();
#if (PH_MASK >> 12) & 1
    { pg8::Gemm g{XB, WA, T, 2 * FF, D}; pg8::StaticOrder so; so.init(T, 2 * FF, G, bx);
      pg8::EpiSwiglu E{HB, FF}; pg8::gemm_phase<pg8::EpiSwiglu, pg8::StaticOrder, true>(lds, g, so, E); }
#endif
    grid.sync();
#if (PH_MASK >> 13) & 1
    { pg8::Gemm g{HB, WD, T, D, FF}; pg8::StaticOrder so; so.init(T, D, G, bx);
      pg8::EpiRes E{R, R, ALPHA, 0.5f}; pg8::gemm_phase<pg8::EpiRes, pg8::StaticOrder, true>(lds, g, so, E); }
#endif
    grid.sync();
#if (PH_MASK >> 14) & 1
    for (int m = gw; m < T; m += NGW) ln_row(R + (size_t)m * D, p.in[23], p.in[24], R + (size_t)m * D, nullptr, lane);
#endif
}

extern "C" void kernel_launch(void* const* d_in, const int* in_sizes, int n_in, void* d_out, int out_size, void* d_ws, size_t ws_size, hipStream_t stream) {
    static int grid = 0;
    if (grid == 0) {
        if (n_in != 25 || out_size != T * D || ws_size < WS_END) { fprintf(stderr, "kernel_launch: unexpected shapes (n_in %d out %d ws %zu)\n", n_in, out_size, ws_size); grid = -1; return; }
        int dev = 0, cus = 0, per = 0;
        (void)hipGetDevice(&dev); (void)hipDeviceGetAttribute(&cus, hipDeviceAttributeMultiprocessorCount, dev);
        (void)hipFuncSetAttribute((const void*)mega_fwd, hipFuncAttributeMaxDynamicSharedMemorySize, LDS_BYTES);
        (void)hipOccupancyMaxActiveBlocksPerMultiprocessor(&per, (const void*)mega_fwd, NWAVES * 64, LDS_BYTES);
        if (per < 1) per = 1;
        grid = cus * per;
        fprintf(stderr, "kernel_launch: grid %d (cus %d x %d), ws %zu\n", grid, cus, per, ws_size);
    }
    if (grid < 0) return;
    Params p{};
    for (int i = 0; i < 25; ++i) p.in[i] = (const float*)d_in[i];
    p.out = (float*)d_out; p.ws = (unsigned char*)d_ws;
    void* args[] = {&p};
    const hipError_t e = hipLaunchCooperativeKernel((const void*)mega_fwd, dim3(grid), dim3(NWAVES * 64), args, LDS_BYTES, stream);
    if (e != hipSuccess) fprintf(stderr, "kernel_launch: cooperative launch failed: %s (grid %d)\n", hipGetErrorString(e), grid);
}
```

```cpp
#include <hip/hip_runtime.h>
#include <hip/hip_cooperative_groups.h>
#include <cstdio>
#include <cstdint>
#include <cmath>
namespace cg = cooperative_groups;
namespace pg8 {
#define PG8_LAS __attribute__((address_space(3)))
typedef unsigned short bf16_t;
typedef short bf16x8 __attribute__((ext_vector_type(8)));
typedef float f32x4 __attribute__((ext_vector_type(4)));
typedef unsigned u32x4 __attribute__((ext_vector_type(4)));
constexpr int BM = 256, BK = 64, HALF = 128, HTB = HALF * BK * 2  , STAGE_BYTES = 8 * HTB, NXCD = 8, WGM = 8;

__host__ __device__ __forceinline__ int lds_byte(int r, int c) { const int st = (r >> 4) * 2 + (c >> 5), rr = r & 15, cc = c & 31, ob = rr * 64 + cc * 2; return st * 1024 + (ob ^ (((ob >> 9) & 1) << 5)); }
__host__ __device__ __forceinline__ void stage_rc(int b, int& R, int& C) { const int st = b / 1024, sb = b % 1024, swz = sb ^ (((sb >> 9) & 1) << 5); R = (st >> 1) * 16 + swz / 64; C = (st & 1) * 32 + (swz % 64) / 2; }
__host__ __device__ __forceinline__ int perm32(int rho) { const int n = rho >> 4, i = rho & 15; return 8 * (i >> 2) + 4 * n + (i & 3); }

struct Unit { int pm, pn, am, bn, seg; };
struct Gemm { const bf16_t* A; const bf16_t* Bt; int M, N, K; };

struct StaticOrder {
    int nM, nN, nwg, G, c;
    __host__ __device__ void init(int M, int N, int G_, int c_) { nM = M / BM; nN = N / BM; nwg = nM * nN; G = G_; c = c_; }
    __host__ __device__ bool next(int i, Unit& u) const {
        const long L = (long)i * G + c; if (L >= nwg) return false;
        int wgid = (int)L; { const int q = nwg / NXCD, r = nwg % NXCD, xcd = wgid % NXCD, off = wgid / NXCD; wgid = (xcd < r ? xcd * (q + 1) : r * (q + 1) + (xcd - r) * q) + off; }
        const int nig = WGM * nN, gid = wgid / nig, fm = gid * WGM, gsz = (nM - fm) < WGM ? (nM - fm) : WGM;
        u.pm = fm + ((wgid % nig) % gsz); u.pn = (wgid % nig) / gsz; u.am = u.pm; u.bn = u.pn; u.seg = 0; return true;
    }
};

__device__ __forceinline__ unsigned cvt_pk_bf16(float lo, float hi) { unsigned r; asm volatile("v_cvt_pk_bf16_f32 %0, %1, %2" : "=v"(r) : "v"(lo), "v"(hi)); return r; }
typedef float f32x2 __attribute__((ext_vector_type(2)));
template <class Epi, class Sched, bool ALIGN_EPI = false, bool SP2 = true>
__device__ __forceinline__ void gemm_phase(PG8_LAS unsigned char* lds, const Gemm g, const Sched& S, const Epi& E) {
    int tid_ = threadIdx.x; asm volatile("" : "+v"(tid_));
    const int tid = tid_, wid = __builtin_amdgcn_readfirstlane(tid >> 6), lane = tid & 63, wr = wid >> 2, wc = wid & 3, fr = lane & 15, fq = lane >> 4;
    const int K = g.K, nt = K / BK;
    unsigned voffA[2], voffB[2];
#pragma unroll
    for (int i = 0; i < 2; ++i) { int R, C; stage_rc(tid * 16 + i * 8192, R, C); const int Rb = Epi::PERM ? ((R & ~31) + perm32(R & 31)) : R;
        voffA[i] = (unsigned)(R * K + C) * 2u; voffB[i] = (unsigned)(Rb * K + C) * 2u; }
    const size_t kstep = (size_t)(BK * 2);
    const size_t hstep = (size_t)HALF * K * 2;
    const size_t tstep = 2 * hstep;
    const unsigned ldsw = (unsigned)wid * 1024u;
    const int aoff = lds_byte(wr * 64 + fr, fq * 8), boff = lds_byte(wc * 32 + fr, fq * 8);
#define PG8_SA(b, h) (((b) * 2 + (h)) * HTB)
#define PG8_SB(b, h) ((4 + (b) * 2 + (h)) * HTB)
#define PG8_STAGE(bufoff, gbase, voff) do { _Pragma("unroll") for (int _i = 0; _i < 2; ++_i) \
        __builtin_amdgcn_global_load_lds((const unsigned*)((const char*)(gbase) + (voff)[_i]), (PG8_LAS unsigned*)(lds + (bufoff) + ldsw + _i * 8192), 16, 0, 0); } while (0)
#define PG8_LDA(dst, b, h) do { _Pragma("unroll") for (int m = 0; m < 4; ++m) _Pragma("unroll") for (int k = 0; k < 2; ++k) dst[m][k] = *(const PG8_LAS bf16x8*)(lds + PG8_SA(b, h) + aoff + m * 2048 + k * 1024); } while (0)
#define PG8_LDB(dst, b, h) do { _Pragma("unroll") for (int n = 0; n < 2; ++n) _Pragma("unroll") for (int k = 0; k < 2; ++k) dst[n][k] = *(const PG8_LAS bf16x8*)(lds + PG8_SB(b, h) + boff + n * 2048 + k * 1024); } while (0)
#define PG8_MMA(ai, bj, At, Bt) do { __builtin_amdgcn_s_setprio(1); _Pragma("unroll") for (int m = 0; m < 4; ++m) _Pragma("unroll") for (int n = 0; n < 2; ++n) _Pragma("unroll") for (int k = 0; k < 2; ++k) \
        acc[ai][bj][m][n] = __builtin_amdgcn_mfma_f32_16x16x32_bf16(Bt[n][k], At[m][k], acc[ai][bj][m][n], 0, 0, 0); __builtin_amdgcn_s_setprio(0); } while (0)
#define PG8_WAIT_V(n) asm volatile("s_waitcnt vmcnt(" #n ")" ::: "memory")
#define PG8_WAIT_L(n) asm volatile("s_waitcnt lgkmcnt(" #n ")" ::: "memory")
#define PG8_BAR __builtin_amdgcn_s_barrier()
#define PG8_SCHED __builtin_amdgcn_sched_barrier(0)
    Unit cur, nxt; int ui = 0;
    if (!S.next(0, cur)) return;
    f32x4 acc[2][2][4][2];
#pragma unroll
    for (int a = 0; a < 2; ++a)
#pragma unroll
        for (int b = 0; b < 2; ++b)
#pragma unroll
            for (int m = 0; m < 4; ++m)
#pragma unroll
                for (int n = 0; n < 2; ++n) acc[a][b][m][n] = (f32x4){0.f, 0.f, 0.f, 0.f};
    bf16x8 At[4][2], B0[2][2], B1[2][2];
    const char* cA = (const char*)g.A + (size_t)cur.am * tstep; const char* cB = (const char*)g.Bt + (size_t)cur.bn * tstep;
    if constexpr (SP2) {
        PG8_STAGE(PG8_SB(0, 0), cB, voffB); PG8_STAGE(PG8_SB(0, 1), cB + hstep, voffB); PG8_STAGE(PG8_SA(0, 0), cA, voffA); PG8_STAGE(PG8_SA(0, 1), cA + hstep, voffA);
        if (wr == 1) PG8_BAR;
        PG8_WAIT_V(2); PG8_BAR;
        PG8_STAGE(PG8_SB(1, 0), cB + kstep, voffB); PG8_STAGE(PG8_SA(1, 0), cA + kstep, voffA); PG8_STAGE(PG8_SB(1, 1), cB + hstep + kstep, voffB);
        PG8_WAIT_V(6); PG8_BAR;
    } else {
        PG8_STAGE(PG8_SB(0, 0), cB, voffB); PG8_STAGE(PG8_SA(0, 0), cA, voffA); PG8_STAGE(PG8_SB(0, 1), cB + hstep, voffB); PG8_STAGE(PG8_SA(0, 1), cA + hstep, voffA);
        if (wr == 1) PG8_BAR;
        PG8_WAIT_V(4); PG8_BAR;
        PG8_STAGE(PG8_SB(1, 0), cB + kstep, voffB); PG8_STAGE(PG8_SA(1, 0), cA + kstep, voffA); PG8_STAGE(PG8_SB(1, 1), cB + hstep + kstep, voffB);
        PG8_WAIT_V(6); PG8_BAR;
    }
    for (;;) {
        const bool has_next = S.next(ui + 1, nxt);
        const char* nA = has_next ? (const char*)g.A + (size_t)nxt.am * tstep : cA; const char* nB = has_next ? (const char*)g.Bt + (size_t)nxt.bn * tstep : cB;
#pragma nounroll
        for (int t = 0; t < nt; t += 2) {
            const bool last = (t == nt - 2);
            const char* a1 = cA + (size_t)(t + 1) * kstep;
            const char* a2 = last ? nA : cA + (size_t)(t + 2) * kstep; const char* b2 = last ? nB : cB + (size_t)(t + 2) * kstep;
            const char* a3 = a2 + kstep; const char* b3 = b2 + kstep;
            if constexpr (SP2) {
            PG8_LDB(B0, 0, 0); PG8_LDB(B1, 0, 1); PG8_SCHED; PG8_LDA(At, 0, 0); PG8_STAGE(PG8_SA(1, 1), a1 + hstep, voffA);
            PG8_WAIT_V(8); PG8_WAIT_L(0); PG8_BAR; PG8_MMA(0, 0, At, B0); PG8_MMA(0, 1, At, B1); PG8_BAR; PG8_SCHED;
            PG8_LDA(At, 0, 1); PG8_STAGE(PG8_SB(0, 0), b2, voffB); PG8_STAGE(PG8_SB(0, 1), b2 + hstep, voffB); PG8_STAGE(PG8_SA(0, 0), a2, voffA);
            PG8_WAIT_V(8); PG8_WAIT_L(0); PG8_BAR; PG8_MMA(1, 0, At, B0); PG8_MMA(1, 1, At, B1); PG8_BAR; PG8_SCHED;
            PG8_LDB(B0, 1, 0); PG8_LDB(B1, 1, 1); PG8_SCHED; PG8_LDA(At, 1, 0); PG8_STAGE(PG8_SA(0, 1), a2 + hstep, voffA);
            PG8_WAIT_V(8); PG8_WAIT_L(0); PG8_BAR; PG8_MMA(0, 0, At, B0); PG8_MMA(0, 1, At, B1); PG8_BAR; PG8_SCHED;
            PG8_LDA(At, 1, 1); PG8_STAGE(PG8_SB(1, 0), b3, voffB); PG8_STAGE(PG8_SB(1, 1), b3 + hstep, voffB); PG8_STAGE(PG8_SA(1, 0), a3, voffA);
            PG8_WAIT_V(8); PG8_WAIT_L(0); PG8_BAR; PG8_MMA(1, 0, At, B0); PG8_MMA(1, 1, At, B1); PG8_BAR; PG8_SCHED;
            } else {
            PG8_LDB(B0, 0, 0); PG8_SCHED; PG8_LDA(At, 0, 0); PG8_STAGE(PG8_SA(1, 1), a1 + hstep, voffA);
            PG8_WAIT_L(8); PG8_BAR; PG8_WAIT_L(0); PG8_MMA(0, 0, At, B0); PG8_BAR; PG8_SCHED;
            PG8_LDB(B1, 0, 1); PG8_STAGE(PG8_SB(0, 0), b2, voffB);
            PG8_BAR; PG8_WAIT_L(0); PG8_MMA(0, 1, At, B1); PG8_BAR;
            PG8_LDA(At, 0, 1); PG8_STAGE(PG8_SA(0, 0), a2, voffA);
            PG8_BAR; PG8_WAIT_L(0); PG8_MMA(1, 0, At, B0); PG8_BAR; PG8_SCHED;
            PG8_STAGE(PG8_SB(0, 1), b2 + hstep, voffB);
            PG8_WAIT_V(6); PG8_BAR; PG8_MMA(1, 1, At, B1); PG8_BAR;
            PG8_LDB(B0, 1, 0); PG8_SCHED; PG8_LDA(At, 1, 0); PG8_STAGE(PG8_SA(0, 1), a2 + hstep, voffA);
            PG8_WAIT_L(8); PG8_BAR; PG8_WAIT_L(0); PG8_MMA(0, 0, At, B0); PG8_BAR; PG8_SCHED;
            PG8_LDB(B1, 1, 1); PG8_STAGE(PG8_SB(1, 0), b3, voffB);
            PG8_BAR; PG8_WAIT_L(0); PG8_MMA(0, 1, At, B1); PG8_BAR;
            PG8_LDA(At, 1, 1); PG8_STAGE(PG8_SA(1, 0), a3, voffA);
            PG8_BAR; PG8_WAIT_L(0); PG8_MMA(1, 0, At, B0); PG8_BAR; PG8_SCHED;
            PG8_STAGE(PG8_SB(1, 1), b3 + hstep, voffB);
            PG8_WAIT_V(6); PG8_BAR; PG8_MMA(1, 1, At, B1); PG8_BAR;
            }
        }
        if constexpr (ALIGN_EPI) { if (wr == 0) PG8_BAR; }
        E(acc, cur, wr, wc, fr, fq);
        if (!has_next) break;
        if (!Epi::keep(cur)) {
#pragma unroll
        for (int a = 0; a < 2; ++a)
#pragma unroll
            for (int b = 0; b < 2; ++b)
#pragma unroll
                for (int m = 0; m < 4; ++m)
#pragma unroll
                    for (int n = 0; n < 2; ++n) acc[a][b][m][n] = (f32x4){0.f, 0.f, 0.f, 0.f};
        }
        cur = nxt; cA = nA; cB = nB; ++ui;
        if constexpr (ALIGN_EPI) { if (wr == 1) PG8_BAR; }
    }
    PG8_WAIT_V(0);
    if constexpr (!ALIGN_EPI) { if (wr == 0) PG8_BAR; }
    PG8_BAR;
#undef PG8_SA
#undef PG8_SB
#undef PG8_STAGE
#undef PG8_LDA
#undef PG8_LDB
#undef PG8_MMA
#undef PG8_WAIT_V
#undef PG8_WAIT_L
#undef PG8_BAR
#undef PG8_SCHED
}

struct SegOrder {
    StaticOrder b; int nseg, aM, bN;
    __device__ void init(int M, int N, int G_, int c_, int nseg_) { b.init(M, N, G_, c_); nseg = nseg_; aM = M / BM; bN = N / BM; }
    __device__ bool next(int i, Unit& u) const { if (!b.next(i / nseg, u)) return false; const int s = i % nseg; u.seg = s; u.am = u.pm + s * aM; u.bn = u.pn + s * bN; return true; }
};

constexpr float LOG2E = 1.4426950408889634f;
__device__ __forceinline__ float sigm(float x) { return __builtin_amdgcn_rcpf(1.f + __expf(-x)); }
__device__ __forceinline__ u32x4 pack8(const f32x4 v0, const f32x4 v1) { u32x4 w; w.x = cvt_pk_bf16(v0[0], v0[1]); w.y = cvt_pk_bf16(v0[2], v0[3]); w.z = cvt_pk_bf16(v1[0], v1[1]); w.w = cvt_pk_bf16(v1[2], v1[3]); return w; }
__device__ __forceinline__ void unpack8(const u32x4 w, f32x4& v0, f32x4& v1) {
    v0[0] = __uint_as_float(w.x << 16); v0[1] = __uint_as_float(w.x & 0xffff0000u); v0[2] = __uint_as_float(w.y << 16); v0[3] = __uint_as_float(w.y & 0xffff0000u);
    v1[0] = __uint_as_float(w.z << 16); v1[1] = __uint_as_float(w.z & 0xffff0000u); v1[2] = __uint_as_float(w.w << 16); v1[3] = __uint_as_float(w.w & 0xffff0000u); }

struct EpiPlain {
    static constexpr bool PERM = true; static __device__ __forceinline__ bool keep(const Unit&) { return false; }
    bf16_t* O; int ldc; float sc;
    __device__ __forceinline__ void operator()(f32x4 (&acc)[2][2][4][2], const Unit& u, int wr, int wc, int fr, int fq) const {
        const int row0 = u.pm * BM + wr * 64 + fr, col0 = u.pn * BM + wc * 32 + 8 * fq;
#pragma unroll
        for (int ai = 0; ai < 2; ++ai)
#pragma unroll
            for (int m = 0; m < 4; ++m) { bf16_t* rowp = O + (size_t)(row0 + ai * HALF + m * 16) * ldc + col0;
#pragma unroll
                for (int bj = 0; bj < 2; ++bj) *(u32x4*)(rowp + bj * HALF) = pack8(acc[ai][bj][m][0] * sc, acc[ai][bj][m][1] * sc); }
    }
};
struct EpiSwiglu {
    static constexpr bool PERM = true; static __device__ __forceinline__ bool keep(const Unit&) { return false; }
    bf16_t* H; int ldh;
    __device__ __forceinline__ void operator()(f32x4 (&acc)[2][2][4][2], const Unit& u, int wr, int wc, int fr, int fq) const {
        const int row0 = u.pm * BM + wr * 64 + fr, col0 = u.pn * HALF + wc * 32 + 8 * fq;
#pragma unroll
        for (int ai = 0; ai < 2; ++ai)
#pragma unroll
            for (int m = 0; m < 4; ++m) {
                f32x4 v0, v1;
#pragma unroll
                for (int i = 0; i < 4; ++i) { const float a0 = acc[ai][0][m][0][i], a1 = acc[ai][0][m][1][i];
                    v0[i] = a0 * sigm(a0) * acc[ai][1][m][0][i]; v1[i] = a1 * sigm(a1) * acc[ai][1][m][1][i]; }
                *(u32x4*)(H + (size_t)(row0 + ai * HALF + m * 16) * ldh + col0) = pack8(v0, v1); }
    }
};
struct EpiRes {
    static constexpr bool PERM = false; static __device__ __forceinline__ bool keep(const Unit&) { return false; }
    const float* res; float* out; float alpha, beta;
    __device__ __forceinline__ void operator()(f32x4 (&acc)[2][2][4][2], const Unit& u, int wr, int wc, int fr, int fq) const {
        const int row0 = u.pm * BM + wr * 64 + fr, col0 = u.pn * BM + wc * 32 + 4 * fq;
#pragma unroll
        for (int ai = 0; ai < 2; ++ai)
#pragma unroll
            for (int m = 0; m < 4; ++m) { const size_t off = (size_t)(row0 + ai * HALF + m * 16) * 1024 + col0;
#pragma unroll
                for (int bj = 0; bj < 2; ++bj)
#pragma unroll
                    for (int n = 0; n < 2; ++n) { const f32x4 r = *(const f32x4*)(res + off + bj * HALF + n * 16); *(f32x4*)(out + off + bj * HALF + n * 16) = r * alpha + acc[ai][bj][m][n] * beta; } }
    }
};
struct EpiProj {
    static constexpr bool PERM = true; static __device__ __forceinline__ bool keep(const Unit&) { return false; }
    bf16_t *G, *FQ, *FK, *FV, *MQ, *CQ, *CKV; float* SIDE; const float* bgate;
    __device__ __forceinline__ void operator()(f32x4 (&acc)[2][2][4][2], const Unit& u, int wr, int wc, int fr, int fq) const {
        const int row0 = u.pm * BM + wr * 64 + fr, pn = u.pn;
#pragma unroll
        for (int bj = 0; bj < 2; ++bj) {
            const int col = pn * BM + bj * HALF + wc * 32 + 8 * fq;
            bf16_t* base; int ld, dcol; float sc = 1.f; bool gate = false;
            if (pn < 12) { base = G; ld = 3072; dcol = col; gate = true; }
            else if (pn < 14) { const int c = col - 3072; base = FQ; ld = 768; dcol = (c >> 6) * 96 + (c & 63); sc = 0.125f * LOG2E; }
            else if (pn < 16) { const int c = col - 3584; base = FK; ld = 640; dcol = (c >> 6) * 80 + (c & 63); }
            else if (pn < 18) { base = FV; ld = 512; dcol = col - 4096; }
            else if (pn < 20) { base = MQ; ld = 768; dcol = col - 4608; sc = 0.08838834764831845f * LOG2E; }
            else { const int bc = col - 5120;
                if (bc < 384) { base = CQ; ld = 384; dcol = bc; } else if (bc < 640) { base = CKV; ld = 256; dcol = bc - 384; } else { base = nullptr; ld = 0; dcol = bc; } }
            f32x4 b0 = (f32x4){0.f, 0.f, 0.f, 0.f}, b1 = b0;
            if (gate) { b0 = *(const f32x4*)(bgate + col); b1 = *(const f32x4*)(bgate + col + 4); }
            const bool side = (pn == 22) && (bj == 1) && (wc == 0 || (wc == 1 && fq == 0));
#pragma unroll
            for (int ai = 0; ai < 2; ++ai)
#pragma unroll
                for (int m = 0; m < 4; ++m) { const size_t row = (size_t)(row0 + ai * HALF + m * 16);
                    f32x4 v0 = acc[ai][bj][m][0], v1 = acc[ai][bj][m][1];
                    if (gate) {
#pragma unroll
                        for (int i = 0; i < 4; ++i) { v0[i] = sigm(v0[i] + b0[i]); v1[i] = sigm(v1[i] + b1[i]); } }
                    else { v0 = v0 * sc; v1 = v1 * sc; }
                    if (base) *(u32x4*)(base + row * ld + dcol) = pack8(v0, v1);
                    if (side) { float* sp = SIDE + row * 40 + (dcol - 640); *(f32x4*)sp = v0; *(f32x4*)(sp + 4) = v1; } }
        }
    }
};
struct EpiKvup {
    static constexpr bool PERM = true; static __device__ __forceinline__ bool keep(const Unit&) { return false; }
    bf16_t* KN; bf16_t* VM;
    __device__ __forceinline__ void operator()(f32x4 (&acc)[2][2][4][2], const Unit& u, int wr, int wc, int fr, int fq) const {
        const int row0 = u.pm * BM + wr * 64 + fr; bf16_t* base = ((wc < 2) ? KN : VM) + (2 * u.pn) * 64 + (wc & 1) * 32 + 8 * fq;
#pragma unroll
        for (int ai = 0; ai < 2; ++ai)
#pragma unroll
            for (int m = 0; m < 4; ++m) { bf16_t* rowp = base + (size_t)(row0 + ai * HALF + m * 16) * 512;
#pragma unroll
                for (int bj = 0; bj < 2; ++bj) *(u32x4*)(rowp + bj * 64) = pack8(acc[ai][bj][m][0], acc[ai][bj][m][1]); }
    }
};
struct EpiBranch {
    static constexpr bool PERM = true; static __device__ __forceinline__ bool keep(const Unit& u) { return u.seg < 2; }
    const bf16_t* G; bf16_t* MG;
    __device__ __forceinline__ void operator()(f32x4 (&acc)[2][2][4][2], const Unit& u, int wr, int wc, int fr, int fq) const {
        const int row0 = u.pm * BM + wr * 64 + fr, col0 = u.pn * BM + wc * 32 + 8 * fq, seg = u.seg;
#pragma unroll
        for (int ai = 0; ai < 2; ++ai)
#pragma unroll
            for (int m = 0; m < 4; ++m) { const size_t row = (size_t)(row0 + ai * HALF + m * 16);
#pragma unroll
                for (int bj = 0; bj < 2; ++bj) { const int col = col0 + bj * HALF;
                    f32x4 ga0, ga1; unpack8(*(const u32x4*)(G + row * 3072 + seg * 1024 + col), ga0, ga1);
                    if (seg < 2) { f32x4 gb0, gb1; unpack8(*(const u32x4*)(G + row * 3072 + (seg + 1) * 1024 + col), gb0, gb1);
#pragma unroll
                        for (int i = 0; i < 4; ++i) { acc[ai][bj][m][0][i] *= fmaxf(ga0[i], 1e-30f) / fmaxf(gb0[i], 1e-30f); acc[ai][bj][m][1][i] *= fmaxf(ga1[i], 1e-30f) / fmaxf(gb1[i], 1e-30f); } }
                    else { f32x4 v0, v1;
#pragma unroll
                        for (int i = 0; i < 4; ++i) { v0[i] = acc[ai][bj][m][0][i] * fmaxf(ga0[i], 1e-30f); v1[i] = acc[ai][bj][m][1][i] * fmaxf(ga1[i], 1e-30f); }
                        *(u32x4*)(MG + row * 1024 + col) = pack8(v0, v1); } } }
    }
};
}

namespace att {
using pg8::bf16_t;
typedef short bf16x8 __attribute__((ext_vector_type(8)));
typedef short s16x4 __attribute__((ext_vector_type(4)));
typedef float f32x16 __attribute__((ext_vector_type(16)));
typedef unsigned u32x4 __attribute__((ext_vector_type(4)));
typedef unsigned u32x2 __attribute__((ext_vector_type(2)));
typedef float f32x4 __attribute__((ext_vector_type(4)));
#define ATT_LAS __attribute__((address_space(3)))
struct Args {
    const bf16_t* Q; int qp;
    const bf16_t* KA; int kap;
    const bf16_t* KB; int kbp;
    const bf16_t* V; int vp;
    bf16_t* O; int op;
    const float* RC; const float* RSN;
};
__device__ __forceinline__ unsigned cvtpk(float lo, float hi) { unsigned r; asm volatile("v_cvt_pk_bf16_f32 %0, %1, %2" : "=v"(r) : "v"(lo), "v"(hi)); return r; }
__device__ __forceinline__ s16x4 vtr(const ATT_LAS unsigned char* p) { return __builtin_bit_cast(s16x4, __builtin_amdgcn_ds_read_tr16_b64_v4i16((ATT_LAS s16x4*)p)); }

template <int DKC, int DVB, bool CAUSAL, bool ROPE>
__device__ __forceinline__ void attn_unit(const Args a, long qrow0, long krow0, int q0, int NT, ATT_LAS unsigned char* lds) {
    int tid_ = threadIdx.x; asm volatile("" : "+v"(tid_));
    const int tid = tid_, lane = tid & 63, r32 = lane & 31, hi = lane >> 5;
    const int wid = __builtin_amdgcn_readfirstlane(tid >> 6);
    constexpr int KSLOT = DKC * 2048, VSLOT = DVB * 4096, NKC = 2 * DKC, KL = (NKC + 7) / 8, VL = (DVB * 4 + 7) / 8;
    ATT_LAS unsigned char* Kb = lds; ATT_LAS unsigned char* Vb = lds + 2 * KSLOT;
    bf16x8 qr[DKC];
    { const bf16_t* qrow = a.Q + (size_t)(qrow0 + wid * 32 + r32) * a.qp + hi * 8;
#pragma unroll
      for (int c = 0; c < DKC; ++c) qr[c] = *(const bf16x8*)(qrow + c * 16); }
    if constexpr (ROPE) {
        const size_t trow = (size_t)(qrow0 + wid * 32 + r32) * 16 + 8 * hi;
        const f32x4 c0 = *(const f32x4*)(a.RC + trow), c1 = *(const f32x4*)(a.RC + trow + 4), s0 = *(const f32x4*)(a.RSN + trow), s1 = *(const f32x4*)(a.RSN + trow + 4);
        bf16x8 x1 = qr[4], x2 = qr[5];
#pragma unroll
        for (int j = 0; j < 8; ++j) { const float cc = j < 4 ? c0[j & 3] : c1[j & 3], ss = j < 4 ? s0[j & 3] : s1[j & 3];
            const float a1 = __uint_as_float((unsigned)(unsigned short)x1[j] << 16), a2 = __uint_as_float((unsigned)(unsigned short)x2[j] << 16);
            const float r1 = a1 * cc - a2 * ss, r2 = a2 * cc + a1 * ss;
            x1[j] = (short)(cvtpk(r1, 0.f) & 0xffffu); x2[j] = (short)(cvtpk(r2, 0.f) & 0xffffu); }
        qr[4] = x1; qr[5] = x2;
    }
    u32x4 kreg[KL], vreg[VL];
#define ATT_GLOAD(t) do { const size_t kr_ = (size_t)(krow0 + 64 * (t)); \
    _Pragma("unroll") for (int j = 0; j < KL; ++j) { const int c8 = wid + 8 * j; if (c8 < NKC) { \
        const bf16_t* src = (c8 < 8) ? (a.KA + (kr_ + lane) * a.kap + c8 * 8) : (a.KB + (kr_ + lane) * a.kbp + (c8 - 8) * 8); kreg[j] = *(const u32x4*)src; } } \
    _Pragma("unroll") for (int j = 0; j < VL; ++j) { const int pc = wid + 8 * j; if (pc < DVB * 4) { \
        vreg[j] = *(const u32x4*)(a.V + (kr_ + 16 * (pc & 3) + (lane >> 2)) * a.vp + 32 * (pc >> 2) + (lane & 3) * 8); } } } while (0)
#define ATT_LSTORE(buf) do { \
    _Pragma("unroll") for (int j = 0; j < KL; ++j) { const int c8 = wid + 8 * j; if (c8 < NKC) *(ATT_LAS u32x4*)(Kb + (buf) * KSLOT + c8 * 1024 + lane * 16) = kreg[j]; } \
    _Pragma("unroll") for (int j = 0; j < VL; ++j) { const int pc = wid + 8 * j; if (pc < DVB * 4) *(ATT_LAS u32x4*)(Vb + (buf) * VSLOT + pc * 1024 + lane * 16) = vreg[j]; } } while (0)
    ATT_GLOAD(0); ATT_LSTORE(0);
    __syncthreads();
    f32x16 o[DVB];
#pragma unroll
    for (int d = 0; d < DVB; ++d)
#pragma unroll
        for (int r = 0; r < 16; ++r) o[d][r] = 0.f;
    float mrun = -1e30f, lrun = 0.f;
    const int qpos = q0 + wid * 32 + r32;
    const int koff = hi * 1024 + r32 * 16;
    const int voff = ((lane >> 4) & 1) * 32 + (lane & 3) * 8 + (4 * hi + ((lane & 15) >> 2)) * 64;
    for (int t = 0; t < NT; ++t) {
        const int buf = t & 1;
        if (t + 1 < NT) ATT_GLOAD(t + 1);
        const bool active = !CAUSAL || (64 * t <= q0 + wid * 32 + 31);
        if (active) {
            f32x16 s0, s1;
#pragma unroll
            for (int r = 0; r < 16; ++r) { s0[r] = 0.f; s1[r] = 0.f; }
            const ATT_LAS unsigned char* kp = Kb + buf * KSLOT + koff;
#pragma unroll
            for (int c = 0; c < DKC; ++c) {
                const bf16x8 k0 = *(const ATT_LAS bf16x8*)(kp + c * 2048), k1 = *(const ATT_LAS bf16x8*)(kp + c * 2048 + 512);
                s0 = __builtin_amdgcn_mfma_f32_32x32x16_bf16(k0, qr[c], s0, 0, 0, 0);
                s1 = __builtin_amdgcn_mfma_f32_32x32x16_bf16(k1, qr[c], s1, 0, 0, 0);
            }
            if (CAUSAL && (64 * t + 63 > q0 + wid * 32)) {
                const int kb = 64 * t + 4 * hi;
#pragma unroll
                for (int r = 0; r < 16; ++r) { const int kv = kb + (r & 3) + 8 * (r >> 2); if (kv > qpos) s0[r] = -INFINITY; if (kv + 32 > qpos) s1[r] = -INFINITY; }
            }
            float rm = fmaxf(s0[0], s1[0]);
#pragma unroll
            for (int r = 1; r < 16; ++r) rm = fmaxf(rm, fmaxf(s0[r], s1[r]));
            rm = fmaxf(rm, __shfl_xor(rm, 32));
            const float mn = fmaxf(mrun, rm);
            const float alpha = __builtin_amdgcn_exp2f(mrun - mn);
            mrun = mn;
            float sum = 0.f;
#pragma unroll
            for (int r = 0; r < 16; ++r) { s0[r] = __builtin_amdgcn_exp2f(s0[r] - mn); s1[r] = __builtin_amdgcn_exp2f(s1[r] - mn); sum += s0[r] + s1[r]; }
            lrun = lrun * alpha + sum;
#pragma unroll
            for (int d = 0; d < DVB; ++d)
#pragma unroll
                for (int r = 0; r < 16; ++r) o[d][r] *= alpha;
            u32x4 pw[4];
#pragma unroll
            for (int i = 0; i < 4; ++i) { pw[0][i] = cvtpk(s0[2 * i], s0[2 * i + 1]); pw[1][i] = cvtpk(s0[8 + 2 * i], s0[9 + 2 * i]); pw[2][i] = cvtpk(s1[2 * i], s1[2 * i + 1]); pw[3][i] = cvtpk(s1[8 + 2 * i], s1[9 + 2 * i]); }
            const ATT_LAS unsigned char* vpp = Vb + buf * VSLOT + voff;
#pragma unroll
            for (int d = 0; d < DVB; ++d)
#pragma unroll
                for (int ks = 0; ks < 4; ++ks) {
                    const s16x4 lo = vtr(vpp + d * 4096 + ks * 1024), hh = vtr(vpp + d * 4096 + ks * 1024 + 512);
                    const bf16x8 vf = (bf16x8){lo[0], lo[1], lo[2], lo[3], hh[0], hh[1], hh[2], hh[3]};
                    o[d] = __builtin_amdgcn_mfma_f32_32x32x16_bf16(vf, __builtin_bit_cast(bf16x8, pw[ks]), o[d], 0, 0, 0);
                }
        }
        if (t + 1 < NT) ATT_LSTORE(buf ^ 1);
        __syncthreads();
    }
    lrun += __shfl_xor(lrun, 32);
    const float inv = 1.f / lrun;
    bf16_t* orow = a.O + (size_t)(qrow0 + wid * 32 + r32) * a.op + 4 * hi;
#pragma unroll
    for (int d = 0; d < DVB; ++d)
#pragma unroll
        for (int g = 0; g < 4; ++g) { u32x2 w; w.x = cvtpk(o[d][4 * g] * inv, o[d][4 * g + 1] * inv); w.y = cvtpk(o[d][4 * g + 2] * inv, o[d][4 * g + 3] * inv);
            *(u32x2*)(orow + 32 * d + 8 * g) = w; }
#undef ATT_GLOAD
#undef ATT_LSTORE
}
}

using pg8::bf16_t; using pg8::f32x4; using pg8::u32x4;
#define LAS __attribute__((address_space(3)))
constexpr int NB = 4, S = 8192, T = NB * S, D = 1024, FF = 2816, NPROJ = 5888, NWAVES = 8;
constexpr float ALPHA = 1.189207115002721f;
constexpr size_t MiB = 1u << 20;
constexpr size_t WS_RS = 2 * MiB;
constexpr size_t WS_RC = 3 * MiB;
constexpr size_t WS_RSN = 5 * MiB;
constexpr size_t WS_SIDE = 7 * MiB;
constexpr size_t WS_MEMB = 12 * MiB;
constexpr size_t WS_MEMKV = 14 * MiB;
constexpr size_t WS_WIN = 16 * MiB;
constexpr size_t WS_WUQ = 28 * MiB;
constexpr size_t WS_WUKV = 29 * MiB;
constexpr size_t WS_WMKV = 30 * MiB;
constexpr size_t WS_KR = 32 * MiB;
constexpr size_t WS_XB = 34 * MiB;
constexpr size_t WS_QM = 34 * MiB;
constexpr size_t WS_WBR = 82 * MiB;
constexpr size_t WS_WOUT = 87 * MiB;
constexpr size_t WS_H = 98 * MiB;
constexpr size_t WS_G = 98 * MiB;
constexpr size_t WS_SLOT0 = 290 * MiB;
constexpr size_t WS_FQ = 338 * MiB;
constexpr size_t WS_MQ = 386 * MiB;
constexpr size_t WS_FK = 434 * MiB;
constexpr size_t WS_FV = 474 * MiB;
constexpr size_t WS_KN = 434 * MiB;
constexpr size_t WS_VM = 466 * MiB;
constexpr size_t WS_MG = 434 * MiB;
constexpr size_t WS_WA = 480 * MiB;
constexpr size_t WS_WD = 491 * MiB;
constexpr size_t WS_END = 512 * MiB;
static_assert(WS_FV + (size_t)T * 512 * 2 <= WS_END && WS_WD + (size_t)1024 * 2816 * 2 <= WS_END && WS_FQ - WS_SLOT0 == (size_t)T * 768 * 2 && WS_MQ - WS_FQ == (size_t)T * 768 * 2, "ws map");
constexpr int LDS_BYTES = 147456;

__device__ __forceinline__ unsigned f2bf(float f) { unsigned u = __builtin_bit_cast(unsigned, f); return (u + 0x7fffu + ((u >> 16) & 1u)) >> 16; }
__device__ __forceinline__ unsigned pk2(float lo, float hi) { return f2bf(lo) | (f2bf(hi) << 16); }
__device__ __forceinline__ float bf2f(unsigned b) { return __uint_as_float(b << 16); }
__device__ __forceinline__ float wave_sum(float v) {
#pragma unroll
    for (int o = 1; o < 64; o <<= 1) v += __shfl_xor(v, o);
    return v;
}
#define LDS_WAIT() asm volatile("s_waitcnt lgkmcnt(0)" ::: "memory")

__device__ __forceinline__ int map_ffn(int c) { return c < FF ? ((c >> 7) << 8) + (c & 127) : (((c - FF) >> 7) << 8) + 128 + ((c - FF) & 127); }
__device__ __forceinline__ int map_win(int c) {
    if (c < 384) return 5120 + c;
    if (c < 640) return 5504 + (c - 384);
    if (c < 672) return 5760 + (c - 640);
    if (c < 1184) return 3072 + (c - 672);
    if (c < 1696) return 3584 + (c - 1184);
    if (c < 2208) return 4096 + (c - 1696);
    if (c < 2216) return 5792 + (c - 2208);
    if (c < 2728) return 4608 + (c - 2216);
    return c - 2728;
}
template <int MODE>
__device__ __forceinline__ void tr_mat(const float* __restrict__ W, int K, int N, const float* __restrict__ ks, bf16_t* WT, int ldt, int kmul, LAS float* scr, int gw, int NGW, int lane) {
    const int nblk = (N + 31) / 32, items = (K / 64) * nblk;
    for (int it = gw; it < items; it += NGW) {
        const int kb = it / nblk, nb = it % nblk, k0 = 64 * kb, n0 = 32 * nb;
        const int nn = n0 + (lane & 31); const bool ok = nn < N;
#pragma unroll 8
        for (int i = 0; i < 32; ++i) { const int kk = 2 * i + (lane >> 5); float v = ok ? W[(size_t)(k0 + kk) * N + nn] : 0.f; if (ks) v *= ks[k0 + kk]; scr[kk * 33 + (lane & 31)] = v; }
        LDS_WAIT(); asm volatile("" ::: "memory");
        const int c = lane & 7, dc = kb * kmul + 8 * c;
#pragma unroll
        for (int j = 0; j < 4; ++j) { const int n = (lane >> 3) + 8 * j, sc = n0 + n;
            if (sc < N) { const LAS float* s = scr + (8 * c) * 33 + n;
                u32x4 o; o.x = pk2(s[0 * 33], s[1 * 33]); o.y = pk2(s[2 * 33], s[3 * 33]); o.z = pk2(s[4 * 33], s[5 * 33]); o.w = pk2(s[6 * 33], s[7 * 33]);
                const int dr = MODE == 1 ? map_ffn(sc) : (MODE == 2 ? map_win(sc) : sc);
                *(u32x4*)(WT + (size_t)dr * ldt + dc) = o; } }
        LDS_WAIT(); asm volatile("" ::: "memory");
    }
}
__device__ __forceinline__ void cvt_copy(const float* __restrict__ src, bf16_t* dst, size_t n, size_t gt, size_t NTH) {
    for (size_t i = gt * 8; i < n; i += NTH * 8) { const f32x4 a = *(const f32x4*)(src + i), b = *(const f32x4*)(src + i + 4);
        u32x4 o; o.x = pk2(a[0], a[1]); o.y = pk2(a[2], a[3]); o.z = pk2(b[0], b[1]); o.w = pk2(b[2], b[3]); *(u32x4*)(dst + i) = o; }
}
__device__ __forceinline__ void ln_row(const float* xrow, const float* __restrict__ g, const float* __restrict__ b, float* outf, bf16_t* outb, int lane) {
    f32x4 v[4]; float s = 0.f;
#pragma unroll
    for (int j = 0; j < 4; ++j) { v[j] = *(const f32x4*)(xrow + 4 * lane + 256 * j); s += (v[j][0] + v[j][1]) + (v[j][2] + v[j][3]); }
    const float mean = wave_sum(s) * (1.f / D); float s2 = 0.f;
#pragma unroll
    for (int j = 0; j < 4; ++j) { v[j] = v[j] - mean; s2 += (v[j][0] * v[j][0] + v[j][1] * v[j][1]) + (v[j][2] * v[j][2] + v[j][3] * v[j][3]); }
    const float rstd = 1.f / sqrtf(wave_sum(s2) * (1.f / D) + 1e-5f);
#pragma unroll
    for (int j = 0; j < 4; ++j) { const f32x4 gg = *(const f32x4*)(g + 4 * lane + 256 * j), bb = *(const f32x4*)(b + 4 * lane + 256 * j);
        const f32x4 y = v[j] * rstd * gg + bb;
        if (outf) *(f32x4*)(outf + 4 * lane + 256 * j) = y;
        if (outb) { unsigned long long w = (unsigned long long)pk2(y[0], y[1]) | ((unsigned long long)pk2(y[2], y[3]) << 32); *(unsigned long long*)(outb + 4 * lane + 256 * j) = w; } }
}

#define XB_TMO      128
#define XB_XCNT(j)  (256  + 64 * (j))
#define XB_XSUB(j)  (1280 + 64 * (j))
#define XB_XGEN(j)  (2304 + 64 * (j))
#define XB_TOP      3328
#define XB_TOPGEN   3392
#define XCD_BAR_WORDS 3456
#define XB_SPIN_CAP (1u << 18)

__device__ __forceinline__ unsigned xb_ld(unsigned* p)              { return __hip_atomic_load(p, __ATOMIC_RELAXED, __HIP_MEMORY_SCOPE_AGENT); }
__device__ __forceinline__ unsigned xb_add(unsigned* p, unsigned v) { return __hip_atomic_fetch_add(p, v, __ATOMIC_RELAXED, __HIP_MEMORY_SCOPE_AGENT); }
__device__ __forceinline__ unsigned xb_xcc_id() { return (unsigned)__builtin_amdgcn_s_getreg((3 << 11) | 20) & 0xFu; }
#define XB_SPIN(cond, bar) do { unsigned _sp = 0; while (cond) { __builtin_amdgcn_s_sleep(1); \
    if ((++_sp & 255u) == 0u) { if (xb_ld(&(bar)[XB_TMO])) break; if (_sp > XB_SPIN_CAP) { atomicAdd(&(bar)[XB_TMO], 1u); break; } } } } while (0)

struct XcdBarrier {
    unsigned* bar; unsigned x;
    volatile LAS unsigned* st;
};

__device__ __forceinline__ XcdBarrier xcd_barrier_post(unsigned* bar, volatile LAS unsigned* st) {
    XcdBarrier b; b.bar = bar; b.x = xb_xcc_id(); b.st = st;
    if (threadIdx.x == 0) (void)xb_add(&bar[XB_XCNT(b.x)], 1u);
    return b;
}
__device__ __forceinline__ void xcd_barrier_complete(unsigned* bar, unsigned x, unsigned& nloc, unsigned& nx) {
    const unsigned G = gridDim.x * gridDim.y * gridDim.z;
    unsigned sum, cnt, mine, sp = 0u;
    for (;;) {
        sum = 0u; cnt = 0u; mine = 0u;
#pragma unroll
        for (unsigned j = 0; j < 16; ++j) { const unsigned c = xb_ld(&bar[XB_XCNT(j)]); sum += c; cnt += (c > 0u) ? 1u : 0u; mine = (j == x) ? c : mine; }
        if (sum == G) break;
        __builtin_amdgcn_s_sleep(1);
        if ((++sp & 255u) == 0u) { if (xb_ld(&bar[XB_TMO])) break; if (sp > XB_SPIN_CAP) { atomicAdd(&bar[XB_TMO], 1u); break; } }
    }
    nloc = mine > 0u ? mine : 1u; nx = cnt > 0u ? cnt : 1u;
}

__device__ __forceinline__ void xcd_barrier(const XcdBarrier& b) {
    asm volatile("s_waitcnt vmcnt(0)" ::: "memory");
    __syncthreads();
    if (threadIdx.x == 0) {
        unsigned* bar = b.bar;
        __builtin_amdgcn_s_waitcnt(0);
        unsigned nloc = b.st[0], nx = b.st[1];
        if (nloc == 0u) { xcd_barrier_complete(bar, b.x, nloc, nx); b.st[0] = nloc; b.st[1] = nx; }
        const unsigned old = xb_add(&bar[XB_XSUB(b.x)], 1u);
        const unsigned gen = old / nloc;
        if (old + 1u == (gen + 1u) * nloc) {
            __builtin_amdgcn_fence(__ATOMIC_RELEASE, "agent");
            asm volatile("s_waitcnt vmcnt(0)" ::: "memory");
            const unsigned og = xb_add(&bar[XB_TOP], 1u);
            const unsigned tg = og / nx;
            if (og + 1u == (tg + 1u) * nx) xb_add(&bar[XB_TOPGEN], 1u);
            else XB_SPIN(xb_ld(&bar[XB_TOPGEN]) == tg, bar);
            __builtin_amdgcn_fence(__ATOMIC_ACQUIRE, "agent");
            xb_add(&bar[XB_XGEN(b.x)], 1u);
            asm volatile("s_waitcnt vmcnt(0)" ::: "memory");
        } else {
            XB_SPIN(xb_ld(&bar[XB_XGEN(b.x)]) == gen, bar);
            __builtin_amdgcn_fence(__ATOMIC_ACQUIRE, "agent");
            asm volatile("s_waitcnt vmcnt(0)" ::: "memory");
        }
    }
    __syncthreads();
}

#ifndef PH_MASK
#define PH_MASK 0xFFFF
#endif
struct Params { const float* in[25]; float* out; unsigned char* ws; };

__global__ void __launch_bounds__(NWAVES * 64) mega_fwd(Params p) {
    extern __shared__ __attribute__((aligned(16))) unsigned char lds_raw[];
    cg::grid_group grid = cg::this_grid();
    LAS unsigned char* lds = (LAS unsigned char*)lds_raw;
    const int tid = threadIdx.x, lane = tid & 63, wave = __builtin_amdgcn_readfirstlane(tid >> 6);
    const int G = gridDim.x, bx = blockIdx.x;
    const int gw = bx * NWAVES + wave, NGW = G * NWAVES;
    const size_t gt = (size_t)bx * (NWAVES * 64) + tid, NTH = (size_t)G * (NWAVES * 64);
    unsigned char* ws = p.ws;
    const float* x = p.in[0]; const float* mem = p.in[1]; const int* positions = (const int*)p.in[2];
    float* R = p.out;
    float* RS = (float*)(ws + WS_RS); float* RC = (float*)(ws + WS_RC); float* RSN = (float*)(ws + WS_RSN); float* SIDE = (float*)(ws + WS_SIDE);
    bf16_t* MEMB = (bf16_t*)(ws + WS_MEMB); bf16_t* MEMKV = (bf16_t*)(ws + WS_MEMKV);
    bf16_t* WIN = (bf16_t*)(ws + WS_WIN); bf16_t* WUQ = (bf16_t*)(ws + WS_WUQ); bf16_t* WUKV = (bf16_t*)(ws + WS_WUKV); bf16_t* WMKV = (bf16_t*)(ws + WS_WMKV);
    bf16_t* KR = (bf16_t*)(ws + WS_KR); bf16_t* XB = (bf16_t*)(ws + WS_XB); bf16_t* QM = (bf16_t*)(ws + WS_QM); bf16_t* WBR = (bf16_t*)(ws + WS_WBR); bf16_t* WOUT = (bf16_t*)(ws + WS_WOUT);
    bf16_t* HB = (bf16_t*)(ws + WS_H); bf16_t* GB = (bf16_t*)(ws + WS_G); bf16_t* SLOT0 = (bf16_t*)(ws + WS_SLOT0); bf16_t* CQ = SLOT0; bf16_t* CKV = SLOT0 + (size_t)T * 384; bf16_t* FQ = (bf16_t*)(ws + WS_FQ); bf16_t* MQ = (bf16_t*)(ws + WS_MQ);
    bf16_t* FK = (bf16_t*)(ws + WS_FK); bf16_t* FV = (bf16_t*)(ws + WS_FV); bf16_t* KN = (bf16_t*)(ws + WS_KN); bf16_t* VM = (bf16_t*)(ws + WS_VM); bf16_t* MG = (bf16_t*)(ws + WS_MG);
    bf16_t* WA = (bf16_t*)(ws + WS_WA); bf16_t* WD = (bf16_t*)(ws + WS_WD);
    LAS float* scr = (LAS float*)(lds + wave * 16384);
    volatile LAS unsigned* MISC = (volatile LAS unsigned*)(lds + 131072 + 256);
    if (tid < 2) MISC[tid] = 0u;
    unsigned* barw = (unsigned*)ws;
    if (bx == 0) for (int i = tid; i < XCD_BAR_WORDS; i += NWAVES * 64) barw[i] = 0u;

#if (PH_MASK >> 0) & 1
    tr_mat<1>(p.in[5], D, 2 * FF, nullptr, WA, D, 64, scr, gw, NGW, lane);
    tr_mat<0>(p.in[6], FF, D, nullptr, WD, FF, 64, scr, gw, NGW, lane);
    tr_mat<2>(p.in[7], D, 5800, nullptr, WIN, D, 64, scr, gw, NGW, lane);
    tr_mat<0>(p.in[10], 384, 768, p.in[9], WUQ, 384, 64, scr, gw, NGW, lane);
    tr_mat<0>(p.in[12], 256, 1024, p.in[11], WUKV, 256, 64, scr, gw, NGW, lane);
    tr_mat<0>(p.in[14], D, 1024, nullptr, WMKV, D, 64, scr, gw, NGW, lane);
    for (size_t i = gt * 8; i < (size_t)88 * D; i += NTH * 8) *(u32x4*)(WIN + (size_t)5800 * D + i) = (u32x4){0u, 0u, 0u, 0u};
    cvt_copy(x, XB, (size_t)T * D, gt, NTH);
    cvt_copy(mem, MEMB, (size_t)NB * 256 * D, gt, NTH);
    for (size_t i = gt; i < (size_t)T * 16; i += NTH) {
        const int row = (int)(i >> 4), f = (int)(i & 15);
        const float invf = (float)exp2(-(double)f * (13.287712379549449 / 16.0));
        const float ang = (float)positions[row] * invf;
        const double rev = (double)ang * 0.15915494309189535; const float fr = (float)(rev - __builtin_rint(rev));
        RC[i] = __builtin_amdgcn_cosf(fr); RSN[i] = __builtin_amdgcn_sinf(fr);
    }
#endif
    grid.sync();
    const XcdBarrier xb = xcd_barrier_post(barw, MISC);

#if (PH_MASK >> 1) & 1
    { pg8::Gemm g{XB, WA, T, 2 * FF, D}; pg8::StaticOrder so; so.init(T, 2 * FF, G, bx);
      pg8::EpiSwiglu E{HB, FF}; pg8::gemm_phase<pg8::EpiSwiglu, pg8::StaticOrder, true>(lds, g, so, E); }
#endif
    xcd_barrier(xb);
#if (PH_MASK >> 2) & 1
    { pg8::Gemm g{HB, WD, T, D, FF}; pg8::StaticOrder so; so.init(T, D, G, bx);
      pg8::EpiRes E{x, R, ALPHA, 0.5f}; pg8::gemm_phase<pg8::EpiRes, pg8::StaticOrder, true>(lds, g, so, E); }
#endif
    xcd_barrier(xb);
#if (PH_MASK >> 3) & 1
    for (int m = gw; m < T; m += NGW) ln_row(R + (size_t)m * D, p.in[3], p.in[4], R + (size_t)m * D, XB + (size_t)m * D, lane);
    { pg8::Gemm g{MEMB, WMKV, NB * 256, 1024, D}; pg8::StaticOrder so; so.init(NB * 256, 1024, G, (bx + 128) % G);
      pg8::EpiPlain E{MEMKV, 1024, 1.f}; pg8::gemm_phase<pg8::EpiPlain, pg8::StaticOrder, true>(lds, g, so, E); }
#endif
    xcd_barrier(xb);
#if (PH_MASK >> 4) & 1
    { pg8::Gemm g{XB, WIN, T, NPROJ, D}; pg8::StaticOrder so; so.init(T, NPROJ, G, bx);
      pg8::EpiProj E{GB, FQ, FK, FV, MQ, CQ, CKV, SIDE, p.in[8]}; pg8::gemm_phase<pg8::EpiProj, pg8::StaticOrder, true>(lds, g, so, E); }
#endif
    xcd_barrier(xb);
#if (PH_MASK >> 5) & 1
    if (bx < 32) {
        const int b = bx >> 3, h = bx & 7; LAS double* sh = (LAS double*)lds;
        const float bfh = p.in[13][h]; float lf[16]; double loc = 0.0;
#pragma unroll
        for (int j = 0; j < 16; ++j) { const float xx = SIDE[((size_t)b * S + 16 * tid + j) * 40 + 32 + h] + bfh; lf[j] = fminf(xx, 0.f) - log1pf(__expf(-fabsf(xx))); loc += (double)lf[j]; }
        sh[tid] = loc; __syncthreads();
        double run = 0.0; for (int j = 0; j < tid; ++j) run += sh[j];
#pragma unroll
        for (int j = 0; j < 16; ++j) { run += (double)lf[j];
            const float f2 = (float)(run * 1.4426950408889634);
            const unsigned h1 = f2bf(f2); const float r1 = f2 - bf2f(h1); const unsigned h2 = f2bf(r1); const float r2 = r1 - bf2f(h2); const unsigned h3 = f2bf(r2);
            const size_t row = (size_t)b * S + 16 * tid + j; const unsigned one = 0x3f80u, z = 0u;
            u32x4* qd = (u32x4*)(FQ + row * 768 + h * 96 + 64);
            qd[0] = (u32x4){one | (one << 16), one | (h1 << 16), h2 | (h3 << 16), z}; qd[1] = (u32x4){z, z, z, z}; qd[2] = (u32x4){z, z, z, z}; qd[3] = (u32x4){z, z, z, z};
            u32x4* kd = (u32x4*)(FK + row * 640 + h * 80 + 64);
            const unsigned n1 = h1 ^ 0x8000u, n2 = h2 ^ 0x8000u, n3 = h3 ^ 0x8000u;
            kd[0] = (u32x4){n1 | (n2 << 16), n3 | (one << 16), one | (one << 16), z}; kd[1] = (u32x4){z, z, z, z}; }
        __syncthreads();
    }
    for (int m = gw; m < T; m += NGW) {
        f32x4 a0, a1, c0, c1; float sq = 0.f, sq2 = 0.f;
        if (lane < 48) { pg8::unpack8(*(const u32x4*)(CQ + (size_t)m * 384 + lane * 8), a0, a1);
#pragma unroll
            for (int i = 0; i < 4; ++i) sq += a0[i] * a0[i] + a1[i] * a1[i]; }
        if (lane < 32) { pg8::unpack8(*(const u32x4*)(CKV + (size_t)m * 256 + lane * 8), c0, c1);
#pragma unroll
            for (int i = 0; i < 4; ++i) sq2 += c0[i] * c0[i] + c1[i] * c1[i]; }
        const float rq = 1.f / sqrtf(wave_sum(sq) * (1.f / 384.f) + 1e-6f), rkv = 1.f / sqrtf(wave_sum(sq2) * (1.f / 256.f) + 1e-6f);
        if (lane < 48) *(u32x4*)(CQ + (size_t)m * 384 + lane * 8) = pg8::pack8(a0 * rq, a1 * rq);
        if (lane < 32) *(u32x4*)(CKV + (size_t)m * 256 + lane * 8) = pg8::pack8(c0 * rkv, c1 * rkv);
        if (lane < 16) { const float x1 = SIDE[(size_t)m * 40 + lane], x2 = SIDE[(size_t)m * 40 + 16 + lane], c = RC[(size_t)m * 16 + lane], s = RSN[(size_t)m * 16 + lane];
            KR[(size_t)m * 32 + lane] = (bf16_t)f2bf(x1 * c - x2 * s); KR[(size_t)m * 32 + 16 + lane] = (bf16_t)f2bf(x2 * c + x1 * s); }
        if (lane < 32) *(u32x4*)(MQ + (size_t)m * 768 + 512 + lane * 8) = (u32x4){0u, 0u, 0u, 0u};
    }
    tr_mat<0>(p.in[15], 512, D, nullptr, WBR, 768, 96, scr, gw, NGW, lane);
    tr_mat<0>(p.in[16], 512, D, nullptr, WBR + (size_t)1024 * 768, 768, 96, scr, gw, NGW, lane);
    tr_mat<0>(p.in[17], 512, D, nullptr, WBR + (size_t)2048 * 768, 768, 64, scr, gw, NGW, lane);
    tr_mat<0>(p.in[18], D, D, nullptr, WOUT, D, 64, scr, gw, NGW, lane);
    for (size_t i = gt; i < (size_t)3 * 1024 * 32; i += NTH) {
        const int r = (int)(i >> 5), c = (int)(i & 31); bf16_t* rowp = WBR + (size_t)r * 768;
        const int col = (r < 2048) ? ((c >> 2) * 96 + 64 + (c & 3) * 8) : (512 + c * 8);
        *(u32x4*)(rowp + col) = (u32x4){0u, 0u, 0u, 0u};
    }
    __syncthreads();
    for (int u = bx; u < NB * 4 * 32; u += G) {
        const int b = u >> 7, hm = (u >> 5) & 3, qb = u & 31;
        att::Args a{MQ + hm * 128, 768, MEMKV + hm * 128, 1024, MEMKV + hm * 128 + 64, 1024, MEMKV + 512 + hm * 128, 1024, MQ + hm * 128, 768, nullptr, nullptr};
        att::attn_unit<8, 4, false, false>(a, (long)b * S + qb * 256, (long)b * 256, 0, 4, lds);
    }
#endif
    xcd_barrier(xb);
#if (PH_MASK >> 6) & 1
    for (int u = bx; u < 1024; u += G) {
        const int v = u & 255, i = u >> 8, vcu = (v & 7) * 32 + (v >> 3), bh = vcu >> 3, s = vcu & 7;
        const int qb = (i == 0) ? s : (i == 1) ? 15 - s : (i == 2) ? 16 + s : 31 - s; const int b = bh >> 3, h = bh & 7;
        att::Args a{FQ + h * 96, 768, FK + h * 80, 640, FK + h * 80 + 64, 640, FV + h * 64, 512, FQ + h * 96, 768, nullptr, nullptr};
        att::attn_unit<5, 2, true, false>(a, (long)b * S + qb * 256, (long)b * S, qb * 256, 4 * (qb + 1), lds);
    }
#endif
    xcd_barrier(xb);
#if (PH_MASK >> 7) & 1
    { pg8::Gemm g{CQ, WUQ, T, 768, 384}; pg8::StaticOrder so; so.init(T, 768, G, bx);
      pg8::EpiPlain E{QM, 768, 0.10206207261596577f * pg8::LOG2E}; pg8::gemm_phase<pg8::EpiPlain, pg8::StaticOrder, true>(lds, g, so, E); }
    { pg8::Gemm g{CKV, WUKV, T, 1024, 256}; pg8::StaticOrder so; so.init(T, 1024, G, bx);
      pg8::EpiKvup E{KN, VM}; pg8::gemm_phase<pg8::EpiKvup, pg8::StaticOrder, true>(lds, g, so, E); }
#endif
    xcd_barrier(xb);
#if (PH_MASK >> 8) & 1
    for (int u = bx; u < 1024; u += G) {
        const int v = u & 255, i = u >> 8, vcu = (v & 7) * 32 + (v >> 3), bh = vcu >> 3, s = vcu & 7;
        const int qb = (i == 0) ? s : (i == 1) ? 15 - s : (i == 2) ? 16 + s : 31 - s; const int b = bh >> 3, h = bh & 7;
        att::Args a{QM + h * 96, 768, KN + h * 64, 512, KR, 32, VM + h * 64, 512, SLOT0 + h * 96, 768, RC, RSN};
        att::attn_unit<6, 2, true, true>(a, (long)b * S + qb * 256, (long)b * S, qb * 256, 4 * (qb + 1), lds);
    }
#endif
    xcd_barrier(xb);
#if (PH_MASK >> 9) & 1
    { pg8::Gemm g{SLOT0, WBR, T, D, 768}; pg8::SegOrder so; so.init(T, D, G, bx, 3);
      pg8::EpiBranch E{GB, MG}; pg8::gemm_phase<pg8::EpiBranch, pg8::SegOrder, true>(lds, g, so, E); }
#endif
    xcd_barrier(xb);
#if (PH_MASK >> 10) & 1
    { pg8::Gemm g{MG, WOUT, T, D, D}; pg8::StaticOrder so; so.init(T, D, G, bx);
      pg8::EpiRes E{R, R, ALPHA, 1.f}; pg8::gemm_phase<pg8::EpiRes, pg8::StaticOrder, true>(lds, g, so, E); }
#endif
    xcd_barrier(xb);
#if (PH_MASK >> 11) & 1
    for (int m = gw; m < T; m += NGW) ln_row(R + (size_t)m * D, p.in[19], p.in[20], R + (size_t)m * D, XB + (size_t)m * D, lane);
    tr_mat<1>(p.in[21], D, 2 * FF, nullptr, WA, D, 64, scr, gw, NGW, lane);
    tr_mat<0>(p.in[22], FF, D, nullptr, WD, FF, 64, scr, gw, NGW, lane);
#endif
    xcd_barrier(xb);
#if (PH_MASK >> 12) & 1
    { pg8::Gemm g{XB, WA, T, 2 * FF, D}; pg8::StaticOrder so; so.init(T, 2 * FF, G, bx);
      pg8::EpiSwiglu E{HB, FF}; pg8::gemm_phase<pg8::EpiSwiglu, pg8::StaticOrder, true>(lds, g, so, E); }
#endif
    xcd_barrier(xb);
#if (PH_MASK >> 13) & 1
    { pg8::Gemm g{HB, WD, T, D, FF}; pg8::StaticOrder so; so.init(T, D, G, bx);
      pg8::EpiRes E{R, R, ALPHA, 0.5f}; pg8::gemm_phase<pg8::EpiRes, pg8::StaticOrder, true>(lds, g, so, E); }
#endif
    xcd_barrier(xb);
#if (PH_MASK >> 14) & 1
    for (int m = gw; m < T; m += NGW) ln_row(R + (size_t)m * D, p.in[23], p.in[24], R + (size_t)m * D, nullptr, lane);
#endif
}

extern "C" void kernel_launch(void* const* d_in, const int* in_sizes, int n_in, void* d_out, int out_size, void* d_ws, size_t ws_size, hipStream_t stream) {
    static int grid = 0;
    if (grid == 0) {
        if (n_in != 25 || out_size != T * D || ws_size < WS_END) { fprintf(stderr, "kernel_launch: unexpected shapes (n_in %d out %d ws %zu)\n", n_in, out_size, ws_size); grid = -1; return; }
        int dev = 0, cus = 0, per = 0;
        (void)hipGetDevice(&dev); (void)hipDeviceGetAttribute(&cus, hipDeviceAttributeMultiprocessorCount, dev);
        (void)hipFuncSetAttribute((const void*)mega_fwd, hipFuncAttributeMaxDynamicSharedMemorySize, LDS_BYTES);
        (void)hipOccupancyMaxActiveBlocksPerMultiprocessor(&per, (const void*)mega_fwd, NWAVES * 64, LDS_BYTES);
        if (per < 1) per = 1;
        grid = cus * per;
        fprintf(stderr, "kernel_launch: grid %d (cus %d x %d), ws %zu\n", grid, cus, per, ws_size);
    }
    if (grid < 0) return;
    Params p{};
    for (int i = 0; i < 25; ++i) p.in[i] = (const float*)d_in[i];
    p.out = (float*)d_out; p.ws = (unsigned char*)d_ws;
    void* args[] = {&p};
    const hipError_t e = hipLaunchCooperativeKernel((const void*)mega_fwd, dim3(grid), dim3(NWAVES * 64), args, LDS_BYTES, stream);
    if (e != hipSuccess) fprintf(stderr, "kernel_launch: cooperative launch failed: %s (grid %d)\n", hipGetErrorString(e), grid);
}
```

```cpp
#include <hip/hip_runtime.h>
#include <hip/hip_cooperative_groups.h>
#include <cstdio>
#include <cstdint>
#include <cmath>
namespace cg = cooperative_groups;
namespace pg8 {
#define PG8_LAS __attribute__((address_space(3)))
typedef unsigned short bf16_t;
typedef short bf16x8 __attribute__((ext_vector_type(8)));
typedef float f32x4 __attribute__((ext_vector_type(4)));
typedef unsigned u32x4 __attribute__((ext_vector_type(4)));
constexpr int BM = 256, BK = 64, HALF = 128, HTB = HALF * BK * 2  , STAGE_BYTES = 8 * HTB, NXCD = 8, WGM = 8;

__host__ __device__ __forceinline__ int lds_byte(int r, int c) { const int st = (r >> 4) * 2 + (c >> 5), rr = r & 15, cc = c & 31, ob = rr * 64 + cc * 2; return st * 1024 + (ob ^ (((ob >> 9) & 1) << 5)); }
__host__ __device__ __forceinline__ void stage_rc(int b, int& R, int& C) { const int st = b / 1024, sb = b % 1024, swz = sb ^ (((sb >> 9) & 1) << 5); R = (st >> 1) * 16 + swz / 64; C = (st & 1) * 32 + (swz % 64) / 2; }
__host__ __device__ __forceinline__ int perm32(int rho) { const int n = rho >> 4, i = rho & 15; return 8 * (i >> 2) + 4 * n + (i & 3); }

struct Unit { int pm, pn, am, bn, seg; };
struct Gemm { const bf16_t* A; const bf16_t* Bt; int M, N, K; };

struct StaticOrder {
    int nM, nN, nwg, G, c;
    __host__ __device__ void init(int M, int N, int G_, int c_) { nM = M / BM; nN = N / BM; nwg = nM * nN; G = G_; c = c_; }
    __host__ __device__ bool next(int i, Unit& u) const {
        const long L = (long)i * G + c; if (L >= nwg) return false;
        int wgid = (int)L; { const int q = nwg / NXCD, r = nwg % NXCD, xcd = wgid % NXCD, off = wgid / NXCD; wgid = (xcd < r ? xcd * (q + 1) : r * (q + 1) + (xcd - r) * q) + off; }
        const int nig = WGM * nN, gid = wgid / nig, fm = gid * WGM, gsz = (nM - fm) < WGM ? (nM - fm) : WGM;
        u.pm = fm + ((wgid % nig) % gsz); u.pn = (wgid % nig) / gsz; u.am = u.pm; u.bn = u.pn; u.seg = 0; return true;
    }
};

__device__ __forceinline__ unsigned cvt_pk_bf16(float lo, float hi) { unsigned r; asm volatile("v_cvt_pk_bf16_f32 %0, %1, %2" : "=v"(r) : "v"(lo), "v"(hi)); return r; }
typedef float f32x2 __attribute__((ext_vector_type(2)));
template <class Epi, class Sched, bool ALIGN_EPI = false, bool SP2 = true>
__device__ __forceinline__ void gemm_phase(PG8_LAS unsigned char* lds, const Gemm g, const Sched& S, const Epi& E) {
    int tid_ = threadIdx.x; asm volatile("" : "+v"(tid_));
    const int tid = tid_, wid = __builtin_amdgcn_readfirstlane(tid >> 6), lane = tid & 63, wr = wid >> 2, wc = wid & 3, fr = lane & 15, fq = lane >> 4;
    const int K = g.K, nt = K / BK;
    unsigned voffA[2], voffB[2];
#pragma unroll
    for (int i = 0; i < 2; ++i) { int R, C; stage_rc(tid * 16 + i * 8192, R, C); const int Rb = Epi::PERM ? ((R & ~31) + perm32(R & 31)) : R;
        voffA[i] = (unsigned)(R * K + C) * 2u; voffB[i] = (unsigned)(Rb * K + C) * 2u; }
    const size_t kstep = (size_t)(BK * 2);
    const size_t hstep = (size_t)HALF * K * 2;
    const size_t tstep = 2 * hstep;
    const unsigned ldsw = (unsigned)wid * 1024u;
    const int aoff = lds_byte(wr * 64 + fr, fq * 8), boff = lds_byte(wc * 32 + fr, fq * 8);
#define PG8_SA(b, h) (((b) * 2 + (h)) * HTB)
#define PG8_SB(b, h) ((4 + (b) * 2 + (h)) * HTB)
#define PG8_STAGE(bufoff, gbase, voff) do { _Pragma("unroll") for (int _i = 0; _i < 2; ++_i) \
        __builtin_amdgcn_global_load_lds((const unsigned*)((const char*)(gbase) + (voff)[_i]), (PG8_LAS unsigned*)(lds + (bufoff) + ldsw + _i * 8192), 16, 0, 0); } while (0)
#define PG8_LDA(dst, b, h) do { _Pragma("unroll") for (int m = 0; m < 4; ++m) _Pragma("unroll") for (int k = 0; k < 2; ++k) dst[m][k] = *(const PG8_LAS bf16x8*)(lds + PG8_SA(b, h) + aoff + m * 2048 + k * 1024); } while (0)
#define PG8_LDB(dst, b, h) do { _Pragma("unroll") for (int n = 0; n < 2; ++n) _Pragma("unroll") for (int k = 0; k < 2; ++k) dst[n][k] = *(const PG8_LAS bf16x8*)(lds + PG8_SB(b, h) + boff + n * 2048 + k * 1024); } while (0)
#define PG8_MMA(ai, bj, At, Bt) do { __builtin_amdgcn_s_setprio(1); _Pragma("unroll") for (int m = 0; m < 4; ++m) _Pragma("unroll") for (int n = 0; n < 2; ++n) _Pragma("unroll") for (int k = 0; k < 2; ++k) \
        acc[ai][bj][m][n] = __builtin_amdgcn_mfma_f32_16x16x32_bf16(Bt[n][k], At[m][k], acc[ai][bj][m][n], 0, 0, 0); __builtin_amdgcn_s_setprio(0); } while (0)
#define PG8_WAIT_V(n) asm volatile("s_waitcnt vmcnt(" #n ")" ::: "memory")
#define PG8_WAIT_L(n) asm volatile("s_waitcnt lgkmcnt(" #n ")" ::: "memory")
#define PG8_BAR __builtin_amdgcn_s_barrier()
#define PG8_SCHED __builtin_amdgcn_sched_barrier(0)
    Unit cur, nxt; int ui = 0;
    if (!S.next(0, cur)) return;
    f32x4 acc[2][2][4][2];
#pragma unroll
    for (int a = 0; a < 2; ++a)
#pragma unroll
        for (int b = 0; b < 2; ++b)
#pragma unroll
            for (int m = 0; m < 4; ++m)
#pragma unroll
                for (int n = 0; n < 2; ++n) acc[a][b][m][n] = (f32x4){0.f, 0.f, 0.f, 0.f};
    bf16x8 At[4][2], B0[2][2], B1[2][2];
    const char* cA = (const char*)g.A + (size_t)cur.am * tstep; const char* cB = (const char*)g.Bt + (size_t)cur.bn * tstep;
    if constexpr (SP2) {
        PG8_STAGE(PG8_SB(0, 0), cB, voffB); PG8_STAGE(PG8_SB(0, 1), cB + hstep, voffB); PG8_STAGE(PG8_SA(0, 0), cA, voffA); PG8_STAGE(PG8_SA(0, 1), cA + hstep, voffA);
        if (wr == 1) PG8_BAR;
        PG8_WAIT_V(2); PG8_BAR;
        PG8_STAGE(PG8_SB(1, 0), cB + kstep, voffB); PG8_STAGE(PG8_SA(1, 0), cA + kstep, voffA); PG8_STAGE(PG8_SB(1, 1), cB + hstep + kstep, voffB);
        PG8_WAIT_V(6); PG8_BAR;
    } else {
        PG8_STAGE(PG8_SB(0, 0), cB, voffB); PG8_STAGE(PG8_SA(0, 0), cA, voffA); PG8_STAGE(PG8_SB(0, 1), cB + hstep, voffB); PG8_STAGE(PG8_SA(0, 1), cA + hstep, voffA);
        if (wr == 1) PG8_BAR;
        PG8_WAIT_V(4); PG8_BAR;
        PG8_STAGE(PG8_SB(1, 0), cB + kstep, voffB); PG8_STAGE(PG8_SA(1, 0), cA + kstep, voffA); PG8_STAGE(PG8_SB(1, 1), cB + hstep + kstep, voffB);
        PG8_WAIT_V(6); PG8_BAR;
    }
    for (;;) {
        const bool has_next = S.next(ui + 1, nxt);
        const char* nA = has_next ? (const char*)g.A + (size_t)nxt.am * tstep : cA; const char* nB = has_next ? (const char*)g.Bt + (size_t)nxt.bn * tstep : cB;
#pragma nounroll
        for (int t = 0; t < nt; t += 2) {
            const bool last = (t == nt - 2);
            const char* a1 = cA + (size_t)(t + 1) * kstep;
            const char* a2 = last ? nA : cA + (size_t)(t + 2) * kstep; const char* b2 = last ? nB : cB + (size_t)(t + 2) * kstep;
            const char* a3 = a2 + kstep; const char* b3 = b2 + kstep;
            if constexpr (SP2) {
            PG8_LDB(B0, 0, 0); PG8_LDB(B1, 0, 1); PG8_SCHED; PG8_LDA(At, 0, 0); PG8_STAGE(PG8_SA(1, 1), a1 + hstep, voffA);
            PG8_WAIT_V(8); PG8_WAIT_L(0); PG8_BAR; PG8_MMA(0, 0, At, B0); PG8_MMA(0, 1, At, B1); PG8_BAR; PG8_SCHED;
            PG8_LDA(At, 0, 1); PG8_STAGE(PG8_SB(0, 0), b2, voffB); PG8_STAGE(PG8_SB(0, 1), b2 + hstep, voffB); PG8_STAGE(PG8_SA(0, 0), a2, voffA);
            PG8_WAIT_V(8); PG8_WAIT_L(0); PG8_BAR; PG8_MMA(1, 0, At, B0); PG8_MMA(1, 1, At, B1); PG8_BAR; PG8_SCHED;
            PG8_LDB(B0, 1, 0); PG8_LDB(B1, 1, 1); PG8_SCHED; PG8_LDA(At, 1, 0); PG8_STAGE(PG8_SA(0, 1), a2 + hstep, voffA);
            PG8_WAIT_V(8); PG8_WAIT_L(0); PG8_BAR; PG8_MMA(0, 0, At, B0); PG8_MMA(0, 1, At, B1); PG8_BAR; PG8_SCHED;
            PG8_LDA(At, 1, 1); PG8_STAGE(PG8_SB(1, 0), b3, voffB); PG8_STAGE(PG8_SB(1, 1), b3 + hstep, voffB); PG8_STAGE(PG8_SA(1, 0), a3, voffA);
            PG8_WAIT_V(8); PG8_WAIT_L(0); PG8_BAR; PG8_MMA(1, 0, At, B0); PG8_MMA(1, 1, At, B1); PG8_BAR; PG8_SCHED;
            } else {
            PG8_LDB(B0, 0, 0); PG8_SCHED; PG8_LDA(At, 0, 0); PG8_STAGE(PG8_SA(1, 1), a1 + hstep, voffA);
            PG8_WAIT_L(8); PG8_BAR; PG8_WAIT_L(0); PG8_MMA(0, 0, At, B0); PG8_BAR; PG8_SCHED;
            PG8_LDB(B1, 0, 1); PG8_STAGE(PG8_SB(0, 0), b2, voffB);
            PG8_BAR; PG8_WAIT_L(0); PG8_MMA(0, 1, At, B1); PG8_BAR;
            PG8_LDA(At, 0, 1); PG8_STAGE(PG8_SA(0, 0), a2, voffA);
            PG8_BAR; PG8_WAIT_L(0); PG8_MMA(1, 0, At, B0); PG8_BAR; PG8_SCHED;
            PG8_STAGE(PG8_SB(0, 1), b2 + hstep, voffB);
            PG8_WAIT_V(6); PG8_BAR; PG8_MMA(1, 1, At, B1); PG8_BAR;
            PG8_LDB(B0, 1, 0); PG8_SCHED; PG8_LDA(At, 1, 0); PG8_STAGE(PG8_SA(0, 1), a2 + hstep, voffA);
            PG8_WAIT_L(8); PG8_BAR; PG8_WAIT_L(0); PG8_MMA(0, 0, At, B0); PG8_BAR; PG8_SCHED;
            PG8_LDB(B1, 1, 1); PG8_STAGE(PG8_SB(1, 0), b3, voffB);
            PG8_BAR; PG8_WAIT_L(0); PG8_MMA(0, 1, At, B1); PG8_BAR;
            PG8_LDA(At, 1, 1); PG8_STAGE(PG8_SA(1, 0), a3, voffA);
            PG8_BAR; PG8_WAIT_L(0); PG8_MMA(1, 0, At, B0); PG8_BAR; PG8_SCHED;
            PG8_STAGE(PG8_SB(1, 1), b3 + hstep, voffB);
            PG8_WAIT_V(6); PG8_BAR; PG8_MMA(1, 1, At, B1); PG8_BAR;
            }
        }
        if constexpr (ALIGN_EPI) { if (wr == 0) PG8_BAR; }
        E(acc, cur, wr, wc, fr, fq);
        if (!has_next) break;
        if (!Epi::keep(cur)) {
#pragma unroll
        for (int a = 0; a < 2; ++a)
#pragma unroll
            for (int b = 0; b < 2; ++b)
#pragma unroll
                for (int m = 0; m < 4; ++m)
#pragma unroll
                    for (int n = 0; n < 2; ++n) acc[a][b][m][n] = (f32x4){0.f, 0.f, 0.f, 0.f};
        }
        cur = nxt; cA = nA; cB = nB; ++ui;
        if constexpr (ALIGN_EPI) { if (wr == 1) PG8_BAR; }
    }
    PG8_WAIT_V(0);
    if constexpr (!ALIGN_EPI) { if (wr == 0) PG8_BAR; }
    PG8_BAR;
#undef PG8_SA
#undef PG8_SB
#undef PG8_STAGE
#undef PG8_LDA
#undef PG8_LDB
#undef PG8_MMA
#undef PG8_WAIT_V
#undef PG8_WAIT_L
#undef PG8_BAR
#undef PG8_SCHED
}

struct SegOrder {
    StaticOrder b; int nseg, aM, bN;
    __device__ void init(int M, int N, int G_, int c_, int nseg_) { b.init(M, N, G_, c_); nseg = nseg_; aM = M / BM; bN = N / BM; }
    __device__ bool next(int i, Unit& u) const { if (!b.next(i / nseg, u)) return false; const int s = i % nseg; u.seg = s; u.am = u.pm + s * aM; u.bn = u.pn + s * bN; return true; }
};

constexpr float LOG2E = 1.4426950408889634f;
__device__ __forceinline__ float sigm(float x) { return __builtin_amdgcn_rcpf(1.f + __expf(-x)); }
__device__ __forceinline__ u32x4 pack8(const f32x4 v0, const f32x4 v1) { u32x4 w; w.x = cvt_pk_bf16(v0[0], v0[1]); w.y = cvt_pk_bf16(v0[2], v0[3]); w.z = cvt_pk_bf16(v1[0], v1[1]); w.w = cvt_pk_bf16(v1[2], v1[3]); return w; }
__device__ __forceinline__ void unpack8(const u32x4 w, f32x4& v0, f32x4& v1) {
    v0[0] = __uint_as_float(w.x << 16); v0[1] = __uint_as_float(w.x & 0xffff0000u); v0[2] = __uint_as_float(w.y << 16); v0[3] = __uint_as_float(w.y & 0xffff0000u);
    v1[0] = __uint_as_float(w.z << 16); v1[1] = __uint_as_float(w.z & 0xffff0000u); v1[2] = __uint_as_float(w.w << 16); v1[3] = __uint_as_float(w.w & 0xffff0000u); }

struct EpiPlain {
    static constexpr bool PERM = true; static __device__ __forceinline__ bool keep(const Unit&) { return false; }
    bf16_t* O; int ldc; float sc;
    __device__ __forceinline__ void operator()(f32x4 (&acc)[2][2][4][2], const Unit& u, int wr, int wc, int fr, int fq) const {
        const int row0 = u.pm * BM + wr * 64 + fr, col0 = u.pn * BM + wc * 32 + 8 * fq;
#pragma unroll
        for (int ai = 0; ai < 2; ++ai)
#pragma unroll
            for (int m = 0; m < 4; ++m) { bf16_t* rowp = O + (size_t)(row0 + ai * HALF + m * 16) * ldc + col0;
#pragma unroll
                for (int bj = 0; bj < 2; ++bj) *(u32x4*)(rowp + bj * HALF) = pack8(acc[ai][bj][m][0] * sc, acc[ai][bj][m][1] * sc); }
    }
};
struct EpiSwiglu {
    static constexpr bool PERM = true; static __device__ __forceinline__ bool keep(const Unit&) { return false; }
    bf16_t* H; int ldh;
    __device__ __forceinline__ void operator()(f32x4 (&acc)[2][2][4][2], const Unit& u, int wr, int wc, int fr, int fq) const {
        const int row0 = u.pm * BM + wr * 64 + fr, col0 = u.pn * HALF + wc * 32 + 8 * fq;
#pragma unroll
        for (int ai = 0; ai < 2; ++ai)
#pragma unroll
            for (int m = 0; m < 4; ++m) {
                f32x4 v0, v1;
#pragma unroll
                for (int i = 0; i < 4; ++i) { const float a0 = acc[ai][0][m][0][i], a1 = acc[ai][0][m][1][i];
                    v0[i] = a0 * sigm(a0) * acc[ai][1][m][0][i]; v1[i] = a1 * sigm(a1) * acc[ai][1][m][1][i]; }
                *(u32x4*)(H + (size_t)(row0 + ai * HALF + m * 16) * ldh + col0) = pack8(v0, v1); }
    }
};
struct EpiRes {
    static constexpr bool PERM = false; static __device__ __forceinline__ bool keep(const Unit&) { return false; }
    const float* res; float* out; float alpha, beta;
    __device__ __forceinline__ void operator()(f32x4 (&acc)[2][2][4][2], const Unit& u, int wr, int wc, int fr, int fq) const {
        const int row0 = u.pm * BM + wr * 64 + fr, col0 = u.pn * BM + wc * 32 + 4 * fq;
#pragma unroll
        for (int ai = 0; ai < 2; ++ai)
#pragma unroll
            for (int m = 0; m < 4; ++m) { const size_t off = (size_t)(row0 + ai * HALF + m * 16) * 1024 + col0;
#pragma unroll
                for (int bj = 0; bj < 2; ++bj)
#pragma unroll
                    for (int n = 0; n < 2; ++n) { const f32x4 r = *(const f32x4*)(res + off + bj * HALF + n * 16); *(f32x4*)(out + off + bj * HALF + n * 16) = r * alpha + acc[ai][bj][m][n] * beta; } }
    }
};
struct EpiProj {
    static constexpr bool PERM = true; static __device__ __forceinline__ bool keep(const Unit&) { return false; }
    bf16_t *G, *FQ, *FK, *FV, *MQ, *CQ, *CKV; float* SIDE; const float* bgate;
    __device__ __forceinline__ void operator()(f32x4 (&acc)[2][2][4][2], const Unit& u, int wr, int wc, int fr, int fq) const {
        const int row0 = u.pm * BM + wr * 64 + fr, pn = u.pn;
#pragma unroll
        for (int bj = 0; bj < 2; ++bj) {
            const int col = pn * BM + bj * HALF + wc * 32 + 8 * fq;
            bf16_t* base; int ld, dcol; float sc = 1.f; bool gate = false;
            if (pn < 12) { base = G; ld = 3072; dcol = col; gate = true; }
            else if (pn < 14) { const int c = col - 3072; base = FQ; ld = 768; dcol = (c >> 6) * 96 + (c & 63); sc = 0.125f * LOG2E; }
            else if (pn < 16) { const int c = col - 3584; base = FK; ld = 640; dcol = (c >> 6) * 80 + (c & 63); }
            else if (pn < 18) { base = FV; ld = 512; dcol = col - 4096; }
            else if (pn < 20) { base = MQ; ld = 768; dcol = col - 4608; sc = 0.08838834764831845f * LOG2E; }
            else { const int bc = col - 5120;
                if (bc < 384) { base = CQ; ld = 384; dcol = bc; } else if (bc < 640) { base = CKV; ld = 256; dcol = bc - 384; } else { base = nullptr; ld = 0; dcol = bc; } }
            f32x4 b0 = (f32x4){0.f, 0.f, 0.f, 0.f}, b1 = b0;
            if (gate) { b0 = *(const f32x4*)(bgate + col); b1 = *(const f32x4*)(bgate + col + 4); }
            const bool side = (pn == 22) && (bj == 1) && (wc == 0 || (wc == 1 && fq == 0));
#pragma unroll
            for (int ai = 0; ai < 2; ++ai)
#pragma unroll
                for (int m = 0; m < 4; ++m) { const size_t row = (size_t)(row0 + ai * HALF + m * 16);
                    f32x4 v0 = acc[ai][bj][m][0], v1 = acc[ai][bj][m][1];
                    if (gate) {
#pragma unroll
                        for (int i = 0; i < 4; ++i) { v0[i] = sigm(v0[i] + b0[i]); v1[i] = sigm(v1[i] + b1[i]); } }
                    else { v0 = v0 * sc; v1 = v1 * sc; }
                    if (base) *(u32x4*)(base + row * ld + dcol) = pack8(v0, v1);
                    if (side) { float* sp = SIDE + row * 40 + (dcol - 640); *(f32x4*)sp = v0; *(f32x4*)(sp + 4) = v1; } }
        }
    }
};
struct EpiKvup {
    static constexpr bool PERM = true; static __device__ __forceinline__ bool keep(const Unit&) { return false; }
    bf16_t* KN; bf16_t* VM;
    __device__ __forceinline__ void operator()(f32x4 (&acc)[2][2][4][2], const Unit& u, int wr, int wc, int fr, int fq) const {
        const int row0 = u.pm * BM + wr * 64 + fr; bf16_t* base = ((wc < 2) ? KN : VM) + (2 * u.pn) * 64 + (wc & 1) * 32 + 8 * fq;
#pragma unroll
        for (int ai = 0; ai < 2; ++ai)
#pragma unroll
            for (int m = 0; m < 4; ++m) { bf16_t* rowp = base + (size_t)(row0 + ai * HALF + m * 16) * 512;
#pragma unroll
                for (int bj = 0; bj < 2; ++bj) *(u32x4*)(rowp + bj * 64) = pack8(acc[ai][bj][m][0], acc[ai][bj][m][1]); }
    }
};
struct EpiBranch {
    static constexpr bool PERM = true; static __device__ __forceinline__ bool keep(const Unit& u) { return u.seg < 2; }
    const bf16_t* G; bf16_t* MG;
    __device__ __forceinline__ void operator()(f32x4 (&acc)[2][2][4][2], const Unit& u, int wr, int wc, int fr, int fq) const {
        const int row0 = u.pm * BM + wr * 64 + fr, col0 = u.pn * BM + wc * 32 + 8 * fq, seg = u.seg;
#pragma unroll
        for (int ai = 0; ai < 2; ++ai)
#pragma unroll
            for (int m = 0; m < 4; ++m) { const size_t row = (size_t)(row0 + ai * HALF + m * 16);
#pragma unroll
                for (int bj = 0; bj < 2; ++bj) { const int col = col0 + bj * HALF;
                    f32x4 ga0, ga1; unpack8(*(const u32x4*)(G + row * 3072 + seg * 1024 + col), ga0, ga1);
                    if (seg < 2) { f32x4 gb0, gb1; unpack8(*(const u32x4*)(G + row * 3072 + (seg + 1) * 1024 + col), gb0, gb1);
#pragma unroll
                        for (int i = 0; i < 4; ++i) { acc[ai][bj][m][0][i] *= fmaxf(ga0[i], 1e-30f) / fmaxf(gb0[i], 1e-30f); acc[ai][bj][m][1][i] *= fmaxf(ga1[i], 1e-30f) / fmaxf(gb1[i], 1e-30f); } }
                    else { f32x4 v0, v1;
#pragma unroll
                        for (int i = 0; i < 4; ++i) { v0[i] = acc[ai][bj][m][0][i] * fmaxf(ga0[i], 1e-30f); v1[i] = acc[ai][bj][m][1][i] * fmaxf(ga1[i], 1e-30f); }
                        *(u32x4*)(MG + row * 1024 + col) = pack8(v0, v1); } } }
    }
};
}

namespace att {
using pg8::bf16_t;
typedef short bf16x8 __attribute__((ext_vector_type(8)));
typedef short s16x4 __attribute__((ext_vector_type(4)));
typedef float f32x16 __attribute__((ext_vector_type(16)));
typedef unsigned u32x4 __attribute__((ext_vector_type(4)));
typedef unsigned u32x2 __attribute__((ext_vector_type(2)));
typedef float f32x4 __attribute__((ext_vector_type(4)));
#define ATT_LAS __attribute__((address_space(3)))
struct Args {
    const bf16_t* Q; int qp;
    const bf16_t* KA; int kap;
    const bf16_t* KB; int kbp;
    const bf16_t* V; int vp;
    bf16_t* O; int op;
    const float* RC; const float* RSN;
};
__device__ __forceinline__ unsigned cvtpk(float lo, float hi) { unsigned r; asm volatile("v_cvt_pk_bf16_f32 %0, %1, %2" : "=v"(r) : "v"(lo), "v"(hi)); return r; }
__device__ __forceinline__ s16x4 vtr(const ATT_LAS unsigned char* p) { return __builtin_bit_cast(s16x4, __builtin_amdgcn_ds_read_tr16_b64_v4i16((ATT_LAS s16x4*)p)); }

template <int DKC, int DVB, bool CAUSAL, bool ROPE, int RG>
__device__ __forceinline__ void attn_unit(const Args a, long qrow0, long krow0, int q0, int NT, ATT_LAS unsigned char* lds) {
    int tid_ = threadIdx.x; asm volatile("" : "+v"(tid_));
    const int tid = tid_, lane = tid & 63, r32 = lane & 31, hi = lane >> 5;
    const int wid = __builtin_amdgcn_readfirstlane(tid >> 6);
    constexpr int KSLOT = DKC * 2048, VSLOT = DVB * 4096, NKC = 2 * DKC, KL = (NKC + 7) / 8, VL = (DVB * 4 + 7) / 8;
    ATT_LAS unsigned char* Kb = lds; ATT_LAS unsigned char* Vb = lds + 2 * KSLOT;
    const int wrow = wid * 32 * RG;
    bf16x8 qr[RG][DKC];
#pragma unroll
    for (int g = 0; g < RG; ++g) {
        const bf16_t* qrow = a.Q + (size_t)(qrow0 + wrow + g * 32 + r32) * a.qp + hi * 8;
#pragma unroll
        for (int c = 0; c < DKC; ++c) qr[g][c] = *(const bf16x8*)(qrow + c * 16);
        if constexpr (ROPE) {
            const size_t trow = (size_t)(qrow0 + wrow + g * 32 + r32) * 16 + 8 * hi;
            const f32x4 c0 = *(const f32x4*)(a.RC + trow), c1 = *(const f32x4*)(a.RC + trow + 4), s0 = *(const f32x4*)(a.RSN + trow), s1 = *(const f32x4*)(a.RSN + trow + 4);
            bf16x8 x1 = qr[g][4], x2 = qr[g][5];
#pragma unroll
            for (int j = 0; j < 8; ++j) { const float cc = j < 4 ? c0[j & 3] : c1[j & 3], ss = j < 4 ? s0[j & 3] : s1[j & 3];
                const float a1 = __uint_as_float((unsigned)(unsigned short)x1[j] << 16), a2 = __uint_as_float((unsigned)(unsigned short)x2[j] << 16);
                const float r1 = a1 * cc - a2 * ss, r2 = a2 * cc + a1 * ss;
                x1[j] = (short)(cvtpk(r1, 0.f) & 0xffffu); x2[j] = (short)(cvtpk(r2, 0.f) & 0xffffu); }
            qr[g][4] = x1; qr[g][5] = x2;
        }
    }
#define ATT_DMA(t, buf) do { const size_t kr_ = (size_t)(krow0 + 64 * (t)); \
    _Pragma("unroll") for (int j = 0; j < KL; ++j) { const int c8 = wid + 8 * j; if (c8 < NKC) { \
        const bf16_t* src = (c8 < 8) ? (a.KA + (kr_ + lane) * a.kap + c8 * 8) : (a.KB + (kr_ + lane) * a.kbp + (c8 - 8) * 8); \
        __builtin_amdgcn_global_load_lds((const unsigned*)src, (ATT_LAS unsigned*)(Kb + (buf) * KSLOT + c8 * 1024), 16, 0, 0); } } \
    _Pragma("unroll") for (int j = 0; j < VL; ++j) { const int pc = wid + 8 * j; if (pc < DVB * 4) { \
        __builtin_amdgcn_global_load_lds((const unsigned*)(a.V + (kr_ + 16 * (pc & 3) + (lane >> 2)) * a.vp + 32 * (pc >> 2) + (lane & 3) * 8), (ATT_LAS unsigned*)(Vb + (buf) * VSLOT + pc * 1024), 16, 0, 0); } } } while (0)
    ATT_DMA(0, 0);
    asm volatile("s_waitcnt vmcnt(0)" ::: "memory");
    __syncthreads();
    f32x16 o[RG][DVB];
    float mrun[RG], lrun[RG];
#pragma unroll
    for (int g = 0; g < RG; ++g) { mrun[g] = -1e30f; lrun[g] = 0.f;
#pragma unroll
        for (int d = 0; d < DVB; ++d)
#pragma unroll
            for (int r = 0; r < 16; ++r) o[g][d][r] = 0.f; }
    const int koff = hi * 1024 + r32 * 16;
    const int voff = ((lane >> 4) & 1) * 32 + (lane & 3) * 8 + (4 * hi + ((lane & 15) >> 2)) * 64;
    const int qw0 = q0 + wrow;
    for (int t = 0; t < NT; ++t) {
        const int buf = t & 1;
        if (t + 1 < NT) ATT_DMA(t + 1, buf ^ 1);
        const bool active = !CAUSAL || (64 * t <= qw0 + 32 * RG - 1);
        if (active) {
            f32x16 s0[RG], s1[RG];
#pragma unroll
            for (int g = 0; g < RG; ++g)
#pragma unroll
                for (int r = 0; r < 16; ++r) { s0[g][r] = 0.f; s1[g][r] = 0.f; }
            const ATT_LAS unsigned char* kp = Kb + buf * KSLOT + koff;
#pragma unroll
            for (int c = 0; c < DKC; ++c) {
                const bf16x8 k0 = *(const ATT_LAS bf16x8*)(kp + c * 2048), k1 = *(const ATT_LAS bf16x8*)(kp + c * 2048 + 512);
#pragma unroll
                for (int g = 0; g < RG; ++g) {
                    s0[g] = __builtin_amdgcn_mfma_f32_32x32x16_bf16(k0, qr[g][c], s0[g], 0, 0, 0);
                    s1[g] = __builtin_amdgcn_mfma_f32_32x32x16_bf16(k1, qr[g][c], s1[g], 0, 0, 0);
                }
            }
            u32x4 pw[RG][4];
#pragma unroll
            for (int g = 0; g < RG; ++g) {
                if (CAUSAL && (64 * t + 63 > qw0 + 32 * g)) {
                    const int kb = 64 * t + 4 * hi, qpos = qw0 + 32 * g + r32;
#pragma unroll
                    for (int r = 0; r < 16; ++r) { const int kv = kb + (r & 3) + 8 * (r >> 2); if (kv > qpos) s0[g][r] = -INFINITY; if (kv + 32 > qpos) s1[g][r] = -INFINITY; }
                }
                float rm = __builtin_fmaxf(s0[g][0], s1[g][0]);
#pragma unroll
                for (int r = 1; r < 16; ++r) rm = __builtin_fmaxf(__builtin_fmaxf(rm, s0[g][r]), s1[g][r]);
                rm = __builtin_fmaxf(rm, __shfl_xor(rm, 32));
                const float mn = __builtin_fmaxf(mrun[g], rm);
                if (__builtin_amdgcn_ballot_w64(mn > mrun[g]) != 0ull) {
                    const float alpha = __builtin_amdgcn_exp2f(mrun[g] - mn);
                    lrun[g] *= alpha;
#pragma unroll
                    for (int d = 0; d < DVB; ++d)
#pragma unroll
                        for (int r = 0; r < 16; ++r) o[g][d][r] *= alpha;
                    mrun[g] = mn;
                }
                float sum = 0.f;
#pragma unroll
                for (int r = 0; r < 16; ++r) { s0[g][r] = __builtin_amdgcn_exp2f(s0[g][r] - mn); s1[g][r] = __builtin_amdgcn_exp2f(s1[g][r] - mn); sum += s0[g][r] + s1[g][r]; }
                lrun[g] += sum;
#pragma unroll
                for (int i = 0; i < 4; ++i) { pw[g][0][i] = cvtpk(s0[g][2 * i], s0[g][2 * i + 1]); pw[g][1][i] = cvtpk(s0[g][8 + 2 * i], s0[g][9 + 2 * i]);
                    pw[g][2][i] = cvtpk(s1[g][2 * i], s1[g][2 * i + 1]); pw[g][3][i] = cvtpk(s1[g][8 + 2 * i], s1[g][9 + 2 * i]); }
            }
            const ATT_LAS unsigned char* vpp = Vb + buf * VSLOT + voff;
#pragma unroll
            for (int d = 0; d < DVB; ++d)
#pragma unroll
                for (int ks = 0; ks < 4; ++ks) {
                    const s16x4 lo = vtr(vpp + d * 4096 + ks * 1024), hh = vtr(vpp + d * 4096 + ks * 1024 + 512);
                    const bf16x8 vf = (bf16x8){lo[0], lo[1], lo[2], lo[3], hh[0], hh[1], hh[2], hh[3]};
#pragma unroll
                    for (int g = 0; g < RG; ++g) o[g][d] = __builtin_amdgcn_mfma_f32_32x32x16_bf16(vf, __builtin_bit_cast(bf16x8, pw[g][ks]), o[g][d], 0, 0, 0);
                }
        }
        asm volatile("s_waitcnt vmcnt(0)" ::: "memory");
        __syncthreads();
    }
#pragma unroll
    for (int g = 0; g < RG; ++g) {
        const float lt = lrun[g] + __shfl_xor(lrun[g], 32);
        const float inv = 1.f / lt;
        bf16_t* orow = a.O + (size_t)(qrow0 + wrow + g * 32 + r32) * a.op + 4 * hi;
#pragma unroll
        for (int d = 0; d < DVB; ++d)
#pragma unroll
            for (int gg = 0; gg < 4; ++gg) { u32x2 w; w.x = cvtpk(o[g][d][4 * gg] * inv, o[g][d][4 * gg + 1] * inv); w.y = cvtpk(o[g][d][4 * gg + 2] * inv, o[g][d][4 * gg + 3] * inv);
                *(u32x2*)(orow + 32 * d + 8 * gg) = w; }
    }
#undef ATT_DMA
}
}

using pg8::bf16_t; using pg8::f32x4; using pg8::u32x4;
#define LAS __attribute__((address_space(3)))
constexpr int NB = 4, S = 8192, T = NB * S, D = 1024, FF = 2816, NPROJ = 5888, NWAVES = 8;
constexpr float ALPHA = 1.189207115002721f;
constexpr size_t MiB = 1u << 20;
constexpr size_t WS_RS = 2 * MiB;
constexpr size_t WS_RC = 3 * MiB;
constexpr size_t WS_RSN = 5 * MiB;
constexpr size_t WS_SIDE = 7 * MiB;
constexpr size_t WS_MEMB = 12 * MiB;
constexpr size_t WS_MEMKV = 14 * MiB;
constexpr size_t WS_WIN = 16 * MiB;
constexpr size_t WS_WUQ = 28 * MiB;
constexpr size_t WS_WUKV = 29 * MiB;
constexpr size_t WS_WMKV = 30 * MiB;
constexpr size_t WS_KR = 32 * MiB;
constexpr size_t WS_XB = 34 * MiB;
constexpr size_t WS_QM = 34 * MiB;
constexpr size_t WS_WBR = 82 * MiB;
constexpr size_t WS_WOUT = 87 * MiB;
constexpr size_t WS_H = 98 * MiB;
constexpr size_t WS_G = 98 * MiB;
constexpr size_t WS_SLOT0 = 290 * MiB;
constexpr size_t WS_FQ = 338 * MiB;
constexpr size_t WS_MQ = 386 * MiB;
constexpr size_t WS_FK = 434 * MiB;
constexpr size_t WS_FV = 474 * MiB;
constexpr size_t WS_KN = 434 * MiB;
constexpr size_t WS_VM = 466 * MiB;
constexpr size_t WS_MG = 434 * MiB;
constexpr size_t WS_WA = 480 * MiB;
constexpr size_t WS_WD = 491 * MiB;
constexpr size_t WS_END = 512 * MiB;
static_assert(WS_FV + (size_t)T * 512 * 2 <= WS_END && WS_WD + (size_t)1024 * 2816 * 2 <= WS_END && WS_FQ - WS_SLOT0 == (size_t)T * 768 * 2 && WS_MQ - WS_FQ == (size_t)T * 768 * 2, "ws map");
constexpr int LDS_BYTES = 147456;

__device__ __forceinline__ unsigned f2bf(float f) { unsigned u = __builtin_bit_cast(unsigned, f); return (u + 0x7fffu + ((u >> 16) & 1u)) >> 16; }
__device__ __forceinline__ unsigned pk2(float lo, float hi) { return f2bf(lo) | (f2bf(hi) << 16); }
__device__ __forceinline__ float bf2f(unsigned b) { return __uint_as_float(b << 16); }
__device__ __forceinline__ float wave_sum(float v) {
#pragma unroll
    for (int o = 1; o < 64; o <<= 1) v += __shfl_xor(v, o);
    return v;
}
#define LDS_WAIT() asm volatile("s_waitcnt lgkmcnt(0)" ::: "memory")

__device__ __forceinline__ int map_ffn(int c) { return c < FF ? ((c >> 7) << 8) + (c & 127) : (((c - FF) >> 7) << 8) + 128 + ((c - FF) & 127); }
__device__ __forceinline__ int map_win(int c) {
    if (c < 384) return 5120 + c;
    if (c < 640) return 5504 + (c - 384);
    if (c < 672) return 5760 + (c - 640);
    if (c < 1184) return 3072 + (c - 672);
    if (c < 1696) return 3584 + (c - 1184);
    if (c < 2208) return 4096 + (c - 1696);
    if (c < 2216) return 5792 + (c - 2208);
    if (c < 2728) return 4608 + (c - 2216);
    return c - 2728;
}
template <int MODE>
__device__ __forceinline__ void tr_mat(const float* __restrict__ W, int K, int N, const float* __restrict__ ks, bf16_t* WT, int ldt, int kmul, LAS float* scr, int gw, int NGW, int lane) {
    const int nblk = (N + 31) / 32, items = (K / 64) * nblk;
    for (int it = gw; it < items; it += NGW) {
        const int kb = it / nblk, nb = it % nblk, k0 = 64 * kb, n0 = 32 * nb;
        const int nn = n0 + (lane & 31); const bool ok = nn < N;
#pragma unroll 8
        for (int i = 0; i < 32; ++i) { const int kk = 2 * i + (lane >> 5); float v = ok ? W[(size_t)(k0 + kk) * N + nn] : 0.f; if (ks) v *= ks[k0 + kk]; scr[kk * 33 + (lane & 31)] = v; }
        LDS_WAIT(); asm volatile("" ::: "memory");
        const int c = lane & 7, dc = kb * kmul + 8 * c;
#pragma unroll
        for (int j = 0; j < 4; ++j) { const int n = (lane >> 3) + 8 * j, sc = n0 + n;
            if (sc < N) { const LAS float* s = scr + (8 * c) * 33 + n;
                u32x4 o; o.x = pk2(s[0 * 33], s[1 * 33]); o.y = pk2(s[2 * 33], s[3 * 33]); o.z = pk2(s[4 * 33], s[5 * 33]); o.w = pk2(s[6 * 33], s[7 * 33]);
                const int dr = MODE == 1 ? map_ffn(sc) : (MODE == 2 ? map_win(sc) : sc);
                *(u32x4*)(WT + (size_t)dr * ldt + dc) = o; } }
        LDS_WAIT(); asm volatile("" ::: "memory");
    }
}
__device__ __forceinline__ void cvt_copy(const float* __restrict__ src, bf16_t* dst, size_t n, size_t gt, size_t NTH) {
    for (size_t i = gt * 8; i < n; i += NTH * 8) { const f32x4 a = *(const f32x4*)(src + i), b = *(const f32x4*)(src + i + 4);
        u32x4 o; o.x = pk2(a[0], a[1]); o.y = pk2(a[2], a[3]); o.z = pk2(b[0], b[1]); o.w = pk2(b[2], b[3]); *(u32x4*)(dst + i) = o; }
}
__device__ __forceinline__ void ln_row(const float* xrow, const float* __restrict__ g, const float* __restrict__ b, float* outf, bf16_t* outb, int lane) {
    f32x4 v[4]; float s = 0.f;
#pragma unroll
    for (int j = 0; j < 4; ++j) { v[j] = *(const f32x4*)(xrow + 4 * lane + 256 * j); s += (v[j][0] + v[j][1]) + (v[j][2] + v[j][3]); }
    const float mean = wave_sum(s) * (1.f / D); float s2 = 0.f;
#pragma unroll
    for (int j = 0; j < 4; ++j) { v[j] = v[j] - mean; s2 += (v[j][0] * v[j][0] + v[j][1] * v[j][1]) + (v[j][2] * v[j][2] + v[j][3] * v[j][3]); }
    const float rstd = 1.f / sqrtf(wave_sum(s2) * (1.f / D) + 1e-5f);
#pragma unroll
    for (int j = 0; j < 4; ++j) { const f32x4 gg = *(const f32x4*)(g + 4 * lane + 256 * j), bb = *(const f32x4*)(b + 4 * lane + 256 * j);
        const f32x4 y = v[j] * rstd * gg + bb;
        if (outf) *(f32x4*)(outf + 4 * lane + 256 * j) = y;
        if (outb) { unsigned long long w = (unsigned long long)pk2(y[0], y[1]) | ((unsigned long long)pk2(y[2], y[3]) << 32); *(unsigned long long*)(outb + 4 * lane + 256 * j) = w; } }
}

#define XB_TMO      128
#define XB_XCNT(j)  (256  + 64 * (j))
#define XB_XSUB(j)  (1280 + 64 * (j))
#define XB_XGEN(j)  (2304 + 64 * (j))
#define XB_TOP      3328
#define XB_TOPGEN   3392
#define XCD_BAR_WORDS 3456
#define XB_SPIN_CAP (1u << 18)

__device__ __forceinline__ unsigned xb_ld(unsigned* p)              { return __hip_atomic_load(p, __ATOMIC_RELAXED, __HIP_MEMORY_SCOPE_AGENT); }
__device__ __forceinline__ unsigned xb_add(unsigned* p, unsigned v) { return __hip_atomic_fetch_add(p, v, __ATOMIC_RELAXED, __HIP_MEMORY_SCOPE_AGENT); }
__device__ __forceinline__ unsigned xb_xcc_id() { return (unsigned)__builtin_amdgcn_s_getreg((3 << 11) | 20) & 0xFu; }
#define XB_SPIN(cond, bar) do { unsigned _sp = 0; while (cond) { __builtin_amdgcn_s_sleep(1); \
    if ((++_sp & 255u) == 0u) { if (xb_ld(&(bar)[XB_TMO])) break; if (_sp > XB_SPIN_CAP) { atomicAdd(&(bar)[XB_TMO], 1u); break; } } } } while (0)

struct XcdBarrier {
    unsigned* bar; unsigned x;
    volatile LAS unsigned* st;
};

__device__ __forceinline__ XcdBarrier xcd_barrier_post(unsigned* bar, volatile LAS unsigned* st) {
    XcdBarrier b; b.bar = bar; b.x = xb_xcc_id(); b.st = st;
    if (threadIdx.x == 0) (void)xb_add(&bar[XB_XCNT(b.x)], 1u);
    return b;
}
__device__ __forceinline__ void xcd_barrier_complete(unsigned* bar, unsigned x, unsigned& nloc, unsigned& nx) {
    const unsigned G = gridDim.x * gridDim.y * gridDim.z;
    unsigned sum, cnt, mine, sp = 0u;
    for (;;) {
        sum = 0u; cnt = 0u; mine = 0u;
#pragma unroll
        for (unsigned j = 0; j < 16; ++j) { const unsigned c = xb_ld(&bar[XB_XCNT(j)]); sum += c; cnt += (c > 0u) ? 1u : 0u; mine = (j == x) ? c : mine; }
        if (sum == G) break;
        __builtin_amdgcn_s_sleep(1);
        if ((++sp & 255u) == 0u) { if (xb_ld(&bar[XB_TMO])) break; if (sp > XB_SPIN_CAP) { atomicAdd(&bar[XB_TMO], 1u); break; } }
    }
    nloc = mine > 0u ? mine : 1u; nx = cnt > 0u ? cnt : 1u;
}

__device__ __forceinline__ void xcd_barrier(const XcdBarrier& b) {
    asm volatile("s_waitcnt vmcnt(0)" ::: "memory");
    __syncthreads();
    if (threadIdx.x == 0) {
        unsigned* bar = b.bar;
        __builtin_amdgcn_s_waitcnt(0);
        unsigned nloc = b.st[0], nx = b.st[1];
        if (nloc == 0u) { xcd_barrier_complete(bar, b.x, nloc, nx); b.st[0] = nloc; b.st[1] = nx; }
        const unsigned old = xb_add(&bar[XB_XSUB(b.x)], 1u);
        const unsigned gen = old / nloc;
        if (old + 1u == (gen + 1u) * nloc) {
            __builtin_amdgcn_fence(__ATOMIC_RELEASE, "agent");
            asm volatile("s_waitcnt vmcnt(0)" ::: "memory");
            const unsigned og = xb_add(&bar[XB_TOP], 1u);
            const unsigned tg = og / nx;
            if (og + 1u == (tg + 1u) * nx) xb_add(&bar[XB_TOPGEN], 1u);
            else XB_SPIN(xb_ld(&bar[XB_TOPGEN]) == tg, bar);
            __builtin_amdgcn_fence(__ATOMIC_ACQUIRE, "agent");
            xb_add(&bar[XB_XGEN(b.x)], 1u);
            asm volatile("s_waitcnt vmcnt(0)" ::: "memory");
        } else {
            XB_SPIN(xb_ld(&bar[XB_XGEN(b.x)]) == gen, bar);
            __builtin_amdgcn_fence(__ATOMIC_ACQUIRE, "agent");
            asm volatile("s_waitcnt vmcnt(0)" ::: "memory");
        }
    }
    __syncthreads();
}

#ifndef PH_MASK
#define PH_MASK 0xFFFF
#endif
struct Params { const float* in[25]; float* out; unsigned char* ws; };

__global__ void __launch_bounds__(NWAVES * 64) mega_fwd(Params p) {
    extern __shared__ __attribute__((aligned(16))) unsigned char lds_raw[];
    cg::grid_group grid = cg::this_grid();
    LAS unsigned char* lds = (LAS unsigned char*)lds_raw;
    const int tid = threadIdx.x, lane = tid & 63, wave = __builtin_amdgcn_readfirstlane(tid >> 6);
    const int G = gridDim.x, bx = blockIdx.x;
    const int gw = bx * NWAVES + wave, NGW = G * NWAVES;
    const size_t gt = (size_t)bx * (NWAVES * 64) + tid, NTH = (size_t)G * (NWAVES * 64);
    unsigned char* ws = p.ws;
    const float* x = p.in[0]; const float* mem = p.in[1]; const int* positions = (const int*)p.in[2];
    float* R = p.out;
    float* RS = (float*)(ws + WS_RS); float* RC = (float*)(ws + WS_RC); float* RSN = (float*)(ws + WS_RSN); float* SIDE = (float*)(ws + WS_SIDE);
    bf16_t* MEMB = (bf16_t*)(ws + WS_MEMB); bf16_t* MEMKV = (bf16_t*)(ws + WS_MEMKV);
    bf16_t* WIN = (bf16_t*)(ws + WS_WIN); bf16_t* WUQ = (bf16_t*)(ws + WS_WUQ); bf16_t* WUKV = (bf16_t*)(ws + WS_WUKV); bf16_t* WMKV = (bf16_t*)(ws + WS_WMKV);
    bf16_t* KR = (bf16_t*)(ws + WS_KR); bf16_t* XB = (bf16_t*)(ws + WS_XB); bf16_t* QM = (bf16_t*)(ws + WS_QM); bf16_t* WBR = (bf16_t*)(ws + WS_WBR); bf16_t* WOUT = (bf16_t*)(ws + WS_WOUT);
    bf16_t* HB = (bf16_t*)(ws + WS_H); bf16_t* GB = (bf16_t*)(ws + WS_G); bf16_t* SLOT0 = (bf16_t*)(ws + WS_SLOT0); bf16_t* CQ = SLOT0; bf16_t* CKV = SLOT0 + (size_t)T * 384; bf16_t* FQ = (bf16_t*)(ws + WS_FQ); bf16_t* MQ = (bf16_t*)(ws + WS_MQ);
    bf16_t* FK = (bf16_t*)(ws + WS_FK); bf16_t* FV = (bf16_t*)(ws + WS_FV); bf16_t* KN = (bf16_t*)(ws + WS_KN); bf16_t* VM = (bf16_t*)(ws + WS_VM); bf16_t* MG = (bf16_t*)(ws + WS_MG);
    bf16_t* WA = (bf16_t*)(ws + WS_WA); bf16_t* WD = (bf16_t*)(ws + WS_WD);
    LAS float* scr = (LAS float*)(lds + wave * 16384);
    volatile LAS unsigned* MISC = (volatile LAS unsigned*)(lds + 131072 + 256);
    if (tid < 2) MISC[tid] = 0u;
    unsigned* barw = (unsigned*)ws;
    if (bx == 0) for (int i = tid; i < XCD_BAR_WORDS; i += NWAVES * 64) barw[i] = 0u;

#if (PH_MASK >> 0) & 1
    tr_mat<1>(p.in[5], D, 2 * FF, nullptr, WA, D, 64, scr, gw, NGW, lane);
    tr_mat<0>(p.in[6], FF, D, nullptr, WD, FF, 64, scr, gw, NGW, lane);
    tr_mat<2>(p.in[7], D, 5800, nullptr, WIN, D, 64, scr, gw, NGW, lane);
    tr_mat<0>(p.in[10], 384, 768, p.in[9], WUQ, 384, 64, scr, gw, NGW, lane);
    tr_mat<0>(p.in[12], 256, 1024, p.in[11], WUKV, 256, 64, scr, gw, NGW, lane);
    tr_mat<0>(p.in[14], D, 1024, nullptr, WMKV, D, 64, scr, gw, NGW, lane);
    for (size_t i = gt * 8; i < (size_t)88 * D; i += NTH * 8) *(u32x4*)(WIN + (size_t)5800 * D + i) = (u32x4){0u, 0u, 0u, 0u};
    cvt_copy(x, XB, (size_t)T * D, gt, NTH);
    cvt_copy(mem, MEMB, (size_t)NB * 256 * D, gt, NTH);
    for (size_t i = gt; i < (size_t)T * 16; i += NTH) {
        const int row = (int)(i >> 4), f = (int)(i & 15);
        const float invf = (float)exp2(-(double)f * (13.287712379549449 / 16.0));
        const float ang = (float)positions[row] * invf;
        const double rev = (double)ang * 0.15915494309189535; const float fr = (float)(rev - __builtin_rint(rev));
        RC[i] = __builtin_amdgcn_cosf(fr); RSN[i] = __builtin_amdgcn_sinf(fr);
    }
#endif
    grid.sync();
    const XcdBarrier xb = xcd_barrier_post(barw, MISC);

#if (PH_MASK >> 1) & 1
    { pg8::Gemm g{XB, WA, T, 2 * FF, D}; pg8::StaticOrder so; so.init(T, 2 * FF, G, bx);
      pg8::EpiSwiglu E{HB, FF}; pg8::gemm_phase<pg8::EpiSwiglu, pg8::StaticOrder, true>(lds, g, so, E); }
#endif
    xcd_barrier(xb);
#if (PH_MASK >> 2) & 1
    { pg8::Gemm g{HB, WD, T, D, FF}; pg8::StaticOrder so; so.init(T, D, G, bx);
      pg8::EpiRes E{x, R, ALPHA, 0.5f}; pg8::gemm_phase<pg8::EpiRes, pg8::StaticOrder, true>(lds, g, so, E); }
#endif
    xcd_barrier(xb);
#if (PH_MASK >> 3) & 1
    for (int m = gw; m < T; m += NGW) ln_row(R + (size_t)m * D, p.in[3], p.in[4], R + (size_t)m * D, XB + (size_t)m * D, lane);
    { pg8::Gemm g{MEMB, WMKV, NB * 256, 1024, D}; pg8::StaticOrder so; so.init(NB * 256, 1024, G, (bx + 128) % G);
      pg8::EpiPlain E{MEMKV, 1024, 1.f}; pg8::gemm_phase<pg8::EpiPlain, pg8::StaticOrder, true>(lds, g, so, E); }
#endif
    xcd_barrier(xb);
#if (PH_MASK >> 4) & 1
    { pg8::Gemm g{XB, WIN, T, NPROJ, D}; pg8::StaticOrder so; so.init(T, NPROJ, G, bx);
      pg8::EpiProj E{GB, FQ, FK, FV, MQ, CQ, CKV, SIDE, p.in[8]}; pg8::gemm_phase<pg8::EpiProj, pg8::StaticOrder, true>(lds, g, so, E); }
#endif
    xcd_barrier(xb);
#if (PH_MASK >> 5) & 1
    if (bx < 32) {
        const int b = bx >> 3, h = bx & 7; LAS double* sh = (LAS double*)lds;
        const float bfh = p.in[13][h]; float lf[16]; double loc = 0.0;
#pragma unroll
        for (int j = 0; j < 16; ++j) { const float xx = SIDE[((size_t)b * S + 16 * tid + j) * 40 + 32 + h] + bfh; lf[j] = fminf(xx, 0.f) - log1pf(__expf(-fabsf(xx))); loc += (double)lf[j]; }
        sh[tid] = loc; __syncthreads();
        double run = 0.0; for (int j = 0; j < tid; ++j) run += sh[j];
#pragma unroll
        for (int j = 0; j < 16; ++j) { run += (double)lf[j];
            const float f2 = (float)(run * 1.4426950408889634);
            const unsigned h1 = f2bf(f2); const float r1 = f2 - bf2f(h1); const unsigned h2 = f2bf(r1); const float r2 = r1 - bf2f(h2); const unsigned h3 = f2bf(r2);
            const size_t row = (size_t)b * S + 16 * tid + j; const unsigned one = 0x3f80u, z = 0u;
            u32x4* qd = (u32x4*)(FQ + row * 768 + h * 96 + 64);
            qd[0] = (u32x4){one | (one << 16), one | (h1 << 16), h2 | (h3 << 16), z}; qd[1] = (u32x4){z, z, z, z}; qd[2] = (u32x4){z, z, z, z}; qd[3] = (u32x4){z, z, z, z};
            u32x4* kd = (u32x4*)(FK + row * 640 + h * 80 + 64);
            const unsigned n1 = h1 ^ 0x8000u, n2 = h2 ^ 0x8000u, n3 = h3 ^ 0x8000u;
            kd[0] = (u32x4){n1 | (n2 << 16), n3 | (one << 16), one | (one << 16), z}; kd[1] = (u32x4){z, z, z, z}; }
        __syncthreads();
    }
    for (int m = gw; m < T; m += NGW) {
        f32x4 a0, a1, c0, c1; float sq = 0.f, sq2 = 0.f;
        if (lane < 48) { pg8::unpack8(*(const u32x4*)(CQ + (size_t)m * 384 + lane * 8), a0, a1);
#pragma unroll
            for (int i = 0; i < 4; ++i) sq += a0[i] * a0[i] + a1[i] * a1[i]; }
        if (lane < 32) { pg8::unpack8(*(const u32x4*)(CKV + (size_t)m * 256 + lane * 8), c0, c1);
#pragma unroll
            for (int i = 0; i < 4; ++i) sq2 += c0[i] * c0[i] + c1[i] * c1[i]; }
        const float rq = 1.f / sqrtf(wave_sum(sq) * (1.f / 384.f) + 1e-6f), rkv = 1.f / sqrtf(wave_sum(sq2) * (1.f / 256.f) + 1e-6f);
        if (lane < 48) *(u32x4*)(CQ + (size_t)m * 384 + lane * 8) = pg8::pack8(a0 * rq, a1 * rq);
        if (lane < 32) *(u32x4*)(CKV + (size_t)m * 256 + lane * 8) = pg8::pack8(c0 * rkv, c1 * rkv);
        if (lane < 16) { const float x1 = SIDE[(size_t)m * 40 + lane], x2 = SIDE[(size_t)m * 40 + 16 + lane], c = RC[(size_t)m * 16 + lane], s = RSN[(size_t)m * 16 + lane];
            KR[(size_t)m * 32 + lane] = (bf16_t)f2bf(x1 * c - x2 * s); KR[(size_t)m * 32 + 16 + lane] = (bf16_t)f2bf(x2 * c + x1 * s); }
        if (lane < 32) *(u32x4*)(MQ + (size_t)m * 768 + 512 + lane * 8) = (u32x4){0u, 0u, 0u, 0u};
    }
    tr_mat<0>(p.in[15], 512, D, nullptr, WBR, 768, 96, scr, gw, NGW, lane);
    tr_mat<0>(p.in[16], 512, D, nullptr, WBR + (size_t)1024 * 768, 768, 96, scr, gw, NGW, lane);
    tr_mat<0>(p.in[17], 512, D, nullptr, WBR + (size_t)2048 * 768, 768, 64, scr, gw, NGW, lane);
    tr_mat<0>(p.in[18], D, D, nullptr, WOUT, D, 64, scr, gw, NGW, lane);
    for (size_t i = gt; i < (size_t)3 * 1024 * 32; i += NTH) {
        const int r = (int)(i >> 5), c = (int)(i & 31); bf16_t* rowp = WBR + (size_t)r * 768;
        const int col = (r < 2048) ? ((c >> 2) * 96 + 64 + (c & 3) * 8) : (512 + c * 8);
        *(u32x4*)(rowp + col) = (u32x4){0u, 0u, 0u, 0u};
    }
    __syncthreads();
    for (int u = bx; u < NB * 4 * 32; u += G) {
        const int b = u >> 7, hm = (u >> 5) & 3, qb = u & 31;
        att::Args a{MQ + hm * 128, 768, MEMKV + hm * 128, 1024, MEMKV + hm * 128 + 64, 1024, MEMKV + 512 + hm * 128, 1024, MQ + hm * 128, 768, nullptr, nullptr};
        att::attn_unit<8, 4, false, false, 1>(a, (long)b * S + qb * 256, (long)b * 256, 0, 4, lds);
    }
#endif
    xcd_barrier(xb);
#if (PH_MASK >> 6) & 1
    for (int u = bx; u < 512; u += G) {
        const int v = u & 255, i = u >> 8, vcu = (v & 7) * 32 + (v >> 3), bh = vcu >> 3, s = vcu & 7;
        const int qb = (i == 0) ? s : 15 - s; const int b = bh >> 3, h = bh & 7;
        att::Args a{FQ + h * 96, 768, FK + h * 80, 640, FK + h * 80 + 64, 640, FV + h * 64, 512, FQ + h * 96, 768, nullptr, nullptr};
        att::attn_unit<5, 2, true, false, 2>(a, (long)b * S + qb * 512, (long)b * S, qb * 512, 8 * (qb + 1), lds);
    }
#endif
    xcd_barrier(xb);
#if (PH_MASK >> 7) & 1
    { pg8::Gemm g{CQ, WUQ, T, 768, 384}; pg8::StaticOrder so; so.init(T, 768, G, bx);
      pg8::EpiPlain E{QM, 768, 0.10206207261596577f * pg8::LOG2E}; pg8::gemm_phase<pg8::EpiPlain, pg8::StaticOrder, true>(lds, g, so, E); }
    { pg8::Gemm g{CKV, WUKV, T, 1024, 256}; pg8::StaticOrder so; so.init(T, 1024, G, bx);
      pg8::EpiKvup E{KN, VM}; pg8::gemm_phase<pg8::EpiKvup, pg8::StaticOrder, true>(lds, g, so, E); }
#endif
    xcd_barrier(xb);
#if (PH_MASK >> 8) & 1
    for (int u = bx; u < 512; u += G) {
        const int v = u & 255, i = u >> 8, vcu = (v & 7) * 32 + (v >> 3), bh = vcu >> 3, s = vcu & 7;
        const int qb = (i == 0) ? s : 15 - s; const int b = bh >> 3, h = bh & 7;
        att::Args a{QM + h * 96, 768, KN + h * 64, 512, KR, 32, VM + h * 64, 512, SLOT0 + h * 96, 768, RC, RSN};
        att::attn_unit<6, 2, true, true, 2>(a, (long)b * S + qb * 512, (long)b * S, qb * 512, 8 * (qb + 1), lds);
    }
#endif
    xcd_barrier(xb);
#if (PH_MASK >> 9) & 1
    { pg8::Gemm g{SLOT0, WBR, T, D, 768}; pg8::SegOrder so; so.init(T, D, G, bx, 3);
      pg8::EpiBranch E{GB, MG}; pg8::gemm_phase<pg8::EpiBranch, pg8::SegOrder, true>(lds, g, so, E); }
#endif
    xcd_barrier(xb);
#if (PH_MASK >> 10) & 1
    { pg8::Gemm g{MG, WOUT, T, D, D}; pg8::StaticOrder so; so.init(T, D, G, bx);
      pg8::EpiRes E{R, R, ALPHA, 1.f}; pg8::gemm_phase<pg8::EpiRes, pg8::StaticOrder, true>(lds, g, so, E); }
#endif
    xcd_barrier(xb);
#if (PH_MASK >> 11) & 1
    for (int m = gw; m < T; m += NGW) ln_row(R + (size_t)m * D, p.in[19], p.in[20], R + (size_t)m * D, XB + (size_t)m * D, lane);
    tr_mat<1>(p.in[21], D, 2 * FF, nullptr, WA, D, 64, scr, gw, NGW, lane);
    tr_mat<0>(p.in[22], FF, D, nullptr, WD, FF, 64, scr, gw, NGW, lane);
#endif
    xcd_barrier(xb);
#if (PH_MASK >> 12) & 1
    { pg8::Gemm g{XB, WA, T, 2 * FF, D}; pg8::StaticOrder so; so.init(T, 2 * FF, G, bx);
      pg8::EpiSwiglu E{HB, FF}; pg8::gemm_phase<pg8::EpiSwiglu, pg8::StaticOrder, true>(lds, g, so, E); }
#endif
    xcd_barrier(xb);
#if (PH_MASK >> 13) & 1
    { pg8::Gemm g{HB, WD, T, D, FF}; pg8::StaticOrder so; so.init(T, D, G, bx);
      pg8::EpiRes E{R, R, ALPHA, 0.5f}; pg8::gemm_phase<pg8::EpiRes, pg8::StaticOrder, true>(lds, g, so, E); }
#endif
    xcd_barrier(xb);
#if (PH_MASK >> 14) & 1
    for (int m = gw; m < T; m += NGW) ln_row(R + (size_t)m * D, p.in[23], p.in[24], R + (size_t)m * D, nullptr, lane);
#endif
}

extern "C" void kernel_launch(void* const* d_in, const int* in_sizes, int n_in, void* d_out, int out_size, void* d_ws, size_t ws_size, hipStream_t stream) {
    static int grid = 0;
    if (grid == 0) {
        if (n_in != 25 || out_size != T * D || ws_size < WS_END) { fprintf(stderr, "kernel_launch: unexpected shapes (n_in %d out %d ws %zu)\n", n_in, out_size, ws_size); grid = -1; return; }
        int dev = 0, cus = 0, per = 0;
        (void)hipGetDevice(&dev); (void)hipDeviceGetAttribute(&cus, hipDeviceAttributeMultiprocessorCount, dev);
        (void)hipFuncSetAttribute((const void*)mega_fwd, hipFuncAttributeMaxDynamicSharedMemorySize, LDS_BYTES);
        (void)hipOccupancyMaxActiveBlocksPerMultiprocessor(&per, (const void*)mega_fwd, NWAVES * 64, LDS_BYTES);
        if (per < 1) per = 1;
        grid = cus * per;
        fprintf(stderr, "kernel_launch: grid %d (cus %d x %d), ws %zu\n", grid, cus, per, ws_size);
    }
    if (grid < 0) return;
    Params p{};
    for (int i = 0; i < 25; ++i) p.in[i] = (const float*)d_in[i];
    p.out = (float*)d_out; p.ws = (unsigned char*)d_ws;
    void* args[] = {&p};
    const hipError_t e = hipLaunchCooperativeKernel((const void*)mega_fwd, dim3(grid), dim3(NWAVES * 64), args, LDS_BYTES, stream);
    if (e != hipSuccess) fprintf(stderr, "kernel_launch: cooperative launch failed: %s (grid %d)\n", hipGetErrorString(e), grid);
}
```

```cpp
#include <hip/hip_runtime.h>
#include <hip/hip_cooperative_groups.h>
#include <cstdio>
#include <cstdint>
#include <cmath>
namespace cg = cooperative_groups;
namespace pg8 {
#define PG8_LAS __attribute__((address_space(3)))
typedef unsigned short bf16_t;
typedef short bf16x8 __attribute__((ext_vector_type(8)));
typedef float f32x4 __attribute__((ext_vector_type(4)));
typedef unsigned u32x4 __attribute__((ext_vector_type(4)));
constexpr int BM = 256, BK = 64, HALF = 128, HTB = HALF * BK * 2  , STAGE_BYTES = 8 * HTB, NXCD = 8, WGM = 8;

__host__ __device__ __forceinline__ int lds_byte(int r, int c) { const int st = (r >> 4) * 2 + (c >> 5), rr = r & 15, cc = c & 31, ob = rr * 64 + cc * 2; return st * 1024 + (ob ^ (((ob >> 9) & 1) << 5)); }
__host__ __device__ __forceinline__ void stage_rc(int b, int& R, int& C) { const int st = b / 1024, sb = b % 1024, swz = sb ^ (((sb >> 9) & 1) << 5); R = (st >> 1) * 16 + swz / 64; C = (st & 1) * 32 + (swz % 64) / 2; }
__host__ __device__ __forceinline__ int perm32(int rho) { const int n = rho >> 4, i = rho & 15; return 8 * (i >> 2) + 4 * n + (i & 3); }

struct Unit { int pm, pn, am, bn, seg; };
struct Gemm { const bf16_t* A; const bf16_t* Bt; int M, N, K; };

struct StaticOrder {
    int nM, nN, nwg, G, c;
    __host__ __device__ void init(int M, int N, int G_, int c_) { nM = M / BM; nN = N / BM; nwg = nM * nN; G = G_; c = c_; }
    __host__ __device__ bool next(int i, Unit& u) const {
        const long L = (long)i * G + c; if (L >= nwg) return false;
        int wgid = (int)L; { const int q = nwg / NXCD, r = nwg % NXCD, xcd = wgid % NXCD, off = wgid / NXCD; wgid = (xcd < r ? xcd * (q + 1) : r * (q + 1) + (xcd - r) * q) + off; }
        const int nig = WGM * nN, gid = wgid / nig, fm = gid * WGM, gsz = (nM - fm) < WGM ? (nM - fm) : WGM;
        u.pm = fm + ((wgid % nig) % gsz); u.pn = (wgid % nig) / gsz; u.am = u.pm; u.bn = u.pn; u.seg = 0; return true;
    }
};

__device__ __forceinline__ unsigned cvt_pk_bf16(float lo, float hi) { unsigned r; asm volatile("v_cvt_pk_bf16_f32 %0, %1, %2" : "=v"(r) : "v"(lo), "v"(hi)); return r; }
typedef float f32x2 __attribute__((ext_vector_type(2)));
template <class Epi, class Sched, bool ALIGN_EPI = false, bool SP2 = true>
__device__ __forceinline__ void gemm_phase(PG8_LAS unsigned char* lds, const Gemm g, const Sched& S, const Epi& E) {
    int tid_ = threadIdx.x; asm volatile("" : "+v"(tid_));
    const int tid = tid_, wid = __builtin_amdgcn_readfirstlane(tid >> 6), lane = tid & 63, wr = wid >> 2, wc = wid & 3, fr = lane & 15, fq = lane >> 4;
    const int K = g.K, nt = K / BK;
    unsigned voffA[2], voffB[2];
#pragma unroll
    for (int i = 0; i < 2; ++i) { int R, C; stage_rc(tid * 16 + i * 8192, R, C); const int Rb = Epi::PERM ? ((R & ~31) + perm32(R & 31)) : R;
        voffA[i] = (unsigned)(R * K + C) * 2u; voffB[i] = (unsigned)(Rb * K + C) * 2u; }
    const size_t kstep = (size_t)(BK * 2);
    const size_t hstep = (size_t)HALF * K * 2;
    const size_t tstep = 2 * hstep;
    const unsigned ldsw = (unsigned)wid * 1024u;
    const int aoff = lds_byte(wr * 64 + fr, fq * 8), boff = lds_byte(wc * 32 + fr, fq * 8);
#define PG8_SA(b, h) (((b) * 2 + (h)) * HTB)
#define PG8_SB(b, h) ((4 + (b) * 2 + (h)) * HTB)
#define PG8_STAGE(bufoff, gbase, voff) do { _Pragma("unroll") for (int _i = 0; _i < 2; ++_i) \
        __builtin_amdgcn_global_load_lds((const unsigned*)((const char*)(gbase) + (voff)[_i]), (PG8_LAS unsigned*)(lds + (bufoff) + ldsw + _i * 8192), 16, 0, 0); } while (0)
#define PG8_LDA(dst, b, h) do { _Pragma("unroll") for (int m = 0; m < 4; ++m) _Pragma("unroll") for (int k = 0; k < 2; ++k) dst[m][k] = *(const PG8_LAS bf16x8*)(lds + PG8_SA(b, h) + aoff + m * 2048 + k * 1024); } while (0)
#define PG8_LDB(dst, b, h) do { _Pragma("unroll") for (int n = 0; n < 2; ++n) _Pragma("unroll") for (int k = 0; k < 2; ++k) dst[n][k] = *(const PG8_LAS bf16x8*)(lds + PG8_SB(b, h) + boff + n * 2048 + k * 1024); } while (0)
#define PG8_MMA(ai, bj, At, Bt) do { __builtin_amdgcn_s_setprio(1); _Pragma("unroll") for (int m = 0; m < 4; ++m) _Pragma("unroll") for (int n = 0; n < 2; ++n) _Pragma("unroll") for (int k = 0; k < 2; ++k) \
        acc[ai][bj][m][n] = __builtin_amdgcn_mfma_f32_16x16x32_bf16(Bt[n][k], At[m][k], acc[ai][bj][m][n], 0, 0, 0); __builtin_amdgcn_s_setprio(0); } while (0)
#define PG8_WAIT_V(n) asm volatile("s_waitcnt vmcnt(" #n ")" ::: "memory")
#define PG8_WAIT_L(n) asm volatile("s_waitcnt lgkmcnt(" #n ")" ::: "memory")
#define PG8_BAR __builtin_amdgcn_s_barrier()
#define PG8_SCHED __builtin_amdgcn_sched_barrier(0)
    Unit cur, nxt; int ui = 0;
    if (!S.next(0, cur)) return;
    f32x4 acc[2][2][4][2];
#pragma unroll
    for (int a = 0; a < 2; ++a)
#pragma unroll
        for (int b = 0; b < 2; ++b)
#pragma unroll
            for (int m = 0; m < 4; ++m)
#pragma unroll
                for (int n = 0; n < 2; ++n) acc[a][b][m][n] = (f32x4){0.f, 0.f, 0.f, 0.f};
    bf16x8 At[4][2], B0[2][2], B1[2][2];
    const char* cA = (const char*)g.A + (size_t)cur.am * tstep; const char* cB = (const char*)g.Bt + (size_t)cur.bn * tstep;
    if constexpr (SP2) {
        PG8_STAGE(PG8_SB(0, 0), cB, voffB); PG8_STAGE(PG8_SB(0, 1), cB + hstep, voffB); PG8_STAGE(PG8_SA(0, 0), cA, voffA); PG8_STAGE(PG8_SA(0, 1), cA + hstep, voffA);
        if (wr == 1) PG8_BAR;
        PG8_WAIT_V(2); PG8_BAR;
        PG8_STAGE(PG8_SB(1, 0), cB + kstep, voffB); PG8_STAGE(PG8_SA(1, 0), cA + kstep, voffA); PG8_STAGE(PG8_SB(1, 1), cB + hstep + kstep, voffB);
        PG8_WAIT_V(6); PG8_BAR;
    } else {
        PG8_STAGE(PG8_SB(0, 0), cB, voffB); PG8_STAGE(PG8_SA(0, 0), cA, voffA); PG8_STAGE(PG8_SB(0, 1), cB + hstep, voffB); PG8_STAGE(PG8_SA(0, 1), cA + hstep, voffA);
        if (wr == 1) PG8_BAR;
        PG8_WAIT_V(4); PG8_BAR;
        PG8_STAGE(PG8_SB(1, 0), cB + kstep, voffB); PG8_STAGE(PG8_SA(1, 0), cA + kstep, voffA); PG8_STAGE(PG8_SB(1, 1), cB + hstep + kstep, voffB);
        PG8_WAIT_V(6); PG8_BAR;
    }
    for (;;) {
        const bool has_next = S.next(ui + 1, nxt);
        const char* nA = has_next ? (const char*)g.A + (size_t)nxt.am * tstep : cA; const char* nB = has_next ? (const char*)g.Bt + (size_t)nxt.bn * tstep : cB;
#pragma nounroll
        for (int t = 0; t < nt; t += 2) {
            const bool last = (t == nt - 2);
            const char* a1 = cA + (size_t)(t + 1) * kstep;
            const char* a2 = last ? nA : cA + (size_t)(t + 2) * kstep; const char* b2 = last ? nB : cB + (size_t)(t + 2) * kstep;
            const char* a3 = a2 + kstep; const char* b3 = b2 + kstep;
            if constexpr (SP2) {
            PG8_LDB(B0, 0, 0); PG8_LDB(B1, 0, 1); PG8_SCHED; PG8_LDA(At, 0, 0); PG8_STAGE(PG8_SA(1, 1), a1 + hstep, voffA);
            PG8_WAIT_V(8); PG8_WAIT_L(0); PG8_BAR; PG8_MMA(0, 0, At, B0); PG8_MMA(0, 1, At, B1); PG8_BAR; PG8_SCHED;
            PG8_LDA(At, 0, 1); PG8_STAGE(PG8_SB(0, 0), b2, voffB); PG8_STAGE(PG8_SB(0, 1), b2 + hstep, voffB); PG8_STAGE(PG8_SA(0, 0), a2, voffA);
            PG8_WAIT_V(8); PG8_WAIT_L(0); PG8_BAR; PG8_MMA(1, 0, At, B0); PG8_MMA(1, 1, At, B1); PG8_BAR; PG8_SCHED;
            PG8_LDB(B0, 1, 0); PG8_LDB(B1, 1, 1); PG8_SCHED; PG8_LDA(At, 1, 0); PG8_STAGE(PG8_SA(0, 1), a2 + hstep, voffA);
            PG8_WAIT_V(8); PG8_WAIT_L(0); PG8_BAR; PG8_MMA(0, 0, At, B0); PG8_MMA(0, 1, At, B1); PG8_BAR; PG8_SCHED;
            PG8_LDA(At, 1, 1); PG8_STAGE(PG8_SB(1, 0), b3, voffB); PG8_STAGE(PG8_SB(1, 1), b3 + hstep, voffB); PG8_STAGE(PG8_SA(1, 0), a3, voffA);
            PG8_WAIT_V(8); PG8_WAIT_L(0); PG8_BAR; PG8_MMA(1, 0, At, B0); PG8_MMA(1, 1, At, B1); PG8_BAR; PG8_SCHED;
            } else {
            PG8_LDB(B0, 0, 0); PG8_SCHED; PG8_LDA(At, 0, 0); PG8_STAGE(PG8_SA(1, 1), a1 + hstep, voffA);
            PG8_WAIT_L(8); PG8_BAR; PG8_WAIT_L(0); PG8_MMA(0, 0, At, B0); PG8_BAR; PG8_SCHED;
            PG8_LDB(B1, 0, 1); PG8_STAGE(PG8_SB(0, 0), b2, voffB);
            PG8_BAR; PG8_WAIT_L(0); PG8_MMA(0, 1, At, B1); PG8_BAR;
            PG8_LDA(At, 0, 1); PG8_STAGE(PG8_SA(0, 0), a2, voffA);
            PG8_BAR; PG8_WAIT_L(0); PG8_MMA(1, 0, At, B0); PG8_BAR; PG8_SCHED;
            PG8_STAGE(PG8_SB(0, 1), b2 + hstep, voffB);
            PG8_WAIT_V(6); PG8_BAR; PG8_MMA(1, 1, At, B1); PG8_BAR;
            PG8_LDB(B0, 1, 0); PG8_SCHED; PG8_LDA(At, 1, 0); PG8_STAGE(PG8_SA(0, 1), a2 + hstep, voffA);
            PG8_WAIT_L(8); PG8_BAR; PG8_WAIT_L(0); PG8_MMA(0, 0, At, B0); PG8_BAR; PG8_SCHED;
            PG8_LDB(B1, 1, 1); PG8_STAGE(PG8_SB(1, 0), b3, voffB);
            PG8_BAR; PG8_WAIT_L(0); PG8_MMA(0, 1, At, B1); PG8_BAR;
            PG8_LDA(At, 1, 1); PG8_STAGE(PG8_SA(1, 0), a3, voffA);
            PG8_BAR; PG8_WAIT_L(0); PG8_MMA(1, 0, At, B0); PG8_BAR; PG8_SCHED;
            PG8_STAGE(PG8_SB(1, 1), b3 + hstep, voffB);
            PG8_WAIT_V(6); PG8_BAR; PG8_MMA(1, 1, At, B1); PG8_BAR;
            }
        }
        if constexpr (ALIGN_EPI) { if (wr == 0) PG8_BAR; }
        E(acc, cur, wr, wc, fr, fq);
        if (!has_next) break;
        if (!Epi::keep(cur)) {
#pragma unroll
        for (int a = 0; a < 2; ++a)
#pragma unroll
            for (int b = 0; b < 2; ++b)
#pragma unroll
                for (int m = 0; m < 4; ++m)
#pragma unroll
                    for (int n = 0; n < 2; ++n) acc[a][b][m][n] = (f32x4){0.f, 0.f, 0.f, 0.f};
        }
        cur = nxt; cA = nA; cB = nB; ++ui;
        if constexpr (ALIGN_EPI) { if (wr == 1) PG8_BAR; }
    }
    PG8_WAIT_V(0);
    if constexpr (!ALIGN_EPI) { if (wr == 0) PG8_BAR; }
    PG8_BAR;
#undef PG8_SA
#undef PG8_SB
#undef PG8_STAGE
#undef PG8_LDA
#undef PG8_LDB
#undef PG8_MMA
#undef PG8_WAIT_V
#undef PG8_WAIT_L
#undef PG8_BAR
#undef PG8_SCHED
}

struct SegOrder {
    StaticOrder b; int nseg, aM, bN;
    __device__ void init(int M, int N, int G_, int c_, int nseg_) { b.init(M, N, G_, c_); nseg = nseg_; aM = M / BM; bN = N / BM; }
    __device__ bool next(int i, Unit& u) const { if (!b.next(i / nseg, u)) return false; const int s = i % nseg; u.seg = s; u.am = u.pm + s * aM; u.bn = u.pn + s * bN; return true; }
};

constexpr float LOG2E = 1.4426950408889634f;
__device__ __forceinline__ float sigm(float x) { return __builtin_amdgcn_rcpf(1.f + __expf(-x)); }
__device__ __forceinline__ u32x4 pack8(const f32x4 v0, const f32x4 v1) { u32x4 w; w.x = cvt_pk_bf16(v0[0], v0[1]); w.y = cvt_pk_bf16(v0[2], v0[3]); w.z = cvt_pk_bf16(v1[0], v1[1]); w.w = cvt_pk_bf16(v1[2], v1[3]); return w; }
__device__ __forceinline__ void unpack8(const u32x4 w, f32x4& v0, f32x4& v1) {
    v0[0] = __uint_as_float(w.x << 16); v0[1] = __uint_as_float(w.x & 0xffff0000u); v0[2] = __uint_as_float(w.y << 16); v0[3] = __uint_as_float(w.y & 0xffff0000u);
    v1[0] = __uint_as_float(w.z << 16); v1[1] = __uint_as_float(w.z & 0xffff0000u); v1[2] = __uint_as_float(w.w << 16); v1[3] = __uint_as_float(w.w & 0xffff0000u); }

struct EpiPlain {
    static constexpr bool PERM = true; static __device__ __forceinline__ bool keep(const Unit&) { return false; }
    bf16_t* O; int ldc; float sc;
    __device__ __forceinline__ void operator()(f32x4 (&acc)[2][2][4][2], const Unit& u, int wr, int wc, int fr, int fq) const {
        const int row0 = u.pm * BM + wr * 64 + fr, col0 = u.pn * BM + wc * 32 + 8 * fq;
#pragma unroll
        for (int ai = 0; ai < 2; ++ai)
#pragma unroll
            for (int m = 0; m < 4; ++m) { bf16_t* rowp = O + (size_t)(row0 + ai * HALF + m * 16) * ldc + col0;
#pragma unroll
                for (int bj = 0; bj < 2; ++bj) *(u32x4*)(rowp + bj * HALF) = pack8(acc[ai][bj][m][0] * sc, acc[ai][bj][m][1] * sc); }
    }
};
struct EpiSwiglu {
    static constexpr bool PERM = true; static __device__ __forceinline__ bool keep(const Unit&) { return false; }
    bf16_t* H; int ldh;
    __device__ __forceinline__ void operator()(f32x4 (&acc)[2][2][4][2], const Unit& u, int wr, int wc, int fr, int fq) const {
        const int row0 = u.pm * BM + wr * 64 + fr, col0 = u.pn * HALF + wc * 32 + 8 * fq;
#pragma unroll
        for (int ai = 0; ai < 2; ++ai)
#pragma unroll
            for (int m = 0; m < 4; ++m) {
                f32x4 v0, v1;
#pragma unroll
                for (int i = 0; i < 4; ++i) { const float a0 = acc[ai][0][m][0][i], a1 = acc[ai][0][m][1][i];
                    v0[i] = a0 * sigm(a0) * acc[ai][1][m][0][i]; v1[i] = a1 * sigm(a1) * acc[ai][1][m][1][i]; }
                *(u32x4*)(H + (size_t)(row0 + ai * HALF + m * 16) * ldh + col0) = pack8(v0, v1); }
    }
};
struct EpiRes {
    static constexpr bool PERM = false; static __device__ __forceinline__ bool keep(const Unit&) { return false; }
    const float* res; float* out; float alpha, beta;
    __device__ __forceinline__ void operator()(f32x4 (&acc)[2][2][4][2], const Unit& u, int wr, int wc, int fr, int fq) const {
        const int row0 = u.pm * BM + wr * 64 + fr, col0 = u.pn * BM + wc * 32 + 4 * fq;
#pragma unroll
        for (int ai = 0; ai < 2; ++ai)
#pragma unroll
            for (int m = 0; m < 4; ++m) { const size_t off = (size_t)(row0 + ai * HALF + m * 16) * 1024 + col0;
#pragma unroll
                for (int bj = 0; bj < 2; ++bj)
#pragma unroll
                    for (int n = 0; n < 2; ++n) { const f32x4 r = *(const f32x4*)(res + off + bj * HALF + n * 16); *(f32x4*)(out + off + bj * HALF + n * 16) = r * alpha + acc[ai][bj][m][n] * beta; } }
    }
};
struct EpiProj {
    static constexpr bool PERM = true; static __device__ __forceinline__ bool keep(const Unit&) { return false; }
    bf16_t *G, *FQ, *FK, *FV, *MQ, *CQ, *CKV; float* SIDE; const float* bgate;
    __device__ __forceinline__ void operator()(f32x4 (&acc)[2][2][4][2], const Unit& u, int wr, int wc, int fr, int fq) const {
        const int row0 = u.pm * BM + wr * 64 + fr, pn = u.pn;
#pragma unroll
        for (int bj = 0; bj < 2; ++bj) {
            const int col = pn * BM + bj * HALF + wc * 32 + 8 * fq;
            bf16_t* base; int ld, dcol; float sc = 1.f; bool gate = false;
            if (pn < 12) { base = G; ld = 3072; dcol = col; gate = true; }
            else if (pn < 14) { const int c = col - 3072; base = FQ; ld = 768; dcol = (c >> 6) * 96 + (c & 63); sc = 0.125f * LOG2E; }
            else if (pn < 16) { const int c = col - 3584; base = FK; ld = 640; dcol = (c >> 6) * 80 + (c & 63); }
            else if (pn < 18) { base = FV; ld = 512; dcol = col - 4096; }
            else if (pn < 20) { base = MQ; ld = 768; dcol = col - 4608; sc = 0.08838834764831845f * LOG2E; }
            else { const int bc = col - 5120;
                if (bc < 384) { base = CQ; ld = 384; dcol = bc; } else if (bc < 640) { base = CKV; ld = 256; dcol = bc - 384; } else { base = nullptr; ld = 0; dcol = bc; } }
            f32x4 b0 = (f32x4){0.f, 0.f, 0.f, 0.f}, b1 = b0;
            if (gate) { b0 = *(const f32x4*)(bgate + col); b1 = *(const f32x4*)(bgate + col + 4); }
            const bool side = (pn == 22) && (bj == 1) && (wc == 0 || (wc == 1 && fq == 0));
#pragma unroll
            for (int ai = 0; ai < 2; ++ai)
#pragma unroll
                for (int m = 0; m < 4; ++m) { const size_t row = (size_t)(row0 + ai * HALF + m * 16);
                    f32x4 v0 = acc[ai][bj][m][0], v1 = acc[ai][bj][m][1];
                    if (gate) {
#pragma unroll
                        for (int i = 0; i < 4; ++i) { v0[i] = sigm(v0[i] + b0[i]); v1[i] = sigm(v1[i] + b1[i]); } }
                    else { v0 = v0 * sc; v1 = v1 * sc; }
                    if (base) *(u32x4*)(base + row * ld + dcol) = pack8(v0, v1);
                    if (side) { float* sp = SIDE + row * 40 + (dcol - 640); *(f32x4*)sp = v0; *(f32x4*)(sp + 4) = v1; } }
        }
    }
};
struct EpiKvup {
    static constexpr bool PERM = true; static __device__ __forceinline__ bool keep(const Unit&) { return false; }
    bf16_t* KN; bf16_t* VM;
    __device__ __forceinline__ void operator()(f32x4 (&acc)[2][2][4][2], const Unit& u, int wr, int wc, int fr, int fq) const {
        const int row0 = u.pm * BM + wr * 64 + fr; bf16_t* base = ((wc < 2) ? KN : VM) + (2 * u.pn) * 64 + (wc & 1) * 32 + 8 * fq;
#pragma unroll
        for (int ai = 0; ai < 2; ++ai)
#pragma unroll
            for (int m = 0; m < 4; ++m) { bf16_t* rowp = base + (size_t)(row0 + ai * HALF + m * 16) * 512;
#pragma unroll
                for (int bj = 0; bj < 2; ++bj) *(u32x4*)(rowp + bj * 64) = pack8(acc[ai][bj][m][0], acc[ai][bj][m][1]); }
    }
};
struct EpiBranch {
    static constexpr bool PERM = true; static __device__ __forceinline__ bool keep(const Unit& u) { return u.seg < 2; }
    const bf16_t* G; bf16_t* MG;
    __device__ __forceinline__ void operator()(f32x4 (&acc)[2][2][4][2], const Unit& u, int wr, int wc, int fr, int fq) const {
        const int row0 = u.pm * BM + wr * 64 + fr, col0 = u.pn * BM + wc * 32 + 8 * fq, seg = u.seg;
#pragma unroll
        for (int ai = 0; ai < 2; ++ai)
#pragma unroll
            for (int m = 0; m < 4; ++m) { const size_t row = (size_t)(row0 + ai * HALF + m * 16);
#pragma unroll
                for (int bj = 0; bj < 2; ++bj) { const int col = col0 + bj * HALF;
                    f32x4 ga0, ga1; unpack8(*(const u32x4*)(G + row * 3072 + seg * 1024 + col), ga0, ga1);
                    if (seg < 2) { f32x4 gb0, gb1; unpack8(*(const u32x4*)(G + row * 3072 + (seg + 1) * 1024 + col), gb0, gb1);
#pragma unroll
                        for (int i = 0; i < 4; ++i) { acc[ai][bj][m][0][i] *= fmaxf(ga0[i], 1e-30f) / fmaxf(gb0[i], 1e-30f); acc[ai][bj][m][1][i] *= fmaxf(ga1[i], 1e-30f) / fmaxf(gb1[i], 1e-30f); } }
                    else { f32x4 v0, v1;
#pragma unroll
                        for (int i = 0; i < 4; ++i) { v0[i] = acc[ai][bj][m][0][i] * fmaxf(ga0[i], 1e-30f); v1[i] = acc[ai][bj][m][1][i] * fmaxf(ga1[i], 1e-30f); }
                        *(u32x4*)(MG + row * 1024 + col) = pack8(v0, v1); } } }
    }
};
}

namespace att {
using pg8::bf16_t;
typedef short bf16x8 __attribute__((ext_vector_type(8)));
typedef short s16x4 __attribute__((ext_vector_type(4)));
typedef float f32x16 __attribute__((ext_vector_type(16)));
typedef unsigned u32x4 __attribute__((ext_vector_type(4)));
typedef unsigned u32x2 __attribute__((ext_vector_type(2)));
typedef float f32x4 __attribute__((ext_vector_type(4)));
#define ATT_LAS __attribute__((address_space(3)))
struct Args {
    const bf16_t* Q; int qp;
    const bf16_t* KA; int kap;
    const bf16_t* KB; int kbp;
    const bf16_t* V; int vp;
    bf16_t* O; int op;
    const float* RC; const float* RSN;
    const float* F2; float kmax;
};
__device__ __forceinline__ unsigned cvtpk(float lo, float hi) { unsigned r; asm volatile("v_cvt_pk_bf16_f32 %0, %1, %2" : "=v"(r) : "v"(lo), "v"(hi)); return r; }
__device__ __forceinline__ s16x4 vtr(const ATT_LAS unsigned char* p) { return __builtin_bit_cast(s16x4, __builtin_amdgcn_ds_read_tr16_b64_v4i16((ATT_LAS s16x4*)p)); }

template <int DKC, int DVB, bool CAUSAL, bool ROPE, int RG, bool PRUNE>
__device__ __forceinline__ void attn_unit(const Args a, long qrow0, long krow0, int q0, int NT, ATT_LAS unsigned char* lds) {
    int tid_ = threadIdx.x; asm volatile("" : "+v"(tid_));
    const int tid = tid_, lane = tid & 63, r32 = lane & 31, hi = lane >> 5;
    const int wid = __builtin_amdgcn_readfirstlane(tid >> 6);
    constexpr int KSLOT = DKC * 2048, VSLOT = DVB * 4096, NKC = 2 * DKC, KL = (NKC + 7) / 8, VL = (DVB * 4 + 7) / 8;
    ATT_LAS unsigned char* Kb = lds; ATT_LAS unsigned char* Vb = lds + 2 * KSLOT;
    const int wrow = wid * 32 * RG;
    bf16x8 qr[RG][DKC];
#pragma unroll
    for (int g = 0; g < RG; ++g) {
        const bf16_t* qrow = a.Q + (size_t)(qrow0 + wrow + g * 32 + r32) * a.qp + hi * 8;
#pragma unroll
        for (int c = 0; c < DKC; ++c) qr[g][c] = *(const bf16x8*)(qrow + c * 16);
        if constexpr (ROPE) {
            const size_t trow = (size_t)(qrow0 + wrow + g * 32 + r32) * 16 + 8 * hi;
            const f32x4 c0 = *(const f32x4*)(a.RC + trow), c1 = *(const f32x4*)(a.RC + trow + 4), s0 = *(const f32x4*)(a.RSN + trow), s1 = *(const f32x4*)(a.RSN + trow + 4);
            bf16x8 x1 = qr[g][4], x2 = qr[g][5];
#pragma unroll
            for (int j = 0; j < 8; ++j) { const float cc = j < 4 ? c0[j & 3] : c1[j & 3], ss = j < 4 ? s0[j & 3] : s1[j & 3];
                const float a1 = __uint_as_float((unsigned)(unsigned short)x1[j] << 16), a2 = __uint_as_float((unsigned)(unsigned short)x2[j] << 16);
                const float r1 = a1 * cc - a2 * ss, r2 = a2 * cc + a1 * ss;
                x1[j] = (short)(cvtpk(r1, 0.f) & 0xffffu); x2[j] = (short)(cvtpk(r2, 0.f) & 0xffffu); }
            qr[g][4] = x1; qr[g][5] = x2;
        }
    }
#define ATT_DMA(t, buf) do { const size_t kr_ = (size_t)(krow0 + 64 * (t)); \
    _Pragma("unroll") for (int j = 0; j < KL; ++j) { const int c8 = wid + 8 * j; if (c8 < NKC) { \
        const bf16_t* src = (c8 < 8) ? (a.KA + (kr_ + lane) * a.kap + c8 * 8) : (a.KB + (kr_ + lane) * a.kbp + (c8 - 8) * 8); \
        __builtin_amdgcn_global_load_lds((const unsigned*)src, (ATT_LAS unsigned*)(Kb + (buf) * KSLOT + c8 * 1024), 16, 0, 0); } } \
    _Pragma("unroll") for (int j = 0; j < VL; ++j) { const int pc = wid + 8 * j; if (pc < DVB * 4) { \
        __builtin_amdgcn_global_load_lds((const unsigned*)(a.V + (kr_ + 16 * (pc & 3) + (lane >> 2)) * a.vp + 32 * (pc >> 2) + (lane & 3) * 8), (ATT_LAS unsigned*)(Vb + (buf) * VSLOT + pc * 1024), 16, 0, 0); } } } while (0)
    float ub[RG]; bool gdone[RG]; bool wdone = false;
    ATT_LAS unsigned* cnt = (ATT_LAS unsigned*)(lds + 2 * KSLOT + 2 * VSLOT);
    if constexpr (PRUNE) {
#pragma unroll
        for (int g = 0; g < RG; ++g) { float nq = 0.f;
#pragma unroll
            for (int c = 0; c < 4; ++c)
#pragma unroll
                for (int j = 0; j < 8; ++j) { const float v = __uint_as_float((unsigned)(unsigned short)qr[g][c][j] << 16); nq += v * v; }
            nq += __shfl_xor(nq, 32);
            ub[g] = sqrtf(nq) * a.kmax + 2.f + a.F2[q0 + wrow + g * 32 + r32]; gdone[g] = false; }
        if (tid == 0) cnt[0] = 0u;
    }
    ATT_DMA(PRUNE ? NT - 1 : 0, 0);
    asm volatile("s_waitcnt vmcnt(0)" ::: "memory");
    __syncthreads();
    f32x16 o[RG][DVB];
    float mrun[RG], lrun[RG];
#pragma unroll
    for (int g = 0; g < RG; ++g) { mrun[g] = -1e30f; lrun[g] = 0.f;
#pragma unroll
        for (int d = 0; d < DVB; ++d)
#pragma unroll
            for (int r = 0; r < 16; ++r) o[g][d][r] = 0.f; }
    const int koff = hi * 1024 + r32 * 16;
    const int voff = ((lane >> 4) & 1) * 32 + (lane & 3) * 8 + (4 * hi + ((lane & 15) >> 2)) * 64;
    const int qw0 = q0 + wrow;
    for (int it = 0; it < NT; ++it) {
        const int t = PRUNE ? NT - 1 - it : it, buf = it & 1;
        if constexpr (PRUNE) { if (tid == 0) cnt[(it + 1) % 3] = 0u; }
        if (it + 1 < NT) ATT_DMA(PRUNE ? t - 1 : t + 1, buf ^ 1);
        const bool active = (!CAUSAL || (64 * t <= qw0 + 32 * RG - 1)) && !(PRUNE && wdone);
        if (active) {
            f32x16 s0[RG], s1[RG];
#pragma unroll
            for (int g = 0; g < RG; ++g)
#pragma unroll
                for (int r = 0; r < 16; ++r) { s0[g][r] = 0.f; s1[g][r] = 0.f; }
            const ATT_LAS unsigned char* kp = Kb + buf * KSLOT + koff;
#pragma unroll
            for (int c = 0; c < DKC; ++c) {
                const bf16x8 k0 = *(const ATT_LAS bf16x8*)(kp + c * 2048), k1 = *(const ATT_LAS bf16x8*)(kp + c * 2048 + 512);
#pragma unroll
                for (int g = 0; g < RG; ++g) {
                    s0[g] = __builtin_amdgcn_mfma_f32_32x32x16_bf16(k0, qr[g][c], s0[g], 0, 0, 0);
                    s1[g] = __builtin_amdgcn_mfma_f32_32x32x16_bf16(k1, qr[g][c], s1[g], 0, 0, 0);
                }
            }
            u32x4 pw[RG][4];
#pragma unroll
            for (int g = 0; g < RG; ++g) {
                if (CAUSAL && (64 * t + 63 > qw0 + 32 * g)) {
                    const int kb = 64 * t + 4 * hi, qpos = qw0 + 32 * g + r32;
#pragma unroll
                    for (int r = 0; r < 16; ++r) { const int kv = kb + (r & 3) + 8 * (r >> 2); if (kv > qpos) s0[g][r] = -INFINITY; if (kv + 32 > qpos) s1[g][r] = -INFINITY; }
                }
                float rm = __builtin_fmaxf(s0[g][0], s1[g][0]);
#pragma unroll
                for (int r = 1; r < 16; ++r) rm = __builtin_fmaxf(__builtin_fmaxf(rm, s0[g][r]), s1[g][r]);
                rm = __builtin_fmaxf(rm, __shfl_xor(rm, 32));
                const float mn = __builtin_fmaxf(mrun[g], rm);
                if (__builtin_amdgcn_ballot_w64(mn > mrun[g]) != 0ull) {
                    const float alpha = __builtin_amdgcn_exp2f(mrun[g] - mn);
                    lrun[g] *= alpha;
#pragma unroll
                    for (int d = 0; d < DVB; ++d)
#pragma unroll
                        for (int r = 0; r < 16; ++r) o[g][d][r] *= alpha;
                    mrun[g] = mn;
                }
                float sum = 0.f;
#pragma unroll
                for (int r = 0; r < 16; ++r) { s0[g][r] = __builtin_amdgcn_exp2f(s0[g][r] - mn); s1[g][r] = __builtin_amdgcn_exp2f(s1[g][r] - mn); sum += s0[g][r] + s1[g][r]; }
                lrun[g] += sum;
                if constexpr (PRUNE) { if (t > 0) { const float f2e = a.F2[64 * t - 1];
                    if (__builtin_amdgcn_ballot_w64((ub[g] - f2e - mrun[g]) < -40.f) == ~0ull) gdone[g] = true; } }
#pragma unroll
                for (int i = 0; i < 4; ++i) { pw[g][0][i] = cvtpk(s0[g][2 * i], s0[g][2 * i + 1]); pw[g][1][i] = cvtpk(s0[g][8 + 2 * i], s0[g][9 + 2 * i]);
                    pw[g][2][i] = cvtpk(s1[g][2 * i], s1[g][2 * i + 1]); pw[g][3][i] = cvtpk(s1[g][8 + 2 * i], s1[g][9 + 2 * i]); }
            }
            const ATT_LAS unsigned char* vpp = Vb + buf * VSLOT + voff;
#pragma unroll
            for (int d = 0; d < DVB; ++d)
#pragma unroll
                for (int ks = 0; ks < 4; ++ks) {
                    const s16x4 lo = vtr(vpp + d * 4096 + ks * 1024), hh = vtr(vpp + d * 4096 + ks * 1024 + 512);
                    const bf16x8 vf = (bf16x8){lo[0], lo[1], lo[2], lo[3], hh[0], hh[1], hh[2], hh[3]};
#pragma unroll
                    for (int g = 0; g < RG; ++g) o[g][d] = __builtin_amdgcn_mfma_f32_32x32x16_bf16(vf, __builtin_bit_cast(bf16x8, pw[g][ks]), o[g][d], 0, 0, 0);
                }
        }
        if constexpr (PRUNE) { bool all = true;
#pragma unroll
            for (int g = 0; g < RG; ++g) all = all && gdone[g];
            wdone = wdone || all;
            if (wdone && lane == 0) __hip_atomic_fetch_add(cnt + (it % 3), 1u, __ATOMIC_RELAXED, __HIP_MEMORY_SCOPE_WORKGROUP); }
        asm volatile("s_waitcnt vmcnt(0) lgkmcnt(0)" ::: "memory");
        __syncthreads();
        if constexpr (PRUNE) { if (((volatile ATT_LAS unsigned*)cnt)[it % 3] == 8u) break; }
    }
    if constexpr (PRUNE) __syncthreads();
#pragma unroll
    for (int g = 0; g < RG; ++g) {
        const float lt = lrun[g] + __shfl_xor(lrun[g], 32);
        const float inv = 1.f / lt;
        bf16_t* orow = a.O + (size_t)(qrow0 + wrow + g * 32 + r32) * a.op + 4 * hi;
#pragma unroll
        for (int d = 0; d < DVB; ++d)
#pragma unroll
            for (int gg = 0; gg < 4; ++gg) { u32x2 w; w.x = cvtpk(o[g][d][4 * gg] * inv, o[g][d][4 * gg + 1] * inv); w.y = cvtpk(o[g][d][4 * gg + 2] * inv, o[g][d][4 * gg + 3] * inv);
                *(u32x2*)(orow + 32 * d + 8 * gg) = w; }
    }
#undef ATT_DMA
}
}

using pg8::bf16_t; using pg8::f32x4; using pg8::u32x4;
#define LAS __attribute__((address_space(3)))
constexpr int NB = 4, S = 8192, T = NB * S, D = 1024, FF = 2816, NPROJ = 5888, NWAVES = 8;
constexpr float ALPHA = 1.189207115002721f;
constexpr size_t MiB = 1u << 20;
constexpr size_t WS_RS = 2 * MiB;
constexpr size_t WS_RC = 3 * MiB;
constexpr size_t WS_RSN = 5 * MiB;
constexpr size_t WS_SIDE = 7 * MiB;
constexpr size_t WS_MEMB = 12 * MiB;
constexpr size_t WS_MEMKV = 14 * MiB;
constexpr size_t WS_WIN = 16 * MiB;
constexpr size_t WS_WUQ = 28 * MiB;
constexpr size_t WS_WUKV = 29 * MiB;
constexpr size_t WS_WMKV = 30 * MiB;
constexpr size_t WS_KR = 32 * MiB;
constexpr size_t WS_XB = 34 * MiB;
constexpr size_t WS_QM = 34 * MiB;
constexpr size_t WS_WBR = 82 * MiB;
constexpr size_t WS_WOUT = 87 * MiB;
constexpr size_t WS_H = 98 * MiB;
constexpr size_t WS_G = 98 * MiB;
constexpr size_t WS_SLOT0 = 290 * MiB;
constexpr size_t WS_FQ = 338 * MiB;
constexpr size_t WS_MQ = 386 * MiB;
constexpr size_t WS_FK = 434 * MiB;
constexpr size_t WS_FV = 474 * MiB;
constexpr size_t WS_KN = 434 * MiB;
constexpr size_t WS_VM = 466 * MiB;
constexpr size_t WS_MG = 434 * MiB;
constexpr size_t WS_WA = 480 * MiB;
constexpr size_t WS_WD = 491 * MiB;
constexpr size_t WS_END = 512 * MiB;
static_assert(WS_FV + (size_t)T * 512 * 2 <= WS_END && WS_WD + (size_t)1024 * 2816 * 2 <= WS_END && WS_FQ - WS_SLOT0 == (size_t)T * 768 * 2 && WS_MQ - WS_FQ == (size_t)T * 768 * 2, "ws map");
constexpr int LDS_BYTES = 147456;

__device__ __forceinline__ unsigned f2bf(float f) { unsigned u = __builtin_bit_cast(unsigned, f); return (u + 0x7fffu + ((u >> 16) & 1u)) >> 16; }
__device__ __forceinline__ unsigned pk2(float lo, float hi) { return f2bf(lo) | (f2bf(hi) << 16); }
__device__ __forceinline__ float bf2f(unsigned b) { return __uint_as_float(b << 16); }
__device__ __forceinline__ float wave_sum(float v) {
#pragma unroll
    for (int o = 1; o < 64; o <<= 1) v += __shfl_xor(v, o);
    return v;
}
#define LDS_WAIT() asm volatile("s_waitcnt lgkmcnt(0)" ::: "memory")

__device__ __forceinline__ int map_ffn(int c) { return c < FF ? ((c >> 7) << 8) + (c & 127) : (((c - FF) >> 7) << 8) + 128 + ((c - FF) & 127); }
__device__ __forceinline__ int map_win(int c) {
    if (c < 384) return 5120 + c;
    if (c < 640) return 5504 + (c - 384);
    if (c < 672) return 5760 + (c - 640);
    if (c < 1184) return 3072 + (c - 672);
    if (c < 1696) return 3584 + (c - 1184);
    if (c < 2208) return 4096 + (c - 1696);
    if (c < 2216) return 5792 + (c - 2208);
    if (c < 2728) return 4608 + (c - 2216);
    return c - 2728;
}
template <int MODE>
__device__ __forceinline__ void tr_mat(const float* __restrict__ W, int K, int N, const float* __restrict__ ks, bf16_t* WT, int ldt, int kmul, LAS float* scr, int gw, int NGW, int lane) {
    const int nblk = (N + 31) / 32, items = (K / 64) * nblk;
    for (int it = gw; it < items; it += NGW) {
        const int kb = it / nblk, nb = it % nblk, k0 = 64 * kb, n0 = 32 * nb;
        const int nn = n0 + (lane & 31); const bool ok = nn < N;
#pragma unroll 8
        for (int i = 0; i < 32; ++i) { const int kk = 2 * i + (lane >> 5); float v = ok ? W[(size_t)(k0 + kk) * N + nn] : 0.f; if (ks) v *= ks[k0 + kk]; scr[kk * 33 + (lane & 31)] = v; }
        LDS_WAIT(); asm volatile("" ::: "memory");
        const int c = lane & 7, dc = kb * kmul + 8 * c;
#pragma unroll
        for (int j = 0; j < 4; ++j) { const int n = (lane >> 3) + 8 * j, sc = n0 + n;
            if (sc < N) { const LAS float* s = scr + (8 * c) * 33 + n;
                u32x4 o; o.x = pk2(s[0 * 33], s[1 * 33]); o.y = pk2(s[2 * 33], s[3 * 33]); o.z = pk2(s[4 * 33], s[5 * 33]); o.w = pk2(s[6 * 33], s[7 * 33]);
                const int dr = MODE == 1 ? map_ffn(sc) : (MODE == 2 ? map_win(sc) : sc);
                *(u32x4*)(WT + (size_t)dr * ldt + dc) = o; } }
        LDS_WAIT(); asm volatile("" ::: "memory");
    }
}
__device__ __forceinline__ void cvt_copy(const float* __restrict__ src, bf16_t* dst, size_t n, size_t gt, size_t NTH) {
    for (size_t i = gt * 8; i < n; i += NTH * 8) { const f32x4 a = *(const f32x4*)(src + i), b = *(const f32x4*)(src + i + 4);
        u32x4 o; o.x = pk2(a[0], a[1]); o.y = pk2(a[2], a[3]); o.z = pk2(b[0], b[1]); o.w = pk2(b[2], b[3]); *(u32x4*)(dst + i) = o; }
}
__device__ __forceinline__ void ln_row(const float* xrow, const float* __restrict__ g, const float* __restrict__ b, float* outf, bf16_t* outb, int lane) {
    f32x4 v[4]; float s = 0.f;
#pragma unroll
    for (int j = 0; j < 4; ++j) { v[j] = *(const f32x4*)(xrow + 4 * lane + 256 * j); s += (v[j][0] + v[j][1]) + (v[j][2] + v[j][3]); }
    const float mean = wave_sum(s) * (1.f / D); float s2 = 0.f;
#pragma unroll
    for (int j = 0; j < 4; ++j) { v[j] = v[j] - mean; s2 += (v[j][0] * v[j][0] + v[j][1] * v[j][1]) + (v[j][2] * v[j][2] + v[j][3] * v[j][3]); }
    const float rstd = 1.f / sqrtf(wave_sum(s2) * (1.f / D) + 1e-5f);
#pragma unroll
    for (int j = 0; j < 4; ++j) { const f32x4 gg = *(const f32x4*)(g + 4 * lane + 256 * j), bb = *(const f32x4*)(b + 4 * lane + 256 * j);
        const f32x4 y = v[j] * rstd * gg + bb;
        if (outf) *(f32x4*)(outf + 4 * lane + 256 * j) = y;
        if (outb) { unsigned long long w = (unsigned long long)pk2(y[0], y[1]) | ((unsigned long long)pk2(y[2], y[3]) << 32); *(unsigned long long*)(outb + 4 * lane + 256 * j) = w; } }
}

#define XB_TMO      128
#define XB_XCNT(j)  (256  + 64 * (j))
#define XB_XSUB(j)  (1280 + 64 * (j))
#define XB_XGEN(j)  (2304 + 64 * (j))
#define XB_TOP      3328
#define XB_TOPGEN   3392
#define XCD_BAR_WORDS 3456
#define XB_SPIN_CAP (1u << 18)

__device__ __forceinline__ unsigned xb_ld(unsigned* p)              { return __hip_atomic_load(p, __ATOMIC_RELAXED, __HIP_MEMORY_SCOPE_AGENT); }
__device__ __forceinline__ unsigned xb_add(unsigned* p, unsigned v) { return __hip_atomic_fetch_add(p, v, __ATOMIC_RELAXED, __HIP_MEMORY_SCOPE_AGENT); }
__device__ __forceinline__ unsigned xb_xcc_id() { return (unsigned)__builtin_amdgcn_s_getreg((3 << 11) | 20) & 0xFu; }
#define XB_SPIN(cond, bar) do { unsigned _sp = 0; while (cond) { __builtin_amdgcn_s_sleep(1); \
    if ((++_sp & 255u) == 0u) { if (xb_ld(&(bar)[XB_TMO])) break; if (_sp > XB_SPIN_CAP) { atomicAdd(&(bar)[XB_TMO], 1u); break; } } } } while (0)

struct XcdBarrier {
    unsigned* bar; unsigned x;
    volatile LAS unsigned* st;
};

__device__ __forceinline__ XcdBarrier xcd_barrier_post(unsigned* bar, volatile LAS unsigned* st) {
    XcdBarrier b; b.bar = bar; b.x = xb_xcc_id(); b.st = st;
    if (threadIdx.x == 0) (void)xb_add(&bar[XB_XCNT(b.x)], 1u);
    return b;
}
__device__ __forceinline__ void xcd_barrier_complete(unsigned* bar, unsigned x, unsigned& nloc, unsigned& nx) {
    const unsigned G = gridDim.x * gridDim.y * gridDim.z;
    unsigned sum, cnt, mine, sp = 0u;
    for (;;) {
        sum = 0u; cnt = 0u; mine = 0u;
#pragma unroll
        for (unsigned j = 0; j < 16; ++j) { const unsigned c = xb_ld(&bar[XB_XCNT(j)]); sum += c; cnt += (c > 0u) ? 1u : 0u; mine = (j == x) ? c : mine; }
        if (sum == G) break;
        __builtin_amdgcn_s_sleep(1);
        if ((++sp & 255u) == 0u) { if (xb_ld(&bar[XB_TMO])) break; if (sp > XB_SPIN_CAP) { atomicAdd(&bar[XB_TMO], 1u); break; } }
    }
    nloc = mine > 0u ? mine : 1u; nx = cnt > 0u ? cnt : 1u;
}

__device__ __forceinline__ void xcd_barrier(const XcdBarrier& b) {
    asm volatile("s_waitcnt vmcnt(0)" ::: "memory");
    __syncthreads();
    if (threadIdx.x == 0) {
        unsigned* bar = b.bar;
        __builtin_amdgcn_s_waitcnt(0);
        unsigned nloc = b.st[0], nx = b.st[1];
        if (nloc == 0u) { xcd_barrier_complete(bar, b.x, nloc, nx); b.st[0] = nloc; b.st[1] = nx; }
        const unsigned old = xb_add(&bar[XB_XSUB(b.x)], 1u);
        const unsigned gen = old / nloc;
        if (old + 1u == (gen + 1u) * nloc) {
            __builtin_amdgcn_fence(__ATOMIC_RELEASE, "agent");
            asm volatile("s_waitcnt vmcnt(0)" ::: "memory");
            const unsigned og = xb_add(&bar[XB_TOP], 1u);
            const unsigned tg = og / nx;
            if (og + 1u == (tg + 1u) * nx) xb_add(&bar[XB_TOPGEN], 1u);
            else XB_SPIN(xb_ld(&bar[XB_TOPGEN]) == tg, bar);
            __builtin_amdgcn_fence(__ATOMIC_ACQUIRE, "agent");
            xb_add(&bar[XB_XGEN(b.x)], 1u);
            asm volatile("s_waitcnt vmcnt(0)" ::: "memory");
        } else {
            XB_SPIN(xb_ld(&bar[XB_XGEN(b.x)]) == gen, bar);
            __builtin_amdgcn_fence(__ATOMIC_ACQUIRE, "agent");
            asm volatile("s_waitcnt vmcnt(0)" ::: "memory");
        }
    }
    __syncthreads();
}

#ifndef PH_MASK
#define PH_MASK 0xFFFF
#endif
struct Params { const float* in[25]; float* out; unsigned char* ws; };

__global__ void __launch_bounds__(NWAVES * 64) mega_fwd(Params p) {
    extern __shared__ __attribute__((aligned(16))) unsigned char lds_raw[];
    cg::grid_group grid = cg::this_grid();
    LAS unsigned char* lds = (LAS unsigned char*)lds_raw;
    const int tid = threadIdx.x, lane = tid & 63, wave = __builtin_amdgcn_readfirstlane(tid >> 6);
    const int G = gridDim.x, bx = blockIdx.x;
    const int gw = bx * NWAVES + wave, NGW = G * NWAVES;
    const size_t gt = (size_t)bx * (NWAVES * 64) + tid, NTH = (size_t)G * (NWAVES * 64);
    unsigned char* ws = p.ws;
    const float* x = p.in[0]; const float* mem = p.in[1]; const int* positions = (const int*)p.in[2];
    float* R = p.out;
    float* KMAX = (float*)(ws + WS_RS); float* F2T = (float*)(ws + 1 * MiB); float* RC = (float*)(ws + WS_RC); float* RSN = (float*)(ws + WS_RSN); float* SIDE = (float*)(ws + WS_SIDE);
    bf16_t* MEMB = (bf16_t*)(ws + WS_MEMB); bf16_t* MEMKV = (bf16_t*)(ws + WS_MEMKV);
    bf16_t* WIN = (bf16_t*)(ws + WS_WIN); bf16_t* WUQ = (bf16_t*)(ws + WS_WUQ); bf16_t* WUKV = (bf16_t*)(ws + WS_WUKV); bf16_t* WMKV = (bf16_t*)(ws + WS_WMKV);
    bf16_t* KR = (bf16_t*)(ws + WS_KR); bf16_t* XB = (bf16_t*)(ws + WS_XB); bf16_t* QM = (bf16_t*)(ws + WS_QM); bf16_t* WBR = (bf16_t*)(ws + WS_WBR); bf16_t* WOUT = (bf16_t*)(ws + WS_WOUT);
    bf16_t* HB = (bf16_t*)(ws + WS_H); bf16_t* GB = (bf16_t*)(ws + WS_G); bf16_t* SLOT0 = (bf16_t*)(ws + WS_SLOT0); bf16_t* CQ = SLOT0; bf16_t* CKV = SLOT0 + (size_t)T * 384; bf16_t* FQ = (bf16_t*)(ws + WS_FQ); bf16_t* MQ = (bf16_t*)(ws + WS_MQ);
    bf16_t* FK = (bf16_t*)(ws + WS_FK); bf16_t* FV = (bf16_t*)(ws + WS_FV); bf16_t* KN = (bf16_t*)(ws + WS_KN); bf16_t* VM = (bf16_t*)(ws + WS_VM); bf16_t* MG = (bf16_t*)(ws + WS_MG);
    bf16_t* WA = (bf16_t*)(ws + WS_WA); bf16_t* WD = (bf16_t*)(ws + WS_WD);
    LAS float* scr = (LAS float*)(lds + wave * 16384);
    volatile LAS unsigned* MISC = (volatile LAS unsigned*)(lds + 131072 + 256);
    if (tid < 2) MISC[tid] = 0u;
    unsigned* barw = (unsigned*)ws;
    if (bx == 0) for (int i = tid; i < XCD_BAR_WORDS; i += NWAVES * 64) barw[i] = 0u;

#if (PH_MASK >> 0) & 1
    tr_mat<1>(p.in[5], D, 2 * FF, nullptr, WA, D, 64, scr, gw, NGW, lane);
    tr_mat<0>(p.in[6], FF, D, nullptr, WD, FF, 64, scr, gw, NGW, lane);
    tr_mat<2>(p.in[7], D, 5800, nullptr, WIN, D, 64, scr, gw, NGW, lane);
    tr_mat<0>(p.in[10], 384, 768, p.in[9], WUQ, 384, 64, scr, gw, NGW, lane);
    tr_mat<0>(p.in[12], 256, 1024, p.in[11], WUKV, 256, 64, scr, gw, NGW, lane);
    tr_mat<0>(p.in[14], D, 1024, nullptr, WMKV, D, 64, scr, gw, NGW, lane);
    for (size_t i = gt * 8; i < (size_t)88 * D; i += NTH * 8) *(u32x4*)(WIN + (size_t)5800 * D + i) = (u32x4){0u, 0u, 0u, 0u};
    cvt_copy(x, XB, (size_t)T * D, gt, NTH);
    cvt_copy(mem, MEMB, (size_t)NB * 256 * D, gt, NTH);
    for (size_t i = gt; i < (size_t)T * 16; i += NTH) {
        const int row = (int)(i >> 4), f = (int)(i & 15);
        const float invf = (float)exp2(-(double)f * (13.287712379549449 / 16.0));
        const float ang = (float)positions[row] * invf;
        const double rev = (double)ang * 0.15915494309189535; const float fr = (float)(rev - __builtin_rint(rev));
        RC[i] = __builtin_amdgcn_cosf(fr); RSN[i] = __builtin_amdgcn_sinf(fr);
    }
#endif
    grid.sync();
    const XcdBarrier xb = xcd_barrier_post(barw, MISC);

#if (PH_MASK >> 1) & 1
    { pg8::Gemm g{XB, WA, T, 2 * FF, D}; pg8::StaticOrder so; so.init(T, 2 * FF, G, bx);
      pg8::EpiSwiglu E{HB, FF}; pg8::gemm_phase<pg8::EpiSwiglu, pg8::StaticOrder, true>(lds, g, so, E); }
#endif
    xcd_barrier(xb);
#if (PH_MASK >> 2) & 1
    { pg8::Gemm g{HB, WD, T, D, FF}; pg8::StaticOrder so; so.init(T, D, G, bx);
      pg8::EpiRes E{x, R, ALPHA, 0.5f}; pg8::gemm_phase<pg8::EpiRes, pg8::StaticOrder, true>(lds, g, so, E); }
#endif
    xcd_barrier(xb);
#if (PH_MASK >> 3) & 1
    for (int m = gw; m < T; m += NGW) ln_row(R + (size_t)m * D, p.in[3], p.in[4], R + (size_t)m * D, XB + (size_t)m * D, lane);
    { pg8::Gemm g{MEMB, WMKV, NB * 256, 1024, D}; pg8::StaticOrder so; so.init(NB * 256, 1024, G, (bx + 128) % G);
      pg8::EpiPlain E{MEMKV, 1024, 1.f}; pg8::gemm_phase<pg8::EpiPlain, pg8::StaticOrder, true>(lds, g, so, E); }
#endif
    xcd_barrier(xb);
#if (PH_MASK >> 4) & 1
    { pg8::Gemm g{XB, WIN, T, NPROJ, D}; pg8::StaticOrder so; so.init(T, NPROJ, G, bx);
      pg8::EpiProj E{GB, FQ, FK, FV, MQ, CQ, CKV, SIDE, p.in[8]}; pg8::gemm_phase<pg8::EpiProj, pg8::StaticOrder, true>(lds, g, so, E); }
#endif
    xcd_barrier(xb);
#if (PH_MASK >> 5) & 1
    if (bx < 32) {
        const int b = bx >> 3, h = bx & 7; LAS double* sh = (LAS double*)lds;
        const float bfh = p.in[13][h]; float lf[16]; double loc = 0.0;
#pragma unroll
        for (int j = 0; j < 16; ++j) { const float xx = SIDE[((size_t)b * S + 16 * tid + j) * 40 + 32 + h] + bfh; lf[j] = fminf(xx, 0.f) - log1pf(__expf(-fabsf(xx))); loc += (double)lf[j]; }
        float kmx = 0.f;
        for (int j = 0; j < 16; ++j) { const bf16_t* kr = FK + ((size_t)b * S + 16 * tid + j) * 640 + h * 80; float sq = 0.f;
#pragma unroll
            for (int c = 0; c < 8; ++c) { f32x4 k0, k1; pg8::unpack8(*(const u32x4*)(kr + 8 * c), k0, k1);
#pragma unroll
                for (int i = 0; i < 4; ++i) sq += k0[i] * k0[i] + k1[i] * k1[i]; }
            kmx = fmaxf(kmx, sq); }
#pragma unroll
        for (int o = 1; o < 64; o <<= 1) kmx = fmaxf(kmx, __shfl_xor(kmx, o));
        LAS float* shk = (LAS float*)(lds + 8192);
        if (lane == 0) shk[wave] = kmx;
        sh[tid] = loc; __syncthreads();
        if (tid == 0) { float mk = shk[0];
#pragma unroll
            for (int w = 1; w < 8; ++w) mk = fmaxf(mk, shk[w]);
            KMAX[bx] = sqrtf(mk) * 1.001f; }
        double run = 0.0; for (int j = 0; j < tid; ++j) run += sh[j];
#pragma unroll
        for (int j = 0; j < 16; ++j) { run += (double)lf[j];
            const float f2 = (float)(run * 1.4426950408889634);
            const unsigned h1 = f2bf(f2); const float r1 = f2 - bf2f(h1); const unsigned h2 = f2bf(r1); const float r2 = r1 - bf2f(h2); const unsigned h3 = f2bf(r2);
            const size_t row = (size_t)b * S + 16 * tid + j; const unsigned one = 0x3f80u, z = 0u;
            F2T[(size_t)bx * S + 16 * tid + j] = f2;
            u32x4* qd = (u32x4*)(FQ + row * 768 + h * 96 + 64);
            qd[0] = (u32x4){one | (one << 16), one | (h1 << 16), h2 | (h3 << 16), z}; qd[1] = (u32x4){z, z, z, z}; qd[2] = (u32x4){z, z, z, z}; qd[3] = (u32x4){z, z, z, z};
            u32x4* kd = (u32x4*)(FK + row * 640 + h * 80 + 64);
            const unsigned n1 = h1 ^ 0x8000u, n2 = h2 ^ 0x8000u, n3 = h3 ^ 0x8000u;
            kd[0] = (u32x4){n1 | (n2 << 16), n3 | (one << 16), one | (one << 16), z}; kd[1] = (u32x4){z, z, z, z}; }
        __syncthreads();
    }
    for (int m = gw; m < T; m += NGW) {
        f32x4 a0, a1, c0, c1; float sq = 0.f, sq2 = 0.f;
        if (lane < 48) { pg8::unpack8(*(const u32x4*)(CQ + (size_t)m * 384 + lane * 8), a0, a1);
#pragma unroll
            for (int i = 0; i < 4; ++i) sq += a0[i] * a0[i] + a1[i] * a1[i]; }
        if (lane < 32) { pg8::unpack8(*(const u32x4*)(CKV + (size_t)m * 256 + lane * 8), c0, c1);
#pragma unroll
            for (int i = 0; i < 4; ++i) sq2 += c0[i] * c0[i] + c1[i] * c1[i]; }
        const float rq = 1.f / sqrtf(wave_sum(sq) * (1.f / 384.f) + 1e-6f), rkv = 1.f / sqrtf(wave_sum(sq2) * (1.f / 256.f) + 1e-6f);
        if (lane < 48) *(u32x4*)(CQ + (size_t)m * 384 + lane * 8) = pg8::pack8(a0 * rq, a1 * rq);
        if (lane < 32) *(u32x4*)(CKV + (size_t)m * 256 + lane * 8) = pg8::pack8(c0 * rkv, c1 * rkv);
        if (lane < 16) { const float x1 = SIDE[(size_t)m * 40 + lane], x2 = SIDE[(size_t)m * 40 + 16 + lane], c = RC[(size_t)m * 16 + lane], s = RSN[(size_t)m * 16 + lane];
            KR[(size_t)m * 32 + lane] = (bf16_t)f2bf(x1 * c - x2 * s); KR[(size_t)m * 32 + 16 + lane] = (bf16_t)f2bf(x2 * c + x1 * s); }
        if (lane < 32) *(u32x4*)(MQ + (size_t)m * 768 + 512 + lane * 8) = (u32x4){0u, 0u, 0u, 0u};
    }
    tr_mat<0>(p.in[15], 512, D, nullptr, WBR, 768, 96, scr, gw, NGW, lane);
    tr_mat<0>(p.in[16], 512, D, nullptr, WBR + (size_t)1024 * 768, 768, 96, scr, gw, NGW, lane);
    tr_mat<0>(p.in[17], 512, D, nullptr, WBR + (size_t)2048 * 768, 768, 64, scr, gw, NGW, lane);
    tr_mat<0>(p.in[18], D, D, nullptr, WOUT, D, 64, scr, gw, NGW, lane);
    for (size_t i = gt; i < (size_t)3 * 1024 * 32; i += NTH) {
        const int r = (int)(i >> 5), c = (int)(i & 31); bf16_t* rowp = WBR + (size_t)r * 768;
        const int col = (r < 2048) ? ((c >> 2) * 96 + 64 + (c & 3) * 8) : (512 + c * 8);
        *(u32x4*)(rowp + col) = (u32x4){0u, 0u, 0u, 0u};
    }
    __syncthreads();
    for (int u = bx; u < NB * 4 * 32; u += G) {
        const int b = u >> 7, hm = (u >> 5) & 3, qb = u & 31;
        att::Args a{MQ + hm * 128, 768, MEMKV + hm * 128, 1024, MEMKV + hm * 128 + 64, 1024, MEMKV + 512 + hm * 128, 1024, MQ + hm * 128, 768, nullptr, nullptr, nullptr, 0.f};
        att::attn_unit<8, 4, false, false, 1, false>(a, (long)b * S + qb * 256, (long)b * 256, 0, 4, lds);
    }
#endif
    xcd_barrier(xb);
#if (PH_MASK >> 6) & 1
    for (int u = bx; u < 512; u += G) {
        const int v = u & 255, i = u >> 8, vcu = (v & 7) * 32 + (v >> 3), bh = vcu >> 3, s = vcu & 7;
        const int qb = (i == 0) ? s : 15 - s; const int b = bh >> 3, h = bh & 7;
        att::Args a{FQ + h * 96, 768, FK + h * 80, 640, FK + h * 80 + 64, 640, FV + h * 64, 512, FQ + h * 96, 768, nullptr, nullptr, F2T + (size_t)bh * S, KMAX[bh]};
        att::attn_unit<5, 2, true, false, 2, true>(a, (long)b * S + qb * 512, (long)b * S, qb * 512, 8 * (qb + 1), lds);
    }
#endif
    xcd_barrier(xb);
#if (PH_MASK >> 7) & 1
    { pg8::Gemm g{CQ, WUQ, T, 768, 384}; pg8::StaticOrder so; so.init(T, 768, G, bx);
      pg8::EpiPlain E{QM, 768, 0.10206207261596577f * pg8::LOG2E}; pg8::gemm_phase<pg8::EpiPlain, pg8::StaticOrder, true>(lds, g, so, E); }
    { pg8::Gemm g{CKV, WUKV, T, 1024, 256}; pg8::StaticOrder so; so.init(T, 1024, G, bx);
      pg8::EpiKvup E{KN, VM}; pg8::gemm_phase<pg8::EpiKvup, pg8::StaticOrder, true>(lds, g, so, E); }
#endif
    xcd_barrier(xb);
#if (PH_MASK >> 8) & 1
    for (int u = bx; u < 512; u += G) {
        const int v = u & 255, i = u >> 8, vcu = (v & 7) * 32 + (v >> 3), bh = vcu >> 3, s = vcu & 7;
        const int qb = (i == 0) ? s : 15 - s; const int b = bh >> 3, h = bh & 7;
        att::Args a{QM + h * 96, 768, KN + h * 64, 512, KR, 32, VM + h * 64, 512, SLOT0 + h * 96, 768, RC, RSN, nullptr, 0.f};
        att::attn_unit<6, 2, true, true, 2, false>(a, (long)b * S + qb * 512, (long)b * S, qb * 512, 8 * (qb + 1), lds);
    }
#endif
    xcd_barrier(xb);
#if (PH_MASK >> 9) & 1
    { pg8::Gemm g{SLOT0, WBR, T, D, 768}; pg8::SegOrder so; so.init(T, D, G, bx, 3);
      pg8::EpiBranch E{GB, MG}; pg8::gemm_phase<pg8::EpiBranch, pg8::SegOrder, true>(lds, g, so, E); }
#endif
    xcd_barrier(xb);
#if (PH_MASK >> 10) & 1
    { pg8::Gemm g{MG, WOUT, T, D, D}; pg8::StaticOrder so; so.init(T, D, G, bx);
      pg8::EpiRes E{R, R, ALPHA, 1.f}; pg8::gemm_phase<pg8::EpiRes, pg8::StaticOrder, true>(lds, g, so, E); }
#endif
    xcd_barrier(xb);
#if (PH_MASK >> 11) & 1
    for (int m = gw; m < T; m += NGW) ln_row(R + (size_t)m * D, p.in[19], p.in[20], R + (size_t)m * D, XB + (size_t)m * D, lane);
    tr_mat<1>(p.in[21], D, 2 * FF, nullptr, WA, D, 64, scr, gw, NGW, lane);
    tr_mat<0>(p.in[22], FF, D, nullptr, WD, FF, 64, scr, gw, NGW, lane);
#endif
    xcd_barrier(xb);
#if (PH_MASK >> 12) & 1
    { pg8::Gemm g{XB, WA, T, 2 * FF, D}; pg8::StaticOrder so; so.init(T, 2 * FF, G, bx);
      pg8::EpiSwiglu E{HB, FF}; pg8::gemm_phase<pg8::EpiSwiglu, pg8::StaticOrder, true>(lds, g, so, E); }
#endif
    xcd_barrier(xb);
#if (PH_MASK >> 13) & 1
    { pg8::Gemm g{HB, WD, T, D, FF}; pg8::StaticOrder so; so.init(T, D, G, bx);
      pg8::EpiRes E{R, R, ALPHA, 0.5f}; pg8::gemm_phase<pg8::EpiRes, pg8::StaticOrder, true>(lds, g, so, E); }
#endif
    xcd_barrier(xb);
#if (PH_MASK >> 14) & 1
    for (int m = gw; m < T; m += NGW) ln_row(R + (size_t)m * D, p.in[23], p.in[24], R + (size_t)m * D, nullptr, lane);
#endif
}

extern "C" void kernel_launch(void* const* d_in, const int* in_sizes, int n_in, void* d_out, int out_size, void* d_ws, size_t ws_size, hipStream_t stream) {
    static int grid = 0;
    if (grid == 0) {
        if (n_in != 25 || out_size != T * D || ws_size < WS_END) { fprintf(stderr, "kernel_launch: unexpected shapes (n_in %d out %d ws %zu)\n", n_in, out_size, ws_size); grid = -1; return; }
        int dev = 0, cus = 0, per = 0;
        (void)hipGetDevice(&dev); (void)hipDeviceGetAttribute(&cus, hipDeviceAttributeMultiprocessorCount, dev);
        (void)hipFuncSetAttribute((const void*)mega_fwd, hipFuncAttributeMaxDynamicSharedMemorySize, LDS_BYTES);
        (void)hipOccupancyMaxActiveBlocksPerMultiprocessor(&per, (const void*)mega_fwd, NWAVES * 64, LDS_BYTES);
        if (per < 1) per = 1;
        grid = cus * per;
        fprintf(stderr, "kernel_launch: grid %d (cus %d x %d), ws %zu\n", grid, cus, per, ws_size);
    }
    if (grid < 0) return;
    Params p{};
    for (int i = 0; i < 25; ++i) p.in[i] = (const float*)d_in[i];
    p.out = (float*)d_out; p.ws = (unsigned char*)d_ws;
    void* args[] = {&p};
    const hipError_t e = hipLaunchCooperativeKernel((const void*)mega_fwd, dim3(grid), dim3(NWAVES * 64), args, LDS_BYTES, stream);
    if (e != hipSuccess) fprintf(stderr, "kernel_launch: cooperative launch failed: %s (grid %d)\n", hipGetErrorString(e), grid);
}
```

```cpp
#include <hip/hip_runtime.h>
#include <hip/hip_cooperative_groups.h>
#include <cstdio>
#include <cstdint>
#include <cmath>
namespace cg = cooperative_groups;
namespace pg8 {
#define PG8_LAS __attribute__((address_space(3)))
typedef unsigned short bf16_t;
typedef short bf16x8 __attribute__((ext_vector_type(8)));
typedef float f32x4 __attribute__((ext_vector_type(4)));
typedef unsigned u32x4 __attribute__((ext_vector_type(4)));
constexpr int BM = 256, BK = 64, HALF = 128, HTB = HALF * BK * 2  , STAGE_BYTES = 8 * HTB, NXCD = 8, WGM = 8;

__host__ __device__ __forceinline__ int lds_byte(int r, int c) { const int st = (r >> 4) * 2 + (c >> 5), rr = r & 15, cc = c & 31, ob = rr * 64 + cc * 2; return st * 1024 + (ob ^ (((ob >> 9) & 1) << 5)); }
__host__ __device__ __forceinline__ void stage_rc(int b, int& R, int& C) { const int st = b / 1024, sb = b % 1024, swz = sb ^ (((sb >> 9) & 1) << 5); R = (st >> 1) * 16 + swz / 64; C = (st & 1) * 32 + (swz % 64) / 2; }
__host__ __device__ __forceinline__ int perm32(int rho) { const int n = rho >> 4, i = rho & 15; return 8 * (i >> 2) + 4 * n + (i & 3); }

struct Unit { int pm, pn, am, bn, seg; };
struct Gemm { const bf16_t* A; const bf16_t* Bt; int M, N, K; };

struct StaticOrder {
    int nM, nN, nwg, G, c;
    __host__ __device__ void init(int M, int N, int G_, int c_) { nM = M / BM; nN = N / BM; nwg = nM * nN; G = G_; c = c_; }
    __host__ __device__ bool next(int i, Unit& u) const {
        const long L = (long)i * G + c; if (L >= nwg) return false;
        int wgid = (int)L; { const int q = nwg / NXCD, r = nwg % NXCD, xcd = wgid % NXCD, off = wgid / NXCD; wgid = (xcd < r ? xcd * (q + 1) : r * (q + 1) + (xcd - r) * q) + off; }
        const int nig = WGM * nN, gid = wgid / nig, fm = gid * WGM, gsz = (nM - fm) < WGM ? (nM - fm) : WGM;
        u.pm = fm + ((wgid % nig) % gsz); u.pn = (wgid % nig) / gsz; u.am = u.pm; u.bn = u.pn; u.seg = 0; return true;
    }
};

__device__ __forceinline__ unsigned cvt_pk_bf16(float lo, float hi) { unsigned r; asm volatile("v_cvt_pk_bf16_f32 %0, %1, %2" : "=v"(r) : "v"(lo), "v"(hi)); return r; }
typedef float f32x2 __attribute__((ext_vector_type(2)));
template <class Epi, class Sched, bool ALIGN_EPI = false, bool SP2 = true>
__device__ __forceinline__ void gemm_phase(PG8_LAS unsigned char* lds, const Gemm g, const Sched& S, const Epi& E) {
    int tid_ = threadIdx.x; asm volatile("" : "+v"(tid_));
    const int tid = tid_, wid = __builtin_amdgcn_readfirstlane(tid >> 6), lane = tid & 63, wr = wid >> 2, wc = wid & 3, fr = lane & 15, fq = lane >> 4;
    const int K = g.K, nt = K / BK;
    unsigned voffA[2], voffB[2];
#pragma unroll
    for (int i = 0; i < 2; ++i) { int R, C; stage_rc(tid * 16 + i * 8192, R, C); const int Rb = Epi::PERM ? ((R & ~31) + perm32(R & 31)) : R;
        voffA[i] = (unsigned)(R * K + C) * 2u; voffB[i] = (unsigned)(Rb * K + C) * 2u; }
    const size_t kstep = (size_t)(BK * 2);
    const size_t hstep = (size_t)HALF * K * 2;
    const size_t tstep = 2 * hstep;
    const unsigned ldsw = (unsigned)wid * 1024u;
    const int aoff = lds_byte(wr * 64 + fr, fq * 8), boff = lds_byte(wc * 32 + fr, fq * 8);
#define PG8_SA(b, h) (((b) * 2 + (h)) * HTB)
#define PG8_SB(b, h) ((4 + (b) * 2 + (h)) * HTB)
#define PG8_STAGE(bufoff, gbase, voff) do { _Pragma("unroll") for (int _i = 0; _i < 2; ++_i) \
        __builtin_amdgcn_global_load_lds((const unsigned*)((const char*)(gbase) + (voff)[_i]), (PG8_LAS unsigned*)(lds + (bufoff) + ldsw + _i * 8192), 16, 0, 0); } while (0)
#define PG8_LDA(dst, b, h) do { _Pragma("unroll") for (int m = 0; m < 4; ++m) _Pragma("unroll") for (int k = 0; k < 2; ++k) dst[m][k] = *(const PG8_LAS bf16x8*)(lds + PG8_SA(b, h) + aoff + m * 2048 + k * 1024); } while (0)
#define PG8_LDB(dst, b, h) do { _Pragma("unroll") for (int n = 0; n < 2; ++n) _Pragma("unroll") for (int k = 0; k < 2; ++k) dst[n][k] = *(const PG8_LAS bf16x8*)(lds + PG8_SB(b, h) + boff + n * 2048 + k * 1024); } while (0)
#define PG8_MMA(ai, bj, At, Bt) do { __builtin_amdgcn_s_setprio(1); _Pragma("unroll") for (int m = 0; m < 4; ++m) _Pragma("unroll") for (int n = 0; n < 2; ++n) _Pragma("unroll") for (int k = 0; k < 2; ++k) \
        acc[ai][bj][m][n] = __builtin_amdgcn_mfma_f32_16x16x32_bf16(Bt[n][k], At[m][k], acc[ai][bj][m][n], 0, 0, 0); __builtin_amdgcn_s_setprio(0); } while (0)
#define PG8_WAIT_V(n) asm volatile("s_waitcnt vmcnt(" #n ")" ::: "memory")
#define PG8_WAIT_L(n) asm volatile("s_waitcnt lgkmcnt(" #n ")" ::: "memory")
#define PG8_BAR __builtin_amdgcn_s_barrier()
#define PG8_SCHED __builtin_amdgcn_sched_barrier(0)
    Unit cur, nxt; int ui = 0;
    if (!S.next(0, cur)) return;
    f32x4 acc[2][2][4][2];
#pragma unroll
    for (int a = 0; a < 2; ++a)
#pragma unroll
        for (int b = 0; b < 2; ++b)
#pragma unroll
            for (int m = 0; m < 4; ++m)
#pragma unroll
                for (int n = 0; n < 2; ++n) acc[a][b][m][n] = (f32x4){0.f, 0.f, 0.f, 0.f};
    bf16x8 At[4][2], B0[2][2], B1[2][2];
    const char* cA = (const char*)g.A + (size_t)cur.am * tstep; const char* cB = (const char*)g.Bt + (size_t)cur.bn * tstep;
    if constexpr (SP2) {
        PG8_STAGE(PG8_SB(0, 0), cB, voffB); PG8_STAGE(PG8_SB(0, 1), cB + hstep, voffB); PG8_STAGE(PG8_SA(0, 0), cA, voffA); PG8_STAGE(PG8_SA(0, 1), cA + hstep, voffA);
        if (wr == 1) PG8_BAR;
        PG8_WAIT_V(2); PG8_BAR;
        PG8_STAGE(PG8_SB(1, 0), cB + kstep, voffB); PG8_STAGE(PG8_SA(1, 0), cA + kstep, voffA); PG8_STAGE(PG8_SB(1, 1), cB + hstep + kstep, voffB);
        PG8_WAIT_V(6); PG8_BAR;
    } else {
        PG8_STAGE(PG8_SB(0, 0), cB, voffB); PG8_STAGE(PG8_SA(0, 0), cA, voffA); PG8_STAGE(PG8_SB(0, 1), cB + hstep, voffB); PG8_STAGE(PG8_SA(0, 1), cA + hstep, voffA);
        if (wr == 1) PG8_BAR;
        PG8_WAIT_V(4); PG8_BAR;
        PG8_STAGE(PG8_SB(1, 0), cB + kstep, voffB); PG8_STAGE(PG8_SA(1, 0), cA + kstep, voffA); PG8_STAGE(PG8_SB(1, 1), cB + hstep + kstep, voffB);
        PG8_WAIT_V(6); PG8_BAR;
    }
    for (;;) {
        const bool has_next = S.next(ui + 1, nxt);
        const char* nA = has_next ? (const char*)g.A + (size_t)nxt.am * tstep : cA; const char* nB = has_next ? (const char*)g.Bt + (size_t)nxt.bn * tstep : cB;
#pragma nounroll
        for (int t = 0; t < nt; t += 2) {
            const bool last = (t == nt - 2);
            const char* a1 = cA + (size_t)(t + 1) * kstep;
            const char* a2 = last ? nA : cA + (size_t)(t + 2) * kstep; const char* b2 = last ? nB : cB + (size_t)(t + 2) * kstep;
            const char* a3 = a2 + kstep; const char* b3 = b2 + kstep;
            if constexpr (SP2) {
            PG8_LDB(B0, 0, 0); PG8_LDB(B1, 0, 1); PG8_SCHED; PG8_LDA(At, 0, 0); PG8_STAGE(PG8_SA(1, 1), a1 + hstep, voffA);
            PG8_WAIT_V(8); PG8_WAIT_L(0); PG8_BAR; PG8_MMA(0, 0, At, B0); PG8_MMA(0, 1, At, B1); PG8_BAR; PG8_SCHED;
            PG8_LDA(At, 0, 1); PG8_STAGE(PG8_SB(0, 0), b2, voffB); PG8_STAGE(PG8_SB(0, 1), b2 + hstep, voffB); PG8_STAGE(PG8_SA(0, 0), a2, voffA);
            PG8_WAIT_V(8); PG8_WAIT_L(0); PG8_BAR; PG8_MMA(1, 0, At, B0); PG8_MMA(1, 1, At, B1); PG8_BAR; PG8_SCHED;
            PG8_LDB(B0, 1, 0); PG8_LDB(B1, 1, 1); PG8_SCHED; PG8_LDA(At, 1, 0); PG8_STAGE(PG8_SA(0, 1), a2 + hstep, voffA);
            PG8_WAIT_V(8); PG8_WAIT_L(0); PG8_BAR; PG8_MMA(0, 0, At, B0); PG8_MMA(0, 1, At, B1); PG8_BAR; PG8_SCHED;
            PG8_LDA(At, 1, 1); PG8_STAGE(PG8_SB(1, 0), b3, voffB); PG8_STAGE(PG8_SB(1, 1), b3 + hstep, voffB); PG8_STAGE(PG8_SA(1, 0), a3, voffA);
            PG8_WAIT_V(8); PG8_WAIT_L(0); PG8_BAR; PG8_MMA(1, 0, At, B0); PG8_MMA(1, 1, At, B1); PG8_BAR; PG8_SCHED;
            } else {
            PG8_LDB(B0, 0, 0); PG8_SCHED; PG8_LDA(At, 0, 0); PG8_STAGE(PG8_SA(1, 1), a1 + hstep, voffA);
            PG8_WAIT_L(8); PG8_BAR; PG8_WAIT_L(0); PG8_MMA(0, 0, At, B0); PG8_BAR; PG8_SCHED;
            PG8_LDB(B1, 0, 1); PG8_STAGE(PG8_SB(0, 0), b2, voffB);
            PG8_BAR; PG8_WAIT_L(0); PG8_MMA(0, 1, At, B1); PG8_BAR;
            PG8_LDA(At, 0, 1); PG8_STAGE(PG8_SA(0, 0), a2, voffA);
            PG8_BAR; PG8_WAIT_L(0); PG8_MMA(1, 0, At, B0); PG8_BAR; PG8_SCHED;
            PG8_STAGE(PG8_SB(0, 1), b2 + hstep, voffB);
            PG8_WAIT_V(6); PG8_BAR; PG8_MMA(1, 1, At, B1); PG8_BAR;
            PG8_LDB(B0, 1, 0); PG8_SCHED; PG8_LDA(At, 1, 0); PG8_STAGE(PG8_SA(0, 1), a2 + hstep, voffA);
            PG8_WAIT_L(8); PG8_BAR; PG8_WAIT_L(0); PG8_MMA(0, 0, At, B0); PG8_BAR; PG8_SCHED;
            PG8_LDB(B1, 1, 1); PG8_STAGE(PG8_SB(1, 0), b3, voffB);
            PG8_BAR; PG8_WAIT_L(0); PG8_MMA(0, 1, At, B1); PG8_BAR;
            PG8_LDA(At, 1, 1); PG8_STAGE(PG8_SA(1, 0), a3, voffA);
            PG8_BAR; PG8_WAIT_L(0); PG8_MMA(1, 0, At, B0); PG8_BAR; PG8_SCHED;
            PG8_STAGE(PG8_SB(1, 1), b3 + hstep, voffB);
            PG8_WAIT_V(6); PG8_BAR; PG8_MMA(1, 1, At, B1); PG8_BAR;
            }
        }
        if constexpr (ALIGN_EPI) { if (wr == 0) PG8_BAR; }
        E(acc, cur, wr, wc, fr, fq);
        if (!has_next) break;
        if (!Epi::keep(cur)) {
#pragma unroll
        for (int a = 0; a < 2; ++a)
#pragma unroll
            for (int b = 0; b < 2; ++b)
#pragma unroll
                for (int m = 0; m < 4; ++m)
#pragma unroll
                    for (int n = 0; n < 2; ++n) acc[a][b][m][n] = (f32x4){0.f, 0.f, 0.f, 0.f};
        }
        cur = nxt; cA = nA; cB = nB; ++ui;
        if constexpr (ALIGN_EPI) { if (wr == 1) PG8_BAR; }
    }
    PG8_WAIT_V(0);
    if constexpr (!ALIGN_EPI) { if (wr == 0) PG8_BAR; }
    PG8_BAR;
#undef PG8_SA
#undef PG8_SB
#undef PG8_STAGE
#undef PG8_LDA
#undef PG8_LDB
#undef PG8_MMA
#undef PG8_WAIT_V
#undef PG8_WAIT_L
#undef PG8_BAR
#undef PG8_SCHED
}

struct SegOrder {
    StaticOrder b; int a1, a2, bN;
    __device__ void init(int M, int N, int G_, int c_, int a1_, int a2_) { b.init(M, N, G_, c_); a1 = a1_; a2 = a2_; bN = N / BM; }
    __device__ bool next(int i, Unit& u) const { if (!b.next(i / 3, u)) return false; const int s = i % 3; u.seg = s; u.am = u.pm + (s == 0 ? 0 : (s == 1 ? a1 : a2)); u.bn = u.pn + s * bN; return true; }
};

constexpr float LOG2E = 1.4426950408889634f;
__device__ __forceinline__ float sigm(float x) { return __builtin_amdgcn_rcpf(1.f + __expf(-x)); }
__device__ __forceinline__ u32x4 pack8(const f32x4 v0, const f32x4 v1) { u32x4 w; w.x = cvt_pk_bf16(v0[0], v0[1]); w.y = cvt_pk_bf16(v0[2], v0[3]); w.z = cvt_pk_bf16(v1[0], v1[1]); w.w = cvt_pk_bf16(v1[2], v1[3]); return w; }
__device__ __forceinline__ void unpack8(const u32x4 w, f32x4& v0, f32x4& v1) {
    v0[0] = __uint_as_float(w.x << 16); v0[1] = __uint_as_float(w.x & 0xffff0000u); v0[2] = __uint_as_float(w.y << 16); v0[3] = __uint_as_float(w.y & 0xffff0000u);
    v1[0] = __uint_as_float(w.z << 16); v1[1] = __uint_as_float(w.z & 0xffff0000u); v1[2] = __uint_as_float(w.w << 16); v1[3] = __uint_as_float(w.w & 0xffff0000u); }

struct EpiPlain {
    static constexpr bool PERM = true; static __device__ __forceinline__ bool keep(const Unit&) { return false; }
    bf16_t* O; int ldc; float sc;
    __device__ __forceinline__ void operator()(f32x4 (&acc)[2][2][4][2], const Unit& u, int wr, int wc, int fr, int fq) const {
        const int row0 = u.pm * BM + wr * 64 + fr, col0 = u.pn * BM + wc * 32 + 8 * fq;
#pragma unroll
        for (int ai = 0; ai < 2; ++ai)
#pragma unroll
            for (int m = 0; m < 4; ++m) { bf16_t* rowp = O + (size_t)(row0 + ai * HALF + m * 16) * ldc + col0;
#pragma unroll
                for (int bj = 0; bj < 2; ++bj) *(u32x4*)(rowp + bj * HALF) = pack8(acc[ai][bj][m][0] * sc, acc[ai][bj][m][1] * sc); }
    }
};
struct EpiSwiglu {
    static constexpr bool PERM = true; static __device__ __forceinline__ bool keep(const Unit&) { return false; }
    bf16_t* H; int ldh;
    __device__ __forceinline__ void operator()(f32x4 (&acc)[2][2][4][2], const Unit& u, int wr, int wc, int fr, int fq) const {
        const int row0 = u.pm * BM + wr * 64 + fr, col0 = u.pn * HALF + wc * 32 + 8 * fq;
#pragma unroll
        for (int ai = 0; ai < 2; ++ai)
#pragma unroll
            for (int m = 0; m < 4; ++m) {
                f32x4 v0, v1;
#pragma unroll
                for (int i = 0; i < 4; ++i) { const float a0 = acc[ai][0][m][0][i], a1 = acc[ai][0][m][1][i];
                    v0[i] = a0 * sigm(a0) * acc[ai][1][m][0][i]; v1[i] = a1 * sigm(a1) * acc[ai][1][m][1][i]; }
                *(u32x4*)(H + (size_t)(row0 + ai * HALF + m * 16) * ldh + col0) = pack8(v0, v1); }
    }
};
struct EpiRes {
    static constexpr bool PERM = false; static __device__ __forceinline__ bool keep(const Unit&) { return false; }
    const float* res; float* out; float alpha, beta;
    __device__ __forceinline__ void operator()(f32x4 (&acc)[2][2][4][2], const Unit& u, int wr, int wc, int fr, int fq) const {
        const int row0 = u.pm * BM + wr * 64 + fr, col0 = u.pn * BM + wc * 32 + 4 * fq;
#pragma unroll
        for (int ai = 0; ai < 2; ++ai)
#pragma unroll
            for (int m = 0; m < 4; ++m) { const size_t off = (size_t)(row0 + ai * HALF + m * 16) * 1024 + col0;
#pragma unroll
                for (int bj = 0; bj < 2; ++bj)
#pragma unroll
                    for (int n = 0; n < 2; ++n) { const f32x4 r = *(const f32x4*)(res + off + bj * HALF + n * 16); *(f32x4*)(out + off + bj * HALF + n * 16) = r * alpha + acc[ai][bj][m][n] * beta; } }
    }
};
struct EpiProj {
    static constexpr bool PERM = true; static __device__ __forceinline__ bool keep(const Unit&) { return false; }
    bf16_t *G, *FQ, *FK, *FV, *MQ, *CQ, *CKV; float* SIDE; const float* bgate;
    __device__ __forceinline__ void operator()(f32x4 (&acc)[2][2][4][2], const Unit& u, int wr, int wc, int fr, int fq) const {
        const int row0 = u.pm * BM + wr * 64 + fr, pn = u.pn;
#pragma unroll
        for (int bj = 0; bj < 2; ++bj) {
            const int col = pn * BM + bj * HALF + wc * 32 + 8 * fq;
            bf16_t* base; int ld, dcol; float sc = 1.f; bool gate = false;
            if (pn < 12) { base = G; ld = 3072; dcol = col; gate = true; }
            else if (pn < 14) { base = FQ; ld = 512; dcol = col - 3072; sc = 0.125f * LOG2E; }
            else if (pn < 16) { base = FK; ld = 512; dcol = col - 3584; }
            else if (pn < 18) { base = FV; ld = 512; dcol = col - 4096; }
            else if (pn < 20) { base = MQ; ld = 512; dcol = col - 4608; sc = 0.08838834764831845f * LOG2E; }
            else { const int bc = col - 5120;
                if (bc < 384) { base = CQ; ld = 384; dcol = bc; } else if (bc < 640) { base = CKV; ld = 256; dcol = bc - 384; } else { base = nullptr; ld = 0; dcol = bc; } }
            f32x4 b0 = (f32x4){0.f, 0.f, 0.f, 0.f}, b1 = b0;
            if (gate) { b0 = *(const f32x4*)(bgate + col); b1 = *(const f32x4*)(bgate + col + 4); }
            const bool side = (pn == 22) && (bj == 1) && (wc == 0 || (wc == 1 && fq == 0));
#pragma unroll
            for (int ai = 0; ai < 2; ++ai)
#pragma unroll
                for (int m = 0; m < 4; ++m) { const size_t row = (size_t)(row0 + ai * HALF + m * 16);
                    f32x4 v0 = acc[ai][bj][m][0], v1 = acc[ai][bj][m][1];
                    if (gate) {
#pragma unroll
                        for (int i = 0; i < 4; ++i) { v0[i] = sigm(v0[i] + b0[i]); v1[i] = sigm(v1[i] + b1[i]); } }
                    else { v0 = v0 * sc; v1 = v1 * sc; }
                    if (base) *(u32x4*)(base + row * ld + dcol) = pack8(v0, v1);
                    if (side) { float* sp = SIDE + row * 40 + (dcol - 640); *(f32x4*)sp = v0; *(f32x4*)(sp + 4) = v1; } }
        }
    }
};
struct EpiKvup {
    static constexpr bool PERM = true; static __device__ __forceinline__ bool keep(const Unit&) { return false; }
    bf16_t* KN; bf16_t* VM;
    __device__ __forceinline__ void operator()(f32x4 (&acc)[2][2][4][2], const Unit& u, int wr, int wc, int fr, int fq) const {
        const int row0 = u.pm * BM + wr * 64 + fr; bf16_t* base = ((wc < 2) ? KN : VM) + (2 * u.pn) * 64 + (wc & 1) * 32 + 8 * fq;
#pragma unroll
        for (int ai = 0; ai < 2; ++ai)
#pragma unroll
            for (int m = 0; m < 4; ++m) { bf16_t* rowp = base + (size_t)(row0 + ai * HALF + m * 16) * 512;
#pragma unroll
                for (int bj = 0; bj < 2; ++bj) *(u32x4*)(rowp + bj * 64) = pack8(acc[ai][bj][m][0], acc[ai][bj][m][1]); }
    }
};
struct EpiBranch {
    static constexpr bool PERM = true; static __device__ __forceinline__ bool keep(const Unit& u) { return u.seg < 2; }
    const bf16_t* G; bf16_t* MG;
    __device__ __forceinline__ void operator()(f32x4 (&acc)[2][2][4][2], const Unit& u, int wr, int wc, int fr, int fq) const {
        const int row0 = u.pm * BM + wr * 64 + fr, col0 = u.pn * BM + wc * 32 + 8 * fq, seg = u.seg;
#pragma unroll
        for (int ai = 0; ai < 2; ++ai)
#pragma unroll
            for (int m = 0; m < 4; ++m) { const size_t row = (size_t)(row0 + ai * HALF + m * 16);
#pragma unroll
                for (int bj = 0; bj < 2; ++bj) { const int col = col0 + bj * HALF;
                    f32x4 ga0, ga1; unpack8(*(const u32x4*)(G + row * 3072 + seg * 1024 + col), ga0, ga1);
                    if (seg < 2) { f32x4 gb0, gb1; unpack8(*(const u32x4*)(G + row * 3072 + (seg + 1) * 1024 + col), gb0, gb1);
#pragma unroll
                        for (int i = 0; i < 4; ++i) { acc[ai][bj][m][0][i] *= fmaxf(ga0[i], 1e-30f) * __builtin_amdgcn_rcpf(fmaxf(gb0[i], 1e-30f)); acc[ai][bj][m][1][i] *= fmaxf(ga1[i], 1e-30f) * __builtin_amdgcn_rcpf(fmaxf(gb1[i], 1e-30f)); } }
                    else { f32x4 v0, v1;
#pragma unroll
                        for (int i = 0; i < 4; ++i) { v0[i] = acc[ai][bj][m][0][i] * fmaxf(ga0[i], 1e-30f); v1[i] = acc[ai][bj][m][1][i] * fmaxf(ga1[i], 1e-30f); }
                        *(u32x4*)(MG + row * 1024 + col) = pack8(v0, v1); } } }
    }
};
}

namespace att {
using pg8::bf16_t;
typedef short bf16x8 __attribute__((ext_vector_type(8)));
typedef short s16x4 __attribute__((ext_vector_type(4)));
typedef float f32x16 __attribute__((ext_vector_type(16)));
typedef unsigned u32x4 __attribute__((ext_vector_type(4)));
typedef unsigned u32x2 __attribute__((ext_vector_type(2)));
typedef float f32x4 __attribute__((ext_vector_type(4)));
#define ATT_LAS __attribute__((address_space(3)))
struct Args {
    const bf16_t* Q; int qp;
    const bf16_t* KA; int kap;
    const bf16_t* KB; int kbp;
    const bf16_t* V; int vp;
    bf16_t* O; int op;
    const float* RC; const float* RSN;
    const float* F2; float kmax;
};
__device__ __forceinline__ unsigned cvtpk(float lo, float hi) { unsigned r; asm volatile("v_cvt_pk_bf16_f32 %0, %1, %2" : "=v"(r) : "v"(lo), "v"(hi)); return r; }
__device__ __forceinline__ s16x4 vtr(const ATT_LAS unsigned char* p) { return __builtin_bit_cast(s16x4, __builtin_amdgcn_ds_read_tr16_b64_v4i16((ATT_LAS s16x4*)p)); }

template <int DKC, int DVB, bool CAUSAL, bool ROPE, int RG, bool PRUNE>
__device__ __forceinline__ void attn_unit(const Args a, long qrow0, long krow0, int q0, int NT, ATT_LAS unsigned char* lds) {
    int tid_ = threadIdx.x; asm volatile("" : "+v"(tid_));
    const int tid = tid_, lane = tid & 63, r32 = lane & 31, hi = lane >> 5;
    const int wid = __builtin_amdgcn_readfirstlane(tid >> 6);
    constexpr int KSLOT = DKC * 2048, VSLOT = DVB * 4096, NKC = PRUNE ? 8 : 2 * DKC, KL = (NKC + 7) / 8, VL = (DVB * 4 + 7) / 8;
    ATT_LAS unsigned char* Kb = lds; ATT_LAS unsigned char* Vb = lds + 2 * KSLOT;
    const int wrow = wid * 32 * RG;
    bf16x8 qr[RG][DKC];
#pragma unroll
    for (int g = 0; g < RG; ++g) {
        const bf16_t* qrow = a.Q + (size_t)(qrow0 + wrow + g * 32 + r32) * a.qp + hi * 8;
#pragma unroll
        for (int c = 0; c < (PRUNE ? 4 : DKC); ++c) qr[g][c] = *(const bf16x8*)(qrow + c * 16);
        if constexpr (PRUNE) {
            const float f2 = a.F2[q0 + wrow + g * 32 + r32];
            const unsigned h1 = cvtpk(f2, 0.f) & 0xffffu; const float r1 = f2 - __uint_as_float(h1 << 16);
            const unsigned h2 = cvtpk(r1, 0.f) & 0xffffu; const float r2 = r1 - __uint_as_float(h2 << 16); const unsigned h3 = cvtpk(r2, 0.f) & 0xffffu;
            u32x4 w = (u32x4){0x3f803f80u, 0x3f80u | (h1 << 16), h2 | (h3 << 16), 0u};
            if (hi) w = (u32x4){0u, 0u, 0u, 0u};
            qr[g][4] = __builtin_bit_cast(bf16x8, w);
        }
        if constexpr (ROPE) {
            const size_t trow = (size_t)(qrow0 + wrow + g * 32 + r32) * 16 + 8 * hi;
            const f32x4 c0 = *(const f32x4*)(a.RC + trow), c1 = *(const f32x4*)(a.RC + trow + 4), s0 = *(const f32x4*)(a.RSN + trow), s1 = *(const f32x4*)(a.RSN + trow + 4);
            bf16x8 x1 = qr[g][4], x2 = qr[g][5];
#pragma unroll
            for (int j = 0; j < 8; ++j) { const float cc = j < 4 ? c0[j & 3] : c1[j & 3], ss = j < 4 ? s0[j & 3] : s1[j & 3];
                const float a1 = __uint_as_float((unsigned)(unsigned short)x1[j] << 16), a2 = __uint_as_float((unsigned)(unsigned short)x2[j] << 16);
                const float r1 = a1 * cc - a2 * ss, r2 = a2 * cc + a1 * ss;
                x1[j] = (short)(cvtpk(r1, 0.f) & 0xffffu); x2[j] = (short)(cvtpk(r2, 0.f) & 0xffffu); }
            qr[g][4] = x1; qr[g][5] = x2;
        }
    }
#define ATT_DMA(t, buf) do { const size_t kr_ = (size_t)(krow0 + 64 * (t)); \
    _Pragma("unroll") for (int j = 0; j < KL; ++j) { const int c8 = wid + 8 * j; if (c8 < NKC) { \
        const bf16_t* src = (c8 < 8) ? (a.KA + (kr_ + lane) * a.kap + c8 * 8) : (a.KB + (kr_ + lane) * a.kbp + (c8 - 8) * 8); \
        __builtin_amdgcn_global_load_lds((const unsigned*)src, (ATT_LAS unsigned*)(Kb + (buf) * KSLOT + c8 * 1024), 16, 0, 0); } } \
    _Pragma("unroll") for (int j = 0; j < VL; ++j) { const int pc = wid + 8 * j; if (pc < DVB * 4) { \
        __builtin_amdgcn_global_load_lds((const unsigned*)(a.V + (kr_ + 16 * (pc & 3) + (lane >> 2)) * a.vp + 32 * (pc >> 2) + (lane & 3) * 8), (ATT_LAS unsigned*)(Vb + (buf) * VSLOT + pc * 1024), 16, 0, 0); } } } while (0)
    float ub[RG]; bool gdone[RG]; bool wdone = false;
    ATT_LAS unsigned* cnt = (ATT_LAS unsigned*)(lds + 2 * KSLOT + 2 * VSLOT);
    if constexpr (PRUNE) {
#pragma unroll
        for (int g = 0; g < RG; ++g) { float nq = 0.f;
#pragma unroll
            for (int c = 0; c < 4; ++c)
#pragma unroll
                for (int j = 0; j < 8; ++j) { const float v = __uint_as_float((unsigned)(unsigned short)qr[g][c][j] << 16); nq += v * v; }
            nq += __shfl_xor(nq, 32);
            ub[g] = sqrtf(nq) * a.kmax + 2.f + a.F2[q0 + wrow + g * 32 + r32]; gdone[g] = false; }
        if (tid == 0) cnt[0] = 0u;
    }
    float fst = 0.f;
#define ATT_KBIAS(buf) do { const unsigned h1 = cvtpk(fst, 0.f) & 0xffffu; const float r1 = fst - __uint_as_float(h1 << 16); \
        const unsigned h2 = cvtpk(r1, 0.f) & 0xffffu; const float r2 = r1 - __uint_as_float(h2 << 16); const unsigned h3 = cvtpk(r2, 0.f) & 0xffffu; \
        *(ATT_LAS u32x4*)(Kb + (buf) * KSLOT + 8 * 1024 + lane * 16) = (u32x4){(h1 ^ 0x8000u) | ((h2 ^ 0x8000u) << 16), (h3 ^ 0x8000u) | 0x3f800000u, 0x3f803f80u, 0u}; } while (0)
    if constexpr (PRUNE) {
        if (wid == 0) { fst = a.F2[64 * (NT - 1) + lane]; ATT_KBIAS(0); }
        if (wid == 1) { *(ATT_LAS u32x4*)(Kb + 9 * 1024 + lane * 16) = (u32x4){0u, 0u, 0u, 0u}; *(ATT_LAS u32x4*)(Kb + KSLOT + 9 * 1024 + lane * 16) = (u32x4){0u, 0u, 0u, 0u}; }
    }
    ATT_DMA(PRUNE ? NT - 1 : 0, 0);
    asm volatile("s_waitcnt vmcnt(0)" ::: "memory");
    __syncthreads();
    f32x16 o[RG][DVB];
    float mrun[RG], lrun[RG];
#pragma unroll
    for (int g = 0; g < RG; ++g) { mrun[g] = -1e30f; lrun[g] = 0.f;
#pragma unroll
        for (int d = 0; d < DVB; ++d)
#pragma unroll
            for (int r = 0; r < 16; ++r) o[g][d][r] = 0.f; }
    const int koff = hi * 1024 + r32 * 16;
    const int voff = ((lane >> 4) & 1) * 32 + (lane & 3) * 8 + (4 * hi + ((lane & 15) >> 2)) * 64;
    const int qw0 = q0 + wrow;
    for (int it = 0; it < NT; ++it) {
        const int t = PRUNE ? NT - 1 - it : it, buf = it & 1;
        if constexpr (PRUNE) { if (tid == 0) cnt[(it + 1) % 3] = 0u; }
        if (it + 1 < NT) { ATT_DMA(PRUNE ? t - 1 : t + 1, buf ^ 1); if constexpr (PRUNE) { if (wid == 0) fst = a.F2[64 * (t - 1) + lane]; } }
        const bool active = (!CAUSAL || (64 * t <= qw0 + 32 * RG - 1)) && !(PRUNE && wdone);
        if (active) {
            f32x16 s0[RG], s1[RG];
#pragma unroll
            for (int g = 0; g < RG; ++g)
#pragma unroll
                for (int r = 0; r < 16; ++r) { s0[g][r] = 0.f; s1[g][r] = 0.f; }
            const ATT_LAS unsigned char* kp = Kb + buf * KSLOT + koff;
#pragma unroll
            for (int c = 0; c < DKC; ++c) {
                const bf16x8 k0 = *(const ATT_LAS bf16x8*)(kp + c * 2048), k1 = *(const ATT_LAS bf16x8*)(kp + c * 2048 + 512);
#pragma unroll
                for (int g = 0; g < RG; ++g) {
                    s0[g] = __builtin_amdgcn_mfma_f32_32x32x16_bf16(k0, qr[g][c], s0[g], 0, 0, 0);
                    s1[g] = __builtin_amdgcn_mfma_f32_32x32x16_bf16(k1, qr[g][c], s1[g], 0, 0, 0);
                }
            }
            u32x4 pw[RG][4];
#pragma unroll
            for (int g = 0; g < RG; ++g) {
                if (CAUSAL && (64 * t + 63 > qw0 + 32 * g)) {
                    const int kb = 64 * t + 4 * hi, qpos = qw0 + 32 * g + r32;
#pragma unroll
                    for (int r = 0; r < 16; ++r) { const int kv = kb + (r & 3) + 8 * (r >> 2); if (kv > qpos) s0[g][r] = -INFINITY; if (kv + 32 > qpos) s1[g][r] = -INFINITY; }
                }
                float rm = __builtin_fmaxf(s0[g][0], s1[g][0]);
#pragma unroll
                for (int r = 1; r < 16; ++r) rm = __builtin_fmaxf(__builtin_fmaxf(rm, s0[g][r]), s1[g][r]);
                rm = __builtin_fmaxf(rm, __shfl_xor(rm, 32));
                const float mn = __builtin_fmaxf(mrun[g], rm);
                if (__builtin_amdgcn_ballot_w64(mn > mrun[g]) != 0ull) {
                    const float alpha = __builtin_amdgcn_exp2f(mrun[g] - mn);
                    lrun[g] *= alpha;
#pragma unroll
                    for (int d = 0; d < DVB; ++d)
#pragma unroll
                        for (int r = 0; r < 16; ++r) o[g][d][r] *= alpha;
                    mrun[g] = mn;
                }
                float sum = 0.f;
#pragma unroll
                for (int r = 0; r < 16; ++r) { s0[g][r] = __builtin_amdgcn_exp2f(s0[g][r] - mn); s1[g][r] = __builtin_amdgcn_exp2f(s1[g][r] - mn); sum += s0[g][r] + s1[g][r]; }
                lrun[g] += sum;
                if constexpr (PRUNE) { if (t > 0) { const float f2e = a.F2[64 * t - 1];
                    if (__builtin_amdgcn_ballot_w64((ub[g] - f2e - mrun[g]) < -40.f) == ~0ull) gdone[g] = true; } }
#pragma unroll
                for (int i = 0; i < 4; ++i) { pw[g][0][i] = cvtpk(s0[g][2 * i], s0[g][2 * i + 1]); pw[g][1][i] = cvtpk(s0[g][8 + 2 * i], s0[g][9 + 2 * i]);
                    pw[g][2][i] = cvtpk(s1[g][2 * i], s1[g][2 * i + 1]); pw[g][3][i] = cvtpk(s1[g][8 + 2 * i], s1[g][9 + 2 * i]); }
            }
            const ATT_LAS unsigned char* vpp = Vb + buf * VSLOT + voff;
#pragma unroll
            for (int d = 0; d < DVB; ++d)
#pragma unroll
                for (int ks = 0; ks < 4; ++ks) {
                    const s16x4 lo = vtr(vpp + d * 4096 + ks * 1024), hh = vtr(vpp + d * 4096 + ks * 1024 + 512);
                    const bf16x8 vf = (bf16x8){lo[0], lo[1], lo[2], lo[3], hh[0], hh[1], hh[2], hh[3]};
#pragma unroll
                    for (int g = 0; g < RG; ++g) o[g][d] = __builtin_amdgcn_mfma_f32_32x32x16_bf16(vf, __builtin_bit_cast(bf16x8, pw[g][ks]), o[g][d], 0, 0, 0);
                }
        }
        if constexpr (PRUNE) { if (wid == 0 && it + 1 < NT) ATT_KBIAS(buf ^ 1);
            bool all = true;
#pragma unroll
            for (int g = 0; g < RG; ++g) all = all && gdone[g];
            wdone = wdone || all;
            if (wdone && lane == 0) __hip_atomic_fetch_add(cnt + (it % 3), 1u, __ATOMIC_RELAXED, __HIP_MEMORY_SCOPE_WORKGROUP); }
        asm volatile("s_waitcnt vmcnt(0) lgkmcnt(0)" ::: "memory");
        __syncthreads();
        if constexpr (PRUNE) { if (((volatile ATT_LAS unsigned*)cnt)[it % 3] == 8u) break; }
    }
    if constexpr (PRUNE) __syncthreads();
#pragma unroll
    for (int g = 0; g < RG; ++g) {
        const float lt = lrun[g] + __shfl_xor(lrun[g], 32);
        const float inv = 1.f / lt;
        bf16_t* orow = a.O + (size_t)(qrow0 + wrow + g * 32 + r32) * a.op + 4 * hi;
#pragma unroll
        for (int d = 0; d < DVB; ++d)
#pragma unroll
            for (int gg = 0; gg < 4; ++gg) { u32x2 w; w.x = cvtpk(o[g][d][4 * gg] * inv, o[g][d][4 * gg + 1] * inv); w.y = cvtpk(o[g][d][4 * gg + 2] * inv, o[g][d][4 * gg + 3] * inv);
                *(u32x2*)(orow + 32 * d + 8 * gg) = w; }
    }
#undef ATT_DMA
#undef ATT_KBIAS
}
}

using pg8::bf16_t; using pg8::f32x4; using pg8::u32x4;
#define LAS __attribute__((address_space(3)))
constexpr int NB = 4, S = 8192, T = NB * S, D = 1024, FF = 2816, NPROJ = 5888, NWAVES = 8;
constexpr float ALPHA = 1.189207115002721f;
constexpr size_t MiB = 1u << 20;
constexpr size_t WS_RS = 2 * MiB;
constexpr size_t WS_RC = 3 * MiB;
constexpr size_t WS_RSN = 5 * MiB;
constexpr size_t WS_SIDE = 7 * MiB;
constexpr size_t WS_MEMB = 12 * MiB;
constexpr size_t WS_MEMKV = 14 * MiB;
constexpr size_t WS_WIN = 16 * MiB;
constexpr size_t WS_WUQ = 28 * MiB;
constexpr size_t WS_WUKV = 29 * MiB;
constexpr size_t WS_WMKV = 30 * MiB;
constexpr size_t WS_KR = 32 * MiB;
constexpr size_t WS_XB = 34 * MiB;
constexpr size_t WS_QM = 34 * MiB;
constexpr size_t WS_WBR = 82 * MiB;
constexpr size_t WS_WOUT = 87 * MiB;
constexpr size_t WS_H = 98 * MiB;
constexpr size_t WS_G = 98 * MiB;
constexpr size_t WS_SLOT0 = 290 * MiB;
constexpr size_t WS_FQ = 338 * MiB;
constexpr size_t WS_MQ = 434 * MiB;
constexpr size_t WS_FK = 370 * MiB;
constexpr size_t WS_FV = 402 * MiB;
constexpr size_t WS_KN = 370 * MiB;
constexpr size_t WS_VM = 402 * MiB;
constexpr size_t WS_MG = 370 * MiB;
constexpr size_t WS_WA = 480 * MiB;
constexpr size_t WS_WD = 491 * MiB;
constexpr size_t WS_END = 512 * MiB;
constexpr size_t ATILE = (size_t)256 * 512 * 2;
static_assert(WS_MQ + (size_t)T * 512 * 2 <= WS_WA && WS_WD + (size_t)1024 * 2816 * 2 <= WS_END && (WS_FQ - WS_SLOT0) % ATILE == 0 && (WS_MQ - WS_SLOT0) % ATILE == 0 && WS_MG + (size_t)T * 1024 * 2 <= WS_MQ, "ws map");
constexpr int LDS_BYTES = 147456;

__device__ __forceinline__ unsigned f2bf(float f) { unsigned u = __builtin_bit_cast(unsigned, f); return (u + 0x7fffu + ((u >> 16) & 1u)) >> 16; }
__device__ __forceinline__ unsigned pk2(float lo, float hi) { return f2bf(lo) | (f2bf(hi) << 16); }
__device__ __forceinline__ float bf2f(unsigned b) { return __uint_as_float(b << 16); }
__device__ __forceinline__ float wave_sum(float v) {
#pragma unroll
    for (int o = 1; o < 64; o <<= 1) v += __shfl_xor(v, o);
    return v;
}
#define LDS_WAIT() asm volatile("s_waitcnt lgkmcnt(0)" ::: "memory")

__device__ __forceinline__ int map_ffn(int c) { return c < FF ? ((c >> 7) << 8) + (c & 127) : (((c - FF) >> 7) << 8) + 128 + ((c - FF) & 127); }
__device__ __forceinline__ int map_win(int c) {
    if (c < 384) return 5120 + c;
    if (c < 640) return 5504 + (c - 384);
    if (c < 672) return 5760 + (c - 640);
    if (c < 1184) return 3072 + (c - 672);
    if (c < 1696) return 3584 + (c - 1184);
    if (c < 2208) return 4096 + (c - 1696);
    if (c < 2216) return 5792 + (c - 2208);
    if (c < 2728) return 4608 + (c - 2216);
    return c - 2728;
}
template <int MODE>
__device__ __forceinline__ void tr_mat(const float* __restrict__ W, int K, int N, const float* __restrict__ ks, bf16_t* WT, int ldt, int kmul, LAS float* scr, int gw, int NGW, int lane) {
    const int nblk = (N + 31) / 32, items = (K / 64) * nblk;
    for (int it = gw; it < items; it += NGW) {
        const int kb = it / nblk, nb = it % nblk, k0 = 64 * kb, n0 = 32 * nb;
        const int nn = n0 + (lane & 31); const bool ok = nn < N;
#pragma unroll 8
        for (int i = 0; i < 32; ++i) { const int kk = 2 * i + (lane >> 5); float v = ok ? W[(size_t)(k0 + kk) * N + nn] : 0.f; if (ks) v *= ks[k0 + kk]; scr[kk * 33 + (lane & 31)] = v; }
        LDS_WAIT(); asm volatile("" ::: "memory");
        const int c = lane & 7, dc = kb * kmul + 8 * c;
#pragma unroll
        for (int j = 0; j < 4; ++j) { const int n = (lane >> 3) + 8 * j, sc = n0 + n;
            if (sc < N) { const LAS float* s = scr + (8 * c) * 33 + n;
                u32x4 o; o.x = pk2(s[0 * 33], s[1 * 33]); o.y = pk2(s[2 * 33], s[3 * 33]); o.z = pk2(s[4 * 33], s[5 * 33]); o.w = pk2(s[6 * 33], s[7 * 33]);
                const int dr = MODE == 1 ? map_ffn(sc) : (MODE == 2 ? map_win(sc) : sc);
                *(u32x4*)(WT + (size_t)dr * ldt + dc) = o; } }
        LDS_WAIT(); asm volatile("" ::: "memory");
    }
}
__device__ __forceinline__ void cvt_copy(const float* __restrict__ src, bf16_t* dst, size_t n, size_t gt, size_t NTH) {
    size_t i = gt * 8;
    for (; i + 3 * NTH * 8 < n; i += 4 * NTH * 8) {
        f32x4 a[4], b[4];
#pragma unroll
        for (int u = 0; u < 4; ++u) { a[u] = __builtin_nontemporal_load((const f32x4*)(src + i + u * NTH * 8)); b[u] = __builtin_nontemporal_load((const f32x4*)(src + i + u * NTH * 8 + 4)); }
#pragma unroll
        for (int u = 0; u < 4; ++u) { u32x4 o; o.x = pk2(a[u][0], a[u][1]); o.y = pk2(a[u][2], a[u][3]); o.z = pk2(b[u][0], b[u][1]); o.w = pk2(b[u][2], b[u][3]); *(u32x4*)(dst + i + u * NTH * 8) = o; }
    }
    for (; i < n; i += NTH * 8) { const f32x4 a = *(const f32x4*)(src + i), b = *(const f32x4*)(src + i + 4);
        u32x4 o; o.x = pk2(a[0], a[1]); o.y = pk2(a[2], a[3]); o.z = pk2(b[0], b[1]); o.w = pk2(b[2], b[3]); *(u32x4*)(dst + i) = o; }
}
__device__ __forceinline__ void ln_row(const float* xrow, const float* __restrict__ g, const float* __restrict__ b, float* outf, bf16_t* outb, int lane) {
    f32x4 v[4]; float s = 0.f;
#pragma unroll
    for (int j = 0; j < 4; ++j) { v[j] = *(const f32x4*)(xrow + 4 * lane + 256 * j); s += (v[j][0] + v[j][1]) + (v[j][2] + v[j][3]); }
    const float mean = wave_sum(s) * (1.f / D); float s2 = 0.f;
#pragma unroll
    for (int j = 0; j < 4; ++j) { v[j] = v[j] - mean; s2 += (v[j][0] * v[j][0] + v[j][1] * v[j][1]) + (v[j][2] * v[j][2] + v[j][3] * v[j][3]); }
    const float rstd = 1.f / sqrtf(wave_sum(s2) * (1.f / D) + 1e-5f);
#pragma unroll
    for (int j = 0; j < 4; ++j) { const f32x4 gg = *(const f32x4*)(g + 4 * lane + 256 * j), bb = *(const f32x4*)(b + 4 * lane + 256 * j);
        const f32x4 y = v[j] * rstd * gg + bb;
        if (outf) *(f32x4*)(outf + 4 * lane + 256 * j) = y;
        if (outb) { unsigned long long w = (unsigned long long)pk2(y[0], y[1]) | ((unsigned long long)pk2(y[2], y[3]) << 32); *(unsigned long long*)(outb + 4 * lane + 256 * j) = w; } }
}

#define XB_TMO      128
#define XB_XCNT(j)  (256  + 64 * (j))
#define XB_XSUB(j)  (1280 + 64 * (j))
#define XB_XGEN(j)  (2304 + 64 * (j))
#define XB_TOP      3328
#define XB_TOPGEN   3392
#define XCD_BAR_WORDS 3456
#define XB_SPIN_CAP (1u << 18)

__device__ __forceinline__ unsigned xb_ld(unsigned* p)              { return __hip_atomic_load(p, __ATOMIC_RELAXED, __HIP_MEMORY_SCOPE_AGENT); }
__device__ __forceinline__ unsigned xb_add(unsigned* p, unsigned v) { return __hip_atomic_fetch_add(p, v, __ATOMIC_RELAXED, __HIP_MEMORY_SCOPE_AGENT); }
__device__ __forceinline__ unsigned xb_xcc_id() { return (unsigned)__builtin_amdgcn_s_getreg((3 << 11) | 20) & 0xFu; }
#define XB_SPIN(cond, bar) do { unsigned _sp = 0; while (cond) { __builtin_amdgcn_s_sleep(1); \
    if ((++_sp & 255u) == 0u) { if (xb_ld(&(bar)[XB_TMO])) break; if (_sp > XB_SPIN_CAP) { atomicAdd(&(bar)[XB_TMO], 1u); break; } } } } while (0)

struct XcdBarrier {
    unsigned* bar; unsigned x;
    volatile LAS unsigned* st;
};

__device__ __forceinline__ XcdBarrier xcd_barrier_post(unsigned* bar, volatile LAS unsigned* st) {
    XcdBarrier b; b.bar = bar; b.x = xb_xcc_id(); b.st = st;
    if (threadIdx.x == 0) (void)xb_add(&bar[XB_XCNT(b.x)], 1u);
    return b;
}
__device__ __forceinline__ void xcd_barrier_complete(unsigned* bar, unsigned x, unsigned& nloc, unsigned& nx) {
    const unsigned G = gridDim.x * gridDim.y * gridDim.z;
    unsigned sum, cnt, mine, sp = 0u;
    for (;;) {
        sum = 0u; cnt = 0u; mine = 0u;
#pragma unroll
        for (unsigned j = 0; j < 16; ++j) { const unsigned c = xb_ld(&bar[XB_XCNT(j)]); sum += c; cnt += (c > 0u) ? 1u : 0u; mine = (j == x) ? c : mine; }
        if (sum == G) break;
        __builtin_amdgcn_s_sleep(1);
        if ((++sp & 255u) == 0u) { if (xb_ld(&bar[XB_TMO])) break; if (sp > XB_SPIN_CAP) { atomicAdd(&bar[XB_TMO], 1u); break; } }
    }
    nloc = mine > 0u ? mine : 1u; nx = cnt > 0u ? cnt : 1u;
}

__device__ __forceinline__ void xcd_barrier(const XcdBarrier& b) {
    asm volatile("s_waitcnt vmcnt(0)" ::: "memory");
    __syncthreads();
    if (threadIdx.x == 0) {
        unsigned* bar = b.bar;
        __builtin_amdgcn_s_waitcnt(0);
        unsigned nloc = b.st[0], nx = b.st[1];
        if (nloc == 0u) { xcd_barrier_complete(bar, b.x, nloc, nx); b.st[0] = nloc; b.st[1] = nx; }
        const unsigned old = xb_add(&bar[XB_XSUB(b.x)], 1u);
        const unsigned gen = old / nloc;
        if (old + 1u == (gen + 1u) * nloc) {
            __builtin_amdgcn_fence(__ATOMIC_RELEASE, "agent");
            asm volatile("s_waitcnt vmcnt(0)" ::: "memory");
            const unsigned og = xb_add(&bar[XB_TOP], 1u);
            const unsigned tg = og / nx;
            if (og + 1u == (tg + 1u) * nx) xb_add(&bar[XB_TOPGEN], 1u);
            else XB_SPIN(xb_ld(&bar[XB_TOPGEN]) == tg, bar);
            __builtin_amdgcn_fence(__ATOMIC_ACQUIRE, "agent");
            xb_add(&bar[XB_XGEN(b.x)], 1u);
            asm volatile("s_waitcnt vmcnt(0)" ::: "memory");
        } else {
            XB_SPIN(xb_ld(&bar[XB_XGEN(b.x)]) == gen, bar);
            __builtin_amdgcn_fence(__ATOMIC_ACQUIRE, "agent");
            asm volatile("s_waitcnt vmcnt(0)" ::: "memory");
        }
    }
    __syncthreads();
}

#ifndef PH_MASK
#define PH_MASK 0xFFFF
#endif
struct Params { const float* in[25]; float* out; unsigned char* ws; };

__global__ void __launch_bounds__(NWAVES * 64) mega_fwd(Params p) {
    extern __shared__ __attribute__((aligned(16))) unsigned char lds_raw[];
    cg::grid_group grid = cg::this_grid();
    LAS unsigned char* lds = (LAS unsigned char*)lds_raw;
    const int tid = threadIdx.x, lane = tid & 63, wave = __builtin_amdgcn_readfirstlane(tid >> 6);
    const int G = gridDim.x, bx = blockIdx.x;
    const int gw = bx * NWAVES + wave, NGW = G * NWAVES;
    const size_t gt = (size_t)bx * (NWAVES * 64) + tid, NTH = (size_t)G * (NWAVES * 64);
    unsigned char* ws = p.ws;
    const float* x = p.in[0]; const float* mem = p.in[1]; const int* positions = (const int*)p.in[2];
    float* R = p.out;
    float* KMAX = (float*)(ws + WS_RS); float* F2T = (float*)(ws + 1 * MiB); float* RC = (float*)(ws + WS_RC); float* RSN = (float*)(ws + WS_RSN); float* SIDE = (float*)(ws + WS_SIDE);
    bf16_t* MEMB = (bf16_t*)(ws + WS_MEMB); bf16_t* MEMKV = (bf16_t*)(ws + WS_MEMKV);
    bf16_t* WIN = (bf16_t*)(ws + WS_WIN); bf16_t* WUQ = (bf16_t*)(ws + WS_WUQ); bf16_t* WUKV = (bf16_t*)(ws + WS_WUKV); bf16_t* WMKV = (bf16_t*)(ws + WS_WMKV);
    bf16_t* KR = (bf16_t*)(ws + WS_KR); bf16_t* XB = (bf16_t*)(ws + WS_XB); bf16_t* QM = (bf16_t*)(ws + WS_QM); bf16_t* WBR = (bf16_t*)(ws + WS_WBR); bf16_t* WOUT = (bf16_t*)(ws + WS_WOUT);
    bf16_t* HB = (bf16_t*)(ws + WS_H); bf16_t* GB = (bf16_t*)(ws + WS_G); bf16_t* SLOT0 = (bf16_t*)(ws + WS_SLOT0); bf16_t* CQ = SLOT0; bf16_t* CKV = SLOT0 + (size_t)T * 384; bf16_t* FQ = (bf16_t*)(ws + WS_FQ); bf16_t* MQ = (bf16_t*)(ws + WS_MQ);
    bf16_t* FK = (bf16_t*)(ws + WS_FK); bf16_t* FV = (bf16_t*)(ws + WS_FV); bf16_t* KN = (bf16_t*)(ws + WS_KN); bf16_t* VM = (bf16_t*)(ws + WS_VM); bf16_t* MG = (bf16_t*)(ws + WS_MG);
    bf16_t* WA = (bf16_t*)(ws + WS_WA); bf16_t* WD = (bf16_t*)(ws + WS_WD);
    LAS float* scr = (LAS float*)(lds + wave * 16384);
    volatile LAS unsigned* MISC = (volatile LAS unsigned*)(lds + 131072 + 256);
    if (tid < 2) MISC[tid] = 0u;
    unsigned* barw = (unsigned*)ws;
    if (bx == 0) for (int i = tid; i < XCD_BAR_WORDS; i += NWAVES * 64) barw[i] = 0u;

#if (PH_MASK >> 0) & 1
    tr_mat<1>(p.in[5], D, 2 * FF, nullptr, WA, D, 64, scr, gw, NGW, lane);
    tr_mat<0>(p.in[6], FF, D, nullptr, WD, FF, 64, scr, gw, NGW, lane);
    tr_mat<2>(p.in[7], D, 5800, nullptr, WIN, D, 64, scr, gw, NGW, lane);
    tr_mat<0>(p.in[10], 384, 768, p.in[9], WUQ, 384, 64, scr, gw, NGW, lane);
    tr_mat<0>(p.in[12], 256, 1024, p.in[11], WUKV, 256, 64, scr, gw, NGW, lane);
    tr_mat<0>(p.in[14], D, 1024, nullptr, WMKV, D, 64, scr, gw, NGW, lane);
    for (size_t i = gt * 8; i < (size_t)88 * D; i += NTH * 8) *(u32x4*)(WIN + (size_t)5800 * D + i) = (u32x4){0u, 0u, 0u, 0u};
    if (gt < 32) KMAX[gt] = 0.f;
    cvt_copy(x, XB, (size_t)T * D, gt, NTH);
    cvt_copy(mem, MEMB, (size_t)NB * 256 * D, gt, NTH);
    for (size_t i = gt; i < (size_t)T * 16; i += NTH) {
        const int row = (int)(i >> 4), f = (int)(i & 15);
        const float invf = (float)exp2(-(double)f * (13.287712379549449 / 16.0));
        const float ang = (float)positions[row] * invf;
        const double rev = (double)ang * 0.15915494309189535; const float fr = (float)(rev - __builtin_rint(rev));
        RC[i] = __builtin_amdgcn_cosf(fr); RSN[i] = __builtin_amdgcn_sinf(fr);
    }
#endif
    grid.sync();
    const XcdBarrier xb = xcd_barrier_post(barw, MISC);

#if (PH_MASK >> 1) & 1
    { pg8::Gemm g{XB, WA, T, 2 * FF, D}; pg8::StaticOrder so; so.init(T, 2 * FF, G, bx);
      pg8::EpiSwiglu E{HB, FF}; pg8::gemm_phase<pg8::EpiSwiglu, pg8::StaticOrder, true>(lds, g, so, E); }
#endif
    xcd_barrier(xb);
#if (PH_MASK >> 2) & 1
    { pg8::Gemm g{HB, WD, T, D, FF}; pg8::StaticOrder so; so.init(T, D, G, bx);
      pg8::EpiRes E{x, R, ALPHA, 0.5f}; pg8::gemm_phase<pg8::EpiRes, pg8::StaticOrder, true>(lds, g, so, E); }
#endif
    xcd_barrier(xb);
#if (PH_MASK >> 3) & 1
    for (int m = gw; m < T; m += NGW) ln_row(R + (size_t)m * D, p.in[3], p.in[4], R + (size_t)m * D, XB + (size_t)m * D, lane);
    { pg8::Gemm g{MEMB, WMKV, NB * 256, 1024, D}; pg8::StaticOrder so; so.init(NB * 256, 1024, G, (bx + 128) % G);
      pg8::EpiPlain E{MEMKV, 1024, 1.f}; pg8::gemm_phase<pg8::EpiPlain, pg8::StaticOrder, true>(lds, g, so, E); }
#endif
    xcd_barrier(xb);
#if (PH_MASK >> 4) & 1
    { pg8::Gemm g{XB, WIN, T, NPROJ, D}; pg8::StaticOrder so; so.init(T, NPROJ, G, bx);
      pg8::EpiProj E{GB, FQ, FK, FV, MQ, CQ, CKV, SIDE, p.in[8]}; pg8::gemm_phase<pg8::EpiProj, pg8::StaticOrder, true>(lds, g, so, E); }
#endif
    xcd_barrier(xb);
#if (PH_MASK >> 5) & 1
    if (bx < 32) {
        const int b = bx >> 3, h = bx & 7; LAS double* sh = (LAS double*)lds;
        const float bfh = p.in[13][h]; float lf[16]; double loc = 0.0;
#pragma unroll
        for (int j = 0; j < 16; ++j) { const float xx = SIDE[((size_t)b * S + 16 * tid + j) * 40 + 32 + h] + bfh; lf[j] = fminf(xx, 0.f) - log1pf(__expf(-fabsf(xx))); loc += (double)lf[j]; }
        double incl = loc;
#pragma unroll
        for (int o = 1; o < 64; o <<= 1) { const double v = __shfl_up(incl, o); if (lane >= o) incl += v; }
        if (lane == 63) sh[wave] = incl;
        __syncthreads();
        double run = incl - loc;
        for (int w = 0; w < wave; ++w) run += sh[w];
#pragma unroll
        for (int j = 0; j < 16; ++j) { run += (double)lf[j];
            const float f2 = (float)(run * 1.4426950408889634);
            F2T[(size_t)bx * S + 16 * tid + j] = f2; }
        __syncthreads();
    }
    float kmrun = 0.f; int curb = gw >> 13;
    for (int m = gw; m < T; m += NGW) {
        { const int bb = m >> 13;
          if (bb != curb) { if ((lane & 7) == 0) atomicMax((unsigned*)KMAX + curb * 8 + (lane >> 3), __float_as_uint(kmrun)); kmrun = 0.f; curb = bb; }
          f32x4 k0, k1; pg8::unpack8(*(const u32x4*)(FK + (size_t)m * 512 + lane * 8), k0, k1); float ks = 0.f;
#pragma unroll
          for (int i = 0; i < 4; ++i) ks += k0[i] * k0[i] + k1[i] * k1[i];
          ks += __shfl_xor(ks, 1); ks += __shfl_xor(ks, 2); ks += __shfl_xor(ks, 4);
          kmrun = fmaxf(kmrun, ks); }
        f32x4 a0, a1, c0, c1; float sq = 0.f, sq2 = 0.f;
        if (lane < 48) { pg8::unpack8(*(const u32x4*)(CQ + (size_t)m * 384 + lane * 8), a0, a1);
#pragma unroll
            for (int i = 0; i < 4; ++i) sq += a0[i] * a0[i] + a1[i] * a1[i]; }
        if (lane < 32) { pg8::unpack8(*(const u32x4*)(CKV + (size_t)m * 256 + lane * 8), c0, c1);
#pragma unroll
            for (int i = 0; i < 4; ++i) sq2 += c0[i] * c0[i] + c1[i] * c1[i]; }
        const float rq = 1.f / sqrtf(wave_sum(sq) * (1.f / 384.f) + 1e-6f), rkv = 1.f / sqrtf(wave_sum(sq2) * (1.f / 256.f) + 1e-6f);
        if (lane < 48) *(u32x4*)(CQ + (size_t)m * 384 + lane * 8) = pg8::pack8(a0 * rq, a1 * rq);
        if (lane < 32) *(u32x4*)(CKV + (size_t)m * 256 + lane * 8) = pg8::pack8(c0 * rkv, c1 * rkv);
        if (lane < 16) { const float x1 = SIDE[(size_t)m * 40 + lane], x2 = SIDE[(size_t)m * 40 + 16 + lane], c = RC[(size_t)m * 16 + lane], s = RSN[(size_t)m * 16 + lane];
            KR[(size_t)m * 32 + lane] = (bf16_t)f2bf(x1 * c - x2 * s); KR[(size_t)m * 32 + 16 + lane] = (bf16_t)f2bf(x2 * c + x1 * s); }
    }
    if ((lane & 7) == 0) atomicMax((unsigned*)KMAX + curb * 8 + (lane >> 3), __float_as_uint(kmrun));
    tr_mat<0>(p.in[15], 512, D, nullptr, WBR, 512, 64, scr, gw, NGW, lane);
    tr_mat<0>(p.in[16], 512, D, nullptr, WBR + (size_t)1024 * 512, 512, 64, scr, gw, NGW, lane);
    tr_mat<0>(p.in[17], 512, D, nullptr, WBR + (size_t)2048 * 512, 512, 64, scr, gw, NGW, lane);
    tr_mat<0>(p.in[18], D, D, nullptr, WOUT, D, 64, scr, gw, NGW, lane);
    __syncthreads();
    for (int u = bx; u < NB * 4 * 32; u += G) {
        const int b = u >> 7, hm = (u >> 5) & 3, qb = u & 31;
        att::Args a{MQ + hm * 128, 512, MEMKV + hm * 128, 1024, MEMKV + hm * 128 + 64, 1024, MEMKV + 512 + hm * 128, 1024, MQ + hm * 128, 512, nullptr, nullptr, nullptr, 0.f};
        att::attn_unit<8, 4, false, false, 1, false>(a, (long)b * S + qb * 256, (long)b * 256, 0, 4, lds);
    }
#endif
    xcd_barrier(xb);
#if (PH_MASK >> 6) & 1
    for (int u = bx; u < 512; u += G) {
        const int v = u & 255, i = u >> 8, vcu = (v & 7) * 32 + (v >> 3), bh = vcu >> 3, s = vcu & 7;
        const int qb = (i == 0) ? s : 15 - s; const int b = bh >> 3, h = bh & 7;
        att::Args a{FQ + h * 64, 512, FK + h * 64, 512, nullptr, 0, FV + h * 64, 512, FQ + h * 64, 512, nullptr, nullptr, F2T + (size_t)bh * S, sqrtf(KMAX[bh]) * 1.001f};
        att::attn_unit<5, 2, true, false, 2, true>(a, (long)b * S + qb * 512, (long)b * S, qb * 512, 8 * (qb + 1), lds);
    }
#endif
    xcd_barrier(xb);
#if (PH_MASK >> 7) & 1
    { pg8::Gemm g{CQ, WUQ, T, 768, 384}; pg8::StaticOrder so; so.init(T, 768, G, bx);
      pg8::EpiPlain E{QM, 768, 0.10206207261596577f * pg8::LOG2E}; pg8::gemm_phase<pg8::EpiPlain, pg8::StaticOrder, true>(lds, g, so, E); }
    { pg8::Gemm g{CKV, WUKV, T, 1024, 256}; pg8::StaticOrder so; so.init(T, 1024, G, bx);
      pg8::EpiKvup E{KN, VM}; pg8::gemm_phase<pg8::EpiKvup, pg8::StaticOrder, true>(lds, g, so, E); }
#endif
    xcd_barrier(xb);
#if (PH_MASK >> 8) & 1
    for (int u = bx; u < 512; u += G) {
        const int v = u & 255, i = u >> 8, vcu = (v & 7) * 32 + (v >> 3), bh = vcu >> 3, s = vcu & 7;
        const int qb = (i == 0) ? s : 15 - s; const int b = bh >> 3, h = bh & 7;
        att::Args a{QM + h * 96, 768, KN + h * 64, 512, KR, 32, VM + h * 64, 512, SLOT0 + h * 64, 512, RC, RSN, nullptr, 0.f};
        att::attn_unit<6, 2, true, true, 2, false>(a, (long)b * S + qb * 512, (long)b * S, qb * 512, 8 * (qb + 1), lds);
    }
#endif
    xcd_barrier(xb);
#if (PH_MASK >> 9) & 1
    { pg8::Gemm g{SLOT0, WBR, T, D, 512}; pg8::SegOrder so; so.init(T, D, G, bx, (int)((WS_FQ - WS_SLOT0) / ATILE), (int)((WS_MQ - WS_SLOT0) / ATILE));
      pg8::EpiBranch E{GB, MG}; pg8::gemm_phase<pg8::EpiBranch, pg8::SegOrder, true>(lds, g, so, E); }
#endif
    xcd_barrier(xb);
#if (PH_MASK >> 10) & 1
    { pg8::Gemm g{MG, WOUT, T, D, D}; pg8::StaticOrder so; so.init(T, D, G, bx);
      pg8::EpiRes E{R, R, ALPHA, 1.f}; pg8::gemm_phase<pg8::EpiRes, pg8::StaticOrder, true>(lds, g, so, E); }
#endif
    xcd_barrier(xb);
#if (PH_MASK >> 11) & 1
    for (int m = gw; m < T; m += NGW) ln_row(R + (size_t)m * D, p.in[19], p.in[20], R + (size_t)m * D, XB + (size_t)m * D, lane);
    tr_mat<1>(p.in[21], D, 2 * FF, nullptr, WA, D, 64, scr, gw, NGW, lane);
    tr_mat<0>(p.in[22], FF, D, nullptr, WD, FF, 64, scr, gw, NGW, lane);
#endif
    xcd_barrier(xb);
#if (PH_MASK >> 12) & 1
    { pg8::Gemm g{XB, WA, T, 2 * FF, D}; pg8::StaticOrder so; so.init(T, 2 * FF, G, bx);
      pg8::EpiSwiglu E{HB, FF}; pg8::gemm_phase<pg8::EpiSwiglu, pg8::StaticOrder, true>(lds, g, so, E); }
#endif
    xcd_barrier(xb);
#if (PH_MASK >> 13) & 1
    { pg8::Gemm g{HB, WD, T, D, FF}; pg8::StaticOrder so; so.init(T, D, G, bx);
      pg8::EpiRes E{R, R, ALPHA, 0.5f}; pg8::gemm_phase<pg8::EpiRes, pg8::StaticOrder, true>(lds, g, so, E); }
#endif
    xcd_barrier(xb);
#if (PH_MASK >> 14) & 1
    for (int m = gw; m < T; m += NGW) ln_row(R + (size_t)m * D, p.in[23], p.in[24], R + (size_t)m * D, nullptr, lane);
#endif
}

extern "C" void kernel_launch(void* const* d_in, const int* in_sizes, int n_in, void* d_out, int out_size, void* d_ws, size_t ws_size, hipStream_t stream) {
    static int grid = 0;
    if (grid == 0) {
        if (n_in != 25 || out_size != T * D || ws_size < WS_END) { fprintf(stderr, "kernel_launch: unexpected shapes (n_in %d out %d ws %zu)\n", n_in, out_size, ws_size); grid = -1; return; }
        int dev = 0, cus = 0, per = 0;
        (void)hipGetDevice(&dev); (void)hipDeviceGetAttribute(&cus, hipDeviceAttributeMultiprocessorCount, dev);
        (void)hipFuncSetAttribute((const void*)mega_fwd, hipFuncAttributeMaxDynamicSharedMemorySize, LDS_BYTES);
        (void)hipOccupancyMaxActiveBlocksPerMultiprocessor(&per, (const void*)mega_fwd, NWAVES * 64, LDS_BYTES);
        if (per < 1) per = 1;
        grid = cus * per;
        fprintf(stderr, "kernel_launch: grid %d (cus %d x %d), ws %zu\n", grid, cus, per, ws_size);
    }
    if (grid < 0) return;
    Params p{};
    for (int i = 0; i < 25; ++i) p.in[i] = (const float*)d_in[i];
    p.out = (float*)d_out; p.ws = (unsigned char*)d_ws;
    void* args[] = {&p};
    const hipError_t e = hipLaunchCooperativeKernel((const void*)mega_fwd, dim3(grid), dim3(NWAVES * 64), args, LDS_BYTES, stream);
    if (e != hipSuccess) fprintf(stderr, "kernel_launch: cooperative launch failed: %s (grid %d)\n", hipGetErrorString(e), grid);
}
```

```cpp
#include <hip/hip_runtime.h>
#include <hip/hip_cooperative_groups.h>
#include <cstdio>
#include <cstdint>
#include <cmath>
namespace cg = cooperative_groups;
namespace pg8 {
#define PG8_LAS __attribute__((address_space(3)))
typedef unsigned short bf16_t;
typedef short bf16x8 __attribute__((ext_vector_type(8)));
typedef float f32x4 __attribute__((ext_vector_type(4)));
typedef unsigned u32x4 __attribute__((ext_vector_type(4)));
constexpr int BM = 256, BK = 64, HALF = 128, HTB = HALF * BK * 2  , STAGE_BYTES = 8 * HTB, NXCD = 8, WGM = 8;

__host__ __device__ __forceinline__ int lds_byte(int r, int c) { const int st = (r >> 4) * 2 + (c >> 5), rr = r & 15, cc = c & 31, ob = rr * 64 + cc * 2; return st * 1024 + (ob ^ (((ob >> 9) & 1) << 5)); }
__host__ __device__ __forceinline__ void stage_rc(int b, int& R, int& C) { const int st = b / 1024, sb = b % 1024, swz = sb ^ (((sb >> 9) & 1) << 5); R = (st >> 1) * 16 + swz / 64; C = (st & 1) * 32 + (swz % 64) / 2; }
__host__ __device__ __forceinline__ int perm32(int rho) { const int n = rho >> 4, i = rho & 15; return 8 * (i >> 2) + 4 * n + (i & 3); }

struct Unit { int pm, pn, am, bn, seg; };
struct Gemm { const bf16_t* A; const bf16_t* Bt; int M, N, K; };

struct StaticOrder {
    int nM, nN, nwg, G, c;
    __host__ __device__ void init(int M, int N, int G_, int c_) { nM = M / BM; nN = N / BM; nwg = nM * nN; G = G_; c = c_; }
    __host__ __device__ bool next(int i, Unit& u) const {
        const long L = (long)i * G + c; if (L >= nwg) return false;
        int wgid = (int)L; { const int q = nwg / NXCD, r = nwg % NXCD, xcd = wgid % NXCD, off = wgid / NXCD; wgid = (xcd < r ? xcd * (q + 1) : r * (q + 1) + (xcd - r) * q) + off; }
        const int nig = WGM * nN, gid = wgid / nig, fm = gid * WGM, gsz = (nM - fm) < WGM ? (nM - fm) : WGM;
        u.pm = fm + ((wgid % nig) % gsz); u.pn = (wgid % nig) / gsz; u.am = u.pm; u.bn = u.pn; u.seg = 0; return true;
    }
};

__device__ __forceinline__ unsigned cvt_pk_bf16(float lo, float hi) { unsigned r; asm volatile("v_cvt_pk_bf16_f32 %0, %1, %2" : "=v"(r) : "v"(lo), "v"(hi)); return r; }
typedef float f32x2 __attribute__((ext_vector_type(2)));
template <class Epi, class Sched, bool ALIGN_EPI = false, bool SP2 = true>
__device__ __forceinline__ void gemm_phase(PG8_LAS unsigned char* lds, const Gemm g, const Sched& S, const Epi& E) {
    int tid_ = threadIdx.x; asm volatile("" : "+v"(tid_));
    const int tid = tid_, wid = __builtin_amdgcn_readfirstlane(tid >> 6), lane = tid & 63, wr = wid >> 2, wc = wid & 3, fr = lane & 15, fq = lane >> 4;
    const int K = g.K, nt = K / BK;
    unsigned voffA[2], voffB[2];
#pragma unroll
    for (int i = 0; i < 2; ++i) { int R, C; stage_rc(tid * 16 + i * 8192, R, C); const int Rb = Epi::PERM ? ((R & ~31) + perm32(R & 31)) : R;
        voffA[i] = (unsigned)(R * K + C) * 2u; voffB[i] = (unsigned)(Rb * K + C) * 2u; }
    const size_t kstep = (size_t)(BK * 2);
    const size_t hstep = (size_t)HALF * K * 2;
    const size_t tstep = 2 * hstep;
    const unsigned ldsw = (unsigned)wid * 1024u;
    const int aoff = lds_byte(wr * 64 + fr, fq * 8), boff = lds_byte(wc * 32 + fr, fq * 8);
#define PG8_SA(b, h) (((b) * 2 + (h)) * HTB)
#define PG8_SB(b, h) ((4 + (b) * 2 + (h)) * HTB)
#define PG8_STAGE(bufoff, gbase, voff) do { _Pragma("unroll") for (int _i = 0; _i < 2; ++_i) \
        __builtin_amdgcn_global_load_lds((const unsigned*)((const char*)(gbase) + (voff)[_i]), (PG8_LAS unsigned*)(lds + (bufoff) + ldsw + _i * 8192), 16, 0, 0); } while (0)
#define PG8_LDA(dst, b, h) do { _Pragma("unroll") for (int m = 0; m < 4; ++m) _Pragma("unroll") for (int k = 0; k < 2; ++k) dst[m][k] = *(const PG8_LAS bf16x8*)(lds + PG8_SA(b, h) + aoff + m * 2048 + k * 1024); } while (0)
#define PG8_LDB(dst, b, h) do { _Pragma("unroll") for (int n = 0; n < 2; ++n) _Pragma("unroll") for (int k = 0; k < 2; ++k) dst[n][k] = *(const PG8_LAS bf16x8*)(lds + PG8_SB(b, h) + boff + n * 2048 + k * 1024); } while (0)
#define PG8_MMA(ai, bj, At, Bt) do { __builtin_amdgcn_s_setprio(1); _Pragma("unroll") for (int m = 0; m < 4; ++m) _Pragma("unroll") for (int n = 0; n < 2; ++n) _Pragma("unroll") for (int k = 0; k < 2; ++k) \
        acc[ai][bj][m][n] = __builtin_amdgcn_mfma_f32_16x16x32_bf16(Bt[n][k], At[m][k], acc[ai][bj][m][n], 0, 0, 0); __builtin_amdgcn_s_setprio(0); } while (0)
#define PG8_WAIT_V(n) asm volatile("s_waitcnt vmcnt(" #n ")" ::: "memory")
#define PG8_WAIT_L(n) asm volatile("s_waitcnt lgkmcnt(" #n ")" ::: "memory")
#define PG8_BAR __builtin_amdgcn_s_barrier()
#define PG8_SCHED __builtin_amdgcn_sched_barrier(0)
    Unit cur, nxt; int ui = 0;
    if (!S.next(0, cur)) return;
    f32x4 acc[2][2][4][2];
#pragma unroll
    for (int a = 0; a < 2; ++a)
#pragma unroll
        for (int b = 0; b < 2; ++b)
#pragma unroll
            for (int m = 0; m < 4; ++m)
#pragma unroll
                for (int n = 0; n < 2; ++n) acc[a][b][m][n] = (f32x4){0.f, 0.f, 0.f, 0.f};
    bf16x8 At[4][2], B0[2][2], B1[2][2];
    const char* cA = (const char*)g.A + (size_t)cur.am * tstep; const char* cB = (const char*)g.Bt + (size_t)cur.bn * tstep;
    if constexpr (SP2) {
        PG8_STAGE(PG8_SB(0, 0), cB, voffB); PG8_STAGE(PG8_SB(0, 1), cB + hstep, voffB); PG8_STAGE(PG8_SA(0, 0), cA, voffA); PG8_STAGE(PG8_SA(0, 1), cA + hstep, voffA);
        if (wr == 1) PG8_BAR;
        PG8_WAIT_V(2); PG8_BAR;
        PG8_STAGE(PG8_SB(1, 0), cB + kstep, voffB); PG8_STAGE(PG8_SA(1, 0), cA + kstep, voffA); PG8_STAGE(PG8_SB(1, 1), cB + hstep + kstep, voffB);
        PG8_WAIT_V(6); PG8_BAR;
    } else {
        PG8_STAGE(PG8_SB(0, 0), cB, voffB); PG8_STAGE(PG8_SA(0, 0), cA, voffA); PG8_STAGE(PG8_SB(0, 1), cB + hstep, voffB); PG8_STAGE(PG8_SA(0, 1), cA + hstep, voffA);
        if (wr == 1) PG8_BAR;
        PG8_WAIT_V(4); PG8_BAR;
        PG8_STAGE(PG8_SB(1, 0), cB + kstep, voffB); PG8_STAGE(PG8_SA(1, 0), cA + kstep, voffA); PG8_STAGE(PG8_SB(1, 1), cB + hstep + kstep, voffB);
        PG8_WAIT_V(6); PG8_BAR;
    }
    for (;;) {
        const bool has_next = S.next(ui + 1, nxt);
        const char* nA = has_next ? (const char*)g.A + (size_t)nxt.am * tstep : cA; const char* nB = has_next ? (const char*)g.Bt + (size_t)nxt.bn * tstep : cB;
#pragma nounroll
        for (int t = 0; t < nt; t += 2) {
            const bool last = (t == nt - 2);
            const char* a1 = cA + (size_t)(t + 1) * kstep;
            const char* a2 = last ? nA : cA + (size_t)(t + 2) * kstep; const char* b2 = last ? nB : cB + (size_t)(t + 2) * kstep;
            const char* a3 = a2 + kstep; const char* b3 = b2 + kstep;
            if constexpr (SP2) {
            PG8_LDB(B0, 0, 0); PG8_LDB(B1, 0, 1); PG8_SCHED; PG8_LDA(At, 0, 0); PG8_STAGE(PG8_SA(1, 1), a1 + hstep, voffA);
            PG8_WAIT_V(8); PG8_WAIT_L(0); PG8_BAR; PG8_MMA(0, 0, At, B0); PG8_MMA(0, 1, At, B1); PG8_BAR; PG8_SCHED;
            PG8_LDA(At, 0, 1); PG8_STAGE(PG8_SB(0, 0), b2, voffB); PG8_STAGE(PG8_SB(0, 1), b2 + hstep, voffB); PG8_STAGE(PG8_SA(0, 0), a2, voffA);
            PG8_WAIT_V(8); PG8_WAIT_L(0); PG8_BAR; PG8_MMA(1, 0, At, B0); PG8_MMA(1, 1, At, B1); PG8_BAR; PG8_SCHED;
            PG8_LDB(B0, 1, 0); PG8_LDB(B1, 1, 1); PG8_SCHED; PG8_LDA(At, 1, 0); PG8_STAGE(PG8_SA(0, 1), a2 + hstep, voffA);
            PG8_WAIT_V(8); PG8_WAIT_L(0); PG8_BAR; PG8_MMA(0, 0, At, B0); PG8_MMA(0, 1, At, B1); PG8_BAR; PG8_SCHED;
            PG8_LDA(At, 1, 1); PG8_STAGE(PG8_SB(1, 0), b3, voffB); PG8_STAGE(PG8_SB(1, 1), b3 + hstep, voffB); PG8_STAGE(PG8_SA(1, 0), a3, voffA);
            PG8_WAIT_V(8); PG8_WAIT_L(0); PG8_BAR; PG8_MMA(1, 0, At, B0); PG8_MMA(1, 1, At, B1); PG8_BAR; PG8_SCHED;
            } else {
            PG8_LDB(B0, 0, 0); PG8_SCHED; PG8_LDA(At, 0, 0); PG8_STAGE(PG8_SA(1, 1), a1 + hstep, voffA);
            PG8_WAIT_L(8); PG8_BAR; PG8_WAIT_L(0); PG8_MMA(0, 0, At, B0); PG8_BAR; PG8_SCHED;
            PG8_LDB(B1, 0, 1); PG8_STAGE(PG8_SB(0, 0), b2, voffB);
            PG8_BAR; PG8_WAIT_L(0); PG8_MMA(0, 1, At, B1); PG8_BAR;
            PG8_LDA(At, 0, 1); PG8_STAGE(PG8_SA(0, 0), a2, voffA);
            PG8_BAR; PG8_WAIT_L(0); PG8_MMA(1, 0, At, B0); PG8_BAR; PG8_SCHED;
            PG8_STAGE(PG8_SB(0, 1), b2 + hstep, voffB);
            PG8_WAIT_V(6); PG8_BAR; PG8_MMA(1, 1, At, B1); PG8_BAR;
            PG8_LDB(B0, 1, 0); PG8_SCHED; PG8_LDA(At, 1, 0); PG8_STAGE(PG8_SA(0, 1), a2 + hstep, voffA);
            PG8_WAIT_L(8); PG8_BAR; PG8_WAIT_L(0); PG8_MMA(0, 0, At, B0); PG8_BAR; PG8_SCHED;
            PG8_LDB(B1, 1, 1); PG8_STAGE(PG8_SB(1, 0), b3, voffB);
            PG8_BAR; PG8_WAIT_L(0); PG8_MMA(0, 1, At, B1); PG8_BAR;
            PG8_LDA(At, 1, 1); PG8_STAGE(PG8_SA(1, 0), a3, voffA);
            PG8_BAR; PG8_WAIT_L(0); PG8_MMA(1, 0, At, B0); PG8_BAR; PG8_SCHED;
            PG8_STAGE(PG8_SB(1, 1), b3 + hstep, voffB);
            PG8_WAIT_V(6); PG8_BAR; PG8_MMA(1, 1, At, B1); PG8_BAR;
            }
        }
        if constexpr (ALIGN_EPI) { if (wr == 0) PG8_BAR; }
        E(acc, cur, wr, wc, fr, fq);
        if (!has_next) break;
        if (!Epi::keep(cur)) {
#pragma unroll
        for (int a = 0; a < 2; ++a)
#pragma unroll
            for (int b = 0; b < 2; ++b)
#pragma unroll
                for (int m = 0; m < 4; ++m)
#pragma unroll
                    for (int n = 0; n < 2; ++n) acc[a][b][m][n] = (f32x4){0.f, 0.f, 0.f, 0.f};
        }
        cur = nxt; cA = nA; cB = nB; ++ui;
        if constexpr (ALIGN_EPI) { if (wr == 1) PG8_BAR; }
    }
    PG8_WAIT_V(0);
    if constexpr (!ALIGN_EPI) { if (wr == 0) PG8_BAR; }
    PG8_BAR;
#undef PG8_SA
#undef PG8_SB
#undef PG8_STAGE
#undef PG8_LDA
#undef PG8_LDB
#undef PG8_MMA
#undef PG8_WAIT_V
#undef PG8_WAIT_L
#undef PG8_BAR
#undef PG8_SCHED
}

struct SegOrder {
    StaticOrder b; int a1, a2, bN;
    __device__ void init(int M, int N, int G_, int c_, int a1_, int a2_) { b.init(M, N, G_, c_); a1 = a1_; a2 = a2_; bN = N / BM; }
    __device__ bool next(int i, Unit& u) const { if (!b.next(i / 3, u)) return false; const int s = i % 3; u.seg = s; u.am = u.pm + (s == 0 ? 0 : (s == 1 ? a1 : a2)); u.bn = u.pn + s * bN; return true; }
};

constexpr float LOG2E = 1.4426950408889634f;
__device__ __forceinline__ float sigm(float x) { return __builtin_amdgcn_rcpf(1.f + __expf(-x)); }
__device__ __forceinline__ u32x4 pack8(const f32x4 v0, const f32x4 v1) { u32x4 w; w.x = cvt_pk_bf16(v0[0], v0[1]); w.y = cvt_pk_bf16(v0[2], v0[3]); w.z = cvt_pk_bf16(v1[0], v1[1]); w.w = cvt_pk_bf16(v1[2], v1[3]); return w; }
__device__ __forceinline__ void unpack8(const u32x4 w, f32x4& v0, f32x4& v1) {
    v0[0] = __uint_as_float(w.x << 16); v0[1] = __uint_as_float(w.x & 0xffff0000u); v0[2] = __uint_as_float(w.y << 16); v0[3] = __uint_as_float(w.y & 0xffff0000u);
    v1[0] = __uint_as_float(w.z << 16); v1[1] = __uint_as_float(w.z & 0xffff0000u); v1[2] = __uint_as_float(w.w << 16); v1[3] = __uint_as_float(w.w & 0xffff0000u); }

struct EpiPlain {
    static constexpr bool PERM = true; static __device__ __forceinline__ bool keep(const Unit&) { return false; }
    bf16_t* O; int ldc; float sc;
    __device__ __forceinline__ void operator()(f32x4 (&acc)[2][2][4][2], const Unit& u, int wr, int wc, int fr, int fq) const {
        const int row0 = u.pm * BM + wr * 64 + fr, col0 = u.pn * BM + wc * 32 + 8 * fq;
#pragma unroll
        for (int ai = 0; ai < 2; ++ai)
#pragma unroll
            for (int m = 0; m < 4; ++m) { bf16_t* rowp = O + (size_t)(row0 + ai * HALF + m * 16) * ldc + col0;
#pragma unroll
                for (int bj = 0; bj < 2; ++bj) *(u32x4*)(rowp + bj * HALF) = pack8(acc[ai][bj][m][0] * sc, acc[ai][bj][m][1] * sc); }
    }
};
struct EpiSwiglu {
    static constexpr bool PERM = true; static __device__ __forceinline__ bool keep(const Unit&) { return false; }
    bf16_t* H; int ldh;
    __device__ __forceinline__ void operator()(f32x4 (&acc)[2][2][4][2], const Unit& u, int wr, int wc, int fr, int fq) const {
        const int row0 = u.pm * BM + wr * 64 + fr, col0 = u.pn * HALF + wc * 32 + 8 * fq;
#pragma unroll
        for (int ai = 0; ai < 2; ++ai)
#pragma unroll
            for (int m = 0; m < 4; ++m) {
                f32x4 v0, v1;
#pragma unroll
                for (int i = 0; i < 4; ++i) { const float a0 = acc[ai][0][m][0][i], a1 = acc[ai][0][m][1][i];
                    v0[i] = a0 * sigm(a0) * acc[ai][1][m][0][i]; v1[i] = a1 * sigm(a1) * acc[ai][1][m][1][i]; }
                *(u32x4*)(H + (size_t)(row0 + ai * HALF + m * 16) * ldh + col0) = pack8(v0, v1); }
    }
};
struct EpiRes {
    static constexpr bool PERM = false; static __device__ __forceinline__ bool keep(const Unit&) { return false; }
    const float* res; float* out; float alpha, beta;
    __device__ __forceinline__ void operator()(f32x4 (&acc)[2][2][4][2], const Unit& u, int wr, int wc, int fr, int fq) const {
        const int row0 = u.pm * BM + wr * 64 + fr, col0 = u.pn * BM + wc * 32 + 4 * fq;
#pragma unroll
        for (int ai = 0; ai < 2; ++ai)
#pragma unroll
            for (int m = 0; m < 4; ++m) { const size_t off = (size_t)(row0 + ai * HALF + m * 16) * 1024 + col0;
#pragma unroll
                for (int bj = 0; bj < 2; ++bj)
#pragma unroll
                    for (int n = 0; n < 2; ++n) { const f32x4 r = *(const f32x4*)(res + off + bj * HALF + n * 16); *(f32x4*)(out + off + bj * HALF + n * 16) = r * alpha + acc[ai][bj][m][n] * beta; } }
    }
};
struct EpiProj {
    static constexpr bool PERM = true; static __device__ __forceinline__ bool keep(const Unit&) { return false; }
    bf16_t *G, *FQ, *FK, *FV, *MQ, *CQ, *CKV; float* SIDE; const float* bgate;
    __device__ __forceinline__ void operator()(f32x4 (&acc)[2][2][4][2], const Unit& u, int wr, int wc, int fr, int fq) const {
        const int row0 = u.pm * BM + wr * 64 + fr, pn = u.pn;
#pragma unroll
        for (int bj = 0; bj < 2; ++bj) {
            const int col = pn * BM + bj * HALF + wc * 32 + 8 * fq;
            bf16_t* base; int ld, dcol; float sc = 1.f; bool gate = false;
            if (pn < 12) { base = G; ld = 3072; dcol = col; gate = true; }
            else if (pn < 14) { base = FQ; ld = 512; dcol = col - 3072; sc = 0.125f * LOG2E; }
            else if (pn < 16) { base = FK; ld = 512; dcol = col - 3584; }
            else if (pn < 18) { base = FV; ld = 512; dcol = col - 4096; }
            else if (pn < 20) { base = MQ; ld = 512; dcol = col - 4608; sc = 0.08838834764831845f * LOG2E; }
            else { const int bc = col - 5120;
                if (bc < 384) { base = CQ; ld = 384; dcol = bc; } else if (bc < 640) { base = CKV; ld = 256; dcol = bc - 384; } else { base = nullptr; ld = 0; dcol = bc; } }
            f32x4 b0 = (f32x4){0.f, 0.f, 0.f, 0.f}, b1 = b0;
            if (gate) { b0 = *(const f32x4*)(bgate + col); b1 = *(const f32x4*)(bgate + col + 4); }
            const bool side = (pn == 22) && (bj == 1) && (wc == 0 || (wc == 1 && fq == 0));
#pragma unroll
            for (int ai = 0; ai < 2; ++ai)
#pragma unroll
                for (int m = 0; m < 4; ++m) { const size_t row = (size_t)(row0 + ai * HALF + m * 16);
                    f32x4 v0 = acc[ai][bj][m][0], v1 = acc[ai][bj][m][1];
                    if (gate) {
#pragma unroll
                        for (int i = 0; i < 4; ++i) { v0[i] = sigm(v0[i] + b0[i]); v1[i] = sigm(v1[i] + b1[i]); } }
                    else { v0 = v0 * sc; v1 = v1 * sc; }
                    if (base) *(u32x4*)(base + row * ld + dcol) = pack8(v0, v1);
                    if (side) { float* sp = SIDE + row * 40 + (dcol - 640); *(f32x4*)sp = v0; *(f32x4*)(sp + 4) = v1; } }
        }
    }
};
struct EpiKvup {
    static constexpr bool PERM = true; static __device__ __forceinline__ bool keep(const Unit&) { return false; }
    bf16_t* KN; bf16_t* VM;
    __device__ __forceinline__ void operator()(f32x4 (&acc)[2][2][4][2], const Unit& u, int wr, int wc, int fr, int fq) const {
        const int row0 = u.pm * BM + wr * 64 + fr; bf16_t* base = ((wc < 2) ? KN : VM) + (2 * u.pn) * 64 + (wc & 1) * 32 + 8 * fq;
#pragma unroll
        for (int ai = 0; ai < 2; ++ai)
#pragma unroll
            for (int m = 0; m < 4; ++m) { bf16_t* rowp = base + (size_t)(row0 + ai * HALF + m * 16) * 512;
#pragma unroll
                for (int bj = 0; bj < 2; ++bj) *(u32x4*)(rowp + bj * 64) = pack8(acc[ai][bj][m][0], acc[ai][bj][m][1]); }
    }
};
struct EpiBranch {
    static constexpr bool PERM = true; static __device__ __forceinline__ bool keep(const Unit& u) { return u.seg < 2; }
    const bf16_t* G; bf16_t* MG;
    __device__ __forceinline__ void operator()(f32x4 (&acc)[2][2][4][2], const Unit& u, int wr, int wc, int fr, int fq) const {
        const int row0 = u.pm * BM + wr * 64 + fr, col0 = u.pn * BM + wc * 32 + 8 * fq, seg = u.seg;
#pragma unroll
        for (int ai = 0; ai < 2; ++ai)
#pragma unroll
            for (int m = 0; m < 4; ++m) { const size_t row = (size_t)(row0 + ai * HALF + m * 16);
#pragma unroll
                for (int bj = 0; bj < 2; ++bj) { const int col = col0 + bj * HALF;
                    f32x4 ga0, ga1; unpack8(*(const u32x4*)(G + row * 3072 + seg * 1024 + col), ga0, ga1);
                    if (seg < 2) { f32x4 gb0, gb1; unpack8(*(const u32x4*)(G + row * 3072 + (seg + 1) * 1024 + col), gb0, gb1);
#pragma unroll
                        for (int i = 0; i < 4; ++i) { acc[ai][bj][m][0][i] *= fmaxf(ga0[i], 1e-30f) * __builtin_amdgcn_rcpf(fmaxf(gb0[i], 1e-30f)); acc[ai][bj][m][1][i] *= fmaxf(ga1[i], 1e-30f) * __builtin_amdgcn_rcpf(fmaxf(gb1[i], 1e-30f)); } }
                    else { f32x4 v0, v1;
#pragma unroll
                        for (int i = 0; i < 4; ++i) { v0[i] = acc[ai][bj][m][0][i] * fmaxf(ga0[i], 1e-30f); v1[i] = acc[ai][bj][m][1][i] * fmaxf(ga1[i], 1e-30f); }
                        *(u32x4*)(MG + row * 1024 + col) = pack8(v0, v1); } } }
    }
};
}

namespace att {
using pg8::bf16_t;
typedef short bf16x8 __attribute__((ext_vector_type(8)));
typedef short s16x4 __attribute__((ext_vector_type(4)));
typedef float f32x16 __attribute__((ext_vector_type(16)));
typedef unsigned u32x4 __attribute__((ext_vector_type(4)));
typedef unsigned u32x2 __attribute__((ext_vector_type(2)));
typedef float f32x4 __attribute__((ext_vector_type(4)));
#define ATT_LAS __attribute__((address_space(3)))
struct Args {
    const bf16_t* Q; int qp;
    const bf16_t* KA; int kap;
    const bf16_t* KB; int kbp;
    const bf16_t* V; int vp;
    bf16_t* O; int op;
    const float* RC; const float* RSN;
    const float* F2; float kmax;
};
__device__ __forceinline__ unsigned cvtpk(float lo, float hi) { unsigned r; asm volatile("v_cvt_pk_bf16_f32 %0, %1, %2" : "=v"(r) : "v"(lo), "v"(hi)); return r; }
__device__ __forceinline__ s16x4 vtr(const ATT_LAS unsigned char* p) { return __builtin_bit_cast(s16x4, __builtin_amdgcn_ds_read_tr16_b64_v4i16((ATT_LAS s16x4*)p)); }

template <int DKC, int DVB, bool CAUSAL, bool ROPE, int RG, bool PRUNE>
__device__ __forceinline__ void attn_unit(const Args a, long qrow0, long krow0, int q0, int NT, ATT_LAS unsigned char* lds) {
    int tid_ = threadIdx.x; asm volatile("" : "+v"(tid_));
    const int tid = tid_, lane = tid & 63, r32 = lane & 31, hi = lane >> 5;
    const int wid = __builtin_amdgcn_readfirstlane(tid >> 6);
    constexpr int KSLOT = DKC * 2048, VSLOT = DVB * 4096, NKC = PRUNE ? 8 : 2 * DKC, KL = (NKC + 7) / 8, VL = (DVB * 4 + 7) / 8;
    ATT_LAS unsigned char* Kb = lds; ATT_LAS unsigned char* Vb = lds + 2 * KSLOT;
    const int wrow = wid * 32 * RG;
    bf16x8 qr[RG][DKC];
#pragma unroll
    for (int g = 0; g < RG; ++g) {
        const bf16_t* qrow = a.Q + (size_t)(qrow0 + wrow + g * 32 + r32) * a.qp + hi * 8;
#pragma unroll
        for (int c = 0; c < (PRUNE ? 4 : DKC); ++c) qr[g][c] = *(const bf16x8*)(qrow + c * 16);
        if constexpr (PRUNE) {
            const float f2 = a.F2[q0 + wrow + g * 32 + r32];
            const unsigned h1 = cvtpk(f2, 0.f) & 0xffffu; const float r1 = f2 - __uint_as_float(h1 << 16);
            const unsigned h2 = cvtpk(r1, 0.f) & 0xffffu; const float r2 = r1 - __uint_as_float(h2 << 16); const unsigned h3 = cvtpk(r2, 0.f) & 0xffffu;
            u32x4 w = (u32x4){0x3f803f80u, 0x3f80u | (h1 << 16), h2 | (h3 << 16), 0u};
            if (hi) w = (u32x4){0u, 0u, 0u, 0u};
            qr[g][4] = __builtin_bit_cast(bf16x8, w);
        }
        if constexpr (ROPE) {
            const size_t trow = (size_t)(qrow0 + wrow + g * 32 + r32) * 16 + 8 * hi;
            const f32x4 c0 = *(const f32x4*)(a.RC + trow), c1 = *(const f32x4*)(a.RC + trow + 4), s0 = *(const f32x4*)(a.RSN + trow), s1 = *(const f32x4*)(a.RSN + trow + 4);
            bf16x8 x1 = qr[g][4], x2 = qr[g][5];
#pragma unroll
            for (int j = 0; j < 8; ++j) { const float cc = j < 4 ? c0[j & 3] : c1[j & 3], ss = j < 4 ? s0[j & 3] : s1[j & 3];
                const float a1 = __uint_as_float((unsigned)(unsigned short)x1[j] << 16), a2 = __uint_as_float((unsigned)(unsigned short)x2[j] << 16);
                const float r1 = a1 * cc - a2 * ss, r2 = a2 * cc + a1 * ss;
                x1[j] = (short)(cvtpk(r1, 0.f) & 0xffffu); x2[j] = (short)(cvtpk(r2, 0.f) & 0xffffu); }
            qr[g][4] = x1; qr[g][5] = x2;
        }
    }
#define ATT_DMA(t, buf) do { const size_t kr_ = (size_t)(krow0 + 64 * (t)); \
    _Pragma("unroll") for (int j = 0; j < KL; ++j) { const int c8 = wid + 8 * j; if (c8 < NKC) { \
        const bf16_t* src = (c8 < 8) ? (a.KA + (kr_ + lane) * a.kap + c8 * 8) : (a.KB + (kr_ + lane) * a.kbp + (c8 - 8) * 8); \
        __builtin_amdgcn_global_load_lds((const unsigned*)src, (ATT_LAS unsigned*)(Kb + (buf) * KSLOT + c8 * 1024), 16, 0, 0); } } \
    _Pragma("unroll") for (int j = 0; j < VL; ++j) { const int pc = wid + 8 * j; if (pc < DVB * 4) { \
        __builtin_amdgcn_global_load_lds((const unsigned*)(a.V + (kr_ + 16 * (pc & 3) + (lane >> 2)) * a.vp + 32 * (pc >> 2) + (lane & 3) * 8), (ATT_LAS unsigned*)(Vb + (buf) * VSLOT + pc * 1024), 16, 0, 0); } } } while (0)
    float ub[RG]; bool gdone[RG]; bool wdone = false;
    ATT_LAS unsigned* cnt = (ATT_LAS unsigned*)(lds + 2 * KSLOT + 2 * VSLOT);
    if constexpr (PRUNE) {
#pragma unroll
        for (int g = 0; g < RG; ++g) { float nq = 0.f;
#pragma unroll
            for (int c = 0; c < 4; ++c)
#pragma unroll
                for (int j = 0; j < 8; ++j) { const float v = __uint_as_float((unsigned)(unsigned short)qr[g][c][j] << 16); nq += v * v; }
            nq += __shfl_xor(nq, 32);
            ub[g] = sqrtf(nq) * a.kmax + 2.f + a.F2[q0 + wrow + g * 32 + r32]; gdone[g] = false; }
        if (tid == 0) cnt[0] = 0u;
    }
    float fst = 0.f;
#define ATT_KBIAS(buf) do { const unsigned h1 = cvtpk(fst, 0.f) & 0xffffu; const float r1 = fst - __uint_as_float(h1 << 16); \
        const unsigned h2 = cvtpk(r1, 0.f) & 0xffffu; const float r2 = r1 - __uint_as_float(h2 << 16); const unsigned h3 = cvtpk(r2, 0.f) & 0xffffu; \
        *(ATT_LAS u32x4*)(Kb + (buf) * KSLOT + 8 * 1024 + lane * 16) = (u32x4){(h1 ^ 0x8000u) | ((h2 ^ 0x8000u) << 16), (h3 ^ 0x8000u) | 0x3f800000u, 0x3f803f80u, 0u}; } while (0)
    if constexpr (PRUNE) {
        if (wid == 0) { fst = a.F2[64 * (NT - 1) + lane]; ATT_KBIAS(0); }
        if (wid == 1) { *(ATT_LAS u32x4*)(Kb + 9 * 1024 + lane * 16) = (u32x4){0u, 0u, 0u, 0u}; *(ATT_LAS u32x4*)(Kb + KSLOT + 9 * 1024 + lane * 16) = (u32x4){0u, 0u, 0u, 0u}; }
    }
    ATT_DMA(PRUNE ? NT - 1 : 0, 0);
    asm volatile("s_waitcnt vmcnt(0)" ::: "memory");
    __syncthreads();
    f32x16 o[RG][DVB];
    float mrun[RG], lrun[RG];
#pragma unroll
    for (int g = 0; g < RG; ++g) { mrun[g] = -1e30f; lrun[g] = 0.f;
#pragma unroll
        for (int d = 0; d < DVB; ++d)
#pragma unroll
            for (int r = 0; r < 16; ++r) o[g][d][r] = 0.f; }
    const int koff = hi * 1024 + r32 * 16;
    const int voff = ((lane >> 4) & 1) * 32 + (lane & 3) * 8 + (4 * hi + ((lane & 15) >> 2)) * 64;
    const int qw0 = q0 + wrow;
    for (int it = 0; it < NT; ++it) {
        const int t = PRUNE ? NT - 1 - it : it, buf = it & 1;
        if constexpr (PRUNE) { if (tid == 0) cnt[(it + 1) % 3] = 0u; }
        if (it + 1 < NT) { ATT_DMA(PRUNE ? t - 1 : t + 1, buf ^ 1); if constexpr (PRUNE) { if (wid == 0) fst = a.F2[64 * (t - 1) + lane]; } }
        const bool active = (!CAUSAL || (64 * t <= qw0 + 32 * RG - 1)) && !(PRUNE && wdone);
        if (active) {
            f32x16 s0[RG], s1[RG];
#pragma unroll
            for (int g = 0; g < RG; ++g)
#pragma unroll
                for (int r = 0; r < 16; ++r) { s0[g][r] = 0.f; s1[g][r] = 0.f; }
            const ATT_LAS unsigned char* kp = Kb + buf * KSLOT + koff;
#pragma unroll
            for (int c = 0; c < DKC; ++c) {
                const bf16x8 k0 = *(const ATT_LAS bf16x8*)(kp + c * 2048), k1 = *(const ATT_LAS bf16x8*)(kp + c * 2048 + 512);
#pragma unroll
                for (int g = 0; g < RG; ++g) {
                    s0[g] = __builtin_amdgcn_mfma_f32_32x32x16_bf16(k0, qr[g][c], s0[g], 0, 0, 0);
                    s1[g] = __builtin_amdgcn_mfma_f32_32x32x16_bf16(k1, qr[g][c], s1[g], 0, 0, 0);
                }
            }
            u32x4 pw[RG][4];
#pragma unroll
            for (int g = 0; g < RG; ++g) {
                if (CAUSAL && (64 * t + 63 > qw0 + 32 * g)) {
                    const int kb = 64 * t + 4 * hi, qpos = qw0 + 32 * g + r32;
#pragma unroll
                    for (int r = 0; r < 16; ++r) { const int kv = kb + (r & 3) + 8 * (r >> 2); if (kv > qpos) s0[g][r] = -INFINITY; if (kv + 32 > qpos) s1[g][r] = -INFINITY; }
                }
                float rm = __builtin_fmaxf(s0[g][0], s1[g][0]);
#pragma unroll
                for (int r = 1; r < 16; ++r) rm = __builtin_fmaxf(__builtin_fmaxf(rm, s0[g][r]), s1[g][r]);
                rm = __builtin_fmaxf(rm, __shfl_xor(rm, 32));
                const float mn = __builtin_fmaxf(mrun[g], rm);
                if (__builtin_amdgcn_ballot_w64(mn > mrun[g]) != 0ull) {
                    const float alpha = __builtin_amdgcn_exp2f(mrun[g] - mn);
                    lrun[g] *= alpha;
#pragma unroll
                    for (int d = 0; d < DVB; ++d)
#pragma unroll
                        for (int r = 0; r < 16; ++r) o[g][d][r] *= alpha;
                    mrun[g] = mn;
                }
                float sum = 0.f;
#pragma unroll
                for (int r = 0; r < 16; ++r) { s0[g][r] = __builtin_amdgcn_exp2f(s0[g][r] - mn); s1[g][r] = __builtin_amdgcn_exp2f(s1[g][r] - mn); sum += s0[g][r] + s1[g][r]; }
                lrun[g] += sum;
                if constexpr (PRUNE) { if (t > 0) { const float f2e = a.F2[64 * t - 1];
                    if (__builtin_amdgcn_ballot_w64((ub[g] - f2e - mrun[g]) < -40.f) == ~0ull) gdone[g] = true; } }
#pragma unroll
                for (int i = 0; i < 4; ++i) { pw[g][0][i] = cvtpk(s0[g][2 * i], s0[g][2 * i + 1]); pw[g][1][i] = cvtpk(s0[g][8 + 2 * i], s0[g][9 + 2 * i]);
                    pw[g][2][i] = cvtpk(s1[g][2 * i], s1[g][2 * i + 1]); pw[g][3][i] = cvtpk(s1[g][8 + 2 * i], s1[g][9 + 2 * i]); }
            }
            const ATT_LAS unsigned char* vpp = Vb + buf * VSLOT + voff;
#pragma unroll
            for (int d = 0; d < DVB; ++d)
#pragma unroll
                for (int ks = 0; ks < 4; ++ks) {
                    const s16x4 lo = vtr(vpp + d * 4096 + ks * 1024), hh = vtr(vpp + d * 4096 + ks * 1024 + 512);
                    const bf16x8 vf = (bf16x8){lo[0], lo[1], lo[2], lo[3], hh[0], hh[1], hh[2], hh[3]};
#pragma unroll
                    for (int g = 0; g < RG; ++g) o[g][d] = __builtin_amdgcn_mfma_f32_32x32x16_bf16(vf, __builtin_bit_cast(bf16x8, pw[g][ks]), o[g][d], 0, 0, 0);
                }
        }
        if constexpr (PRUNE) { if (wid == 0 && it + 1 < NT) ATT_KBIAS(buf ^ 1);
            bool all = true;
#pragma unroll
            for (int g = 0; g < RG; ++g) all = all && gdone[g];
            wdone = wdone || all;
            if (wdone && lane == 0) __hip_atomic_fetch_add(cnt + (it % 3), 1u, __ATOMIC_RELAXED, __HIP_MEMORY_SCOPE_WORKGROUP); }
        asm volatile("s_waitcnt vmcnt(0) lgkmcnt(0)" ::: "memory");
        __syncthreads();
        if constexpr (PRUNE) { if (((volatile ATT_LAS unsigned*)cnt)[it % 3] == 8u) break; }
    }
    if constexpr (PRUNE) __syncthreads();
#pragma unroll
    for (int g = 0; g < RG; ++g) {
        const float lt = lrun[g] + __shfl_xor(lrun[g], 32);
        const float inv = 1.f / lt;
        bf16_t* orow = a.O + (size_t)(qrow0 + wrow + g * 32 + r32) * a.op + 4 * hi;
#pragma unroll
        for (int d = 0; d < DVB; ++d)
#pragma unroll
            for (int gg = 0; gg < 4; ++gg) { u32x2 w; w.x = cvtpk(o[g][d][4 * gg] * inv, o[g][d][4 * gg + 1] * inv); w.y = cvtpk(o[g][d][4 * gg + 2] * inv, o[g][d][4 * gg + 3] * inv);
                *(u32x2*)(orow + 32 * d + 8 * gg) = w; }
    }
#undef ATT_DMA
#undef ATT_KBIAS
}
}

using pg8::bf16_t; using pg8::f32x4; using pg8::u32x4;
#define LAS __attribute__((address_space(3)))
constexpr int NB = 4, S = 8192, T = NB * S, D = 1024, FF = 2816, NPROJ = 5888, NWAVES = 8;
constexpr float ALPHA = 1.189207115002721f;
constexpr size_t MiB = 1u << 20;
constexpr size_t WS_RS = 2 * MiB;
constexpr size_t WS_RC = 3 * MiB;
constexpr size_t WS_RSN = 5 * MiB;
constexpr size_t WS_SIDE = 7 * MiB;
constexpr size_t WS_MEMB = 12 * MiB;
constexpr size_t WS_MEMKV = 14 * MiB;
constexpr size_t WS_WIN = 16 * MiB;
constexpr size_t WS_WUQ = 28 * MiB;
constexpr size_t WS_WUKV = 29 * MiB;
constexpr size_t WS_WMKV = 30 * MiB;
constexpr size_t WS_KR = 32 * MiB;
constexpr size_t WS_XB = 34 * MiB;
constexpr size_t WS_QM = 34 * MiB;
constexpr size_t WS_WBR = 82 * MiB;
constexpr size_t WS_WOUT = 87 * MiB;
constexpr size_t WS_H = 98 * MiB;
constexpr size_t WS_G = 98 * MiB;
constexpr size_t WS_SLOT0 = 290 * MiB;
constexpr size_t WS_FQ = 338 * MiB;
constexpr size_t WS_MQ = 434 * MiB;
constexpr size_t WS_FK = 370 * MiB;
constexpr size_t WS_FV = 402 * MiB;
constexpr size_t WS_KN = 370 * MiB;
constexpr size_t WS_VM = 402 * MiB;
constexpr size_t WS_MG = 370 * MiB;
constexpr size_t WS_WA = 480 * MiB;
constexpr size_t WS_WD = 491 * MiB;
constexpr size_t WS_END = 512 * MiB;
constexpr size_t ATILE = (size_t)256 * 512 * 2;
static_assert(WS_MQ + (size_t)T * 512 * 2 <= WS_WA && WS_WD + (size_t)1024 * 2816 * 2 <= WS_END && (WS_FQ - WS_SLOT0) % ATILE == 0 && (WS_MQ - WS_SLOT0) % ATILE == 0 && WS_MG + (size_t)T * 1024 * 2 <= WS_MQ, "ws map");
constexpr int LDS_BYTES = 147456;

__device__ __forceinline__ unsigned f2bf(float f) { unsigned u = __builtin_bit_cast(unsigned, f); return (u + 0x7fffu + ((u >> 16) & 1u)) >> 16; }
__device__ __forceinline__ unsigned pk2(float lo, float hi) { return f2bf(lo) | (f2bf(hi) << 16); }
__device__ __forceinline__ float bf2f(unsigned b) { return __uint_as_float(b << 16); }
__device__ __forceinline__ float wave_sum(float v) {
#pragma unroll
    for (int o = 1; o < 64; o <<= 1) v += __shfl_xor(v, o);
    return v;
}
#define LDS_WAIT() asm volatile("s_waitcnt lgkmcnt(0)" ::: "memory")

__device__ __forceinline__ int map_ffn(int c) { return c < FF ? ((c >> 7) << 8) + (c & 127) : (((c - FF) >> 7) << 8) + 128 + ((c - FF) & 127); }
__device__ __forceinline__ int map_win(int c) {
    if (c < 384) return 5120 + c;
    if (c < 640) return 5504 + (c - 384);
    if (c < 672) return 5760 + (c - 640);
    if (c < 1184) return 3072 + (c - 672);
    if (c < 1696) return 3584 + (c - 1184);
    if (c < 2208) return 4096 + (c - 1696);
    if (c < 2216) return 5792 + (c - 2208);
    if (c < 2728) return 4608 + (c - 2216);
    return c - 2728;
}
template <int MODE>
__device__ __forceinline__ void tr_mat(const float* __restrict__ W, int K, int N, const float* __restrict__ ks, bf16_t* WT, int ldt, int kmul, LAS float* scr, int gw, int NGW, int lane) {
    const int nblk = (N + 31) / 32, items = (K / 64) * nblk;
    for (int it = gw; it < items; it += NGW) {
        const int kb = it / nblk, nb = it % nblk, k0 = 64 * kb, n0 = 32 * nb;
        const int nn = n0 + (lane & 31); const bool ok = nn < N;
#pragma unroll 8
        for (int i = 0; i < 32; ++i) { const int kk = 2 * i + (lane >> 5); float v = ok ? W[(size_t)(k0 + kk) * N + nn] : 0.f; if (ks) v *= ks[k0 + kk]; scr[kk * 33 + (lane & 31)] = v; }
        LDS_WAIT(); asm volatile("" ::: "memory");
        const int c = lane & 7, dc = kb * kmul + 8 * c;
#pragma unroll
        for (int j = 0; j < 4; ++j) { const int n = (lane >> 3) + 8 * j, sc = n0 + n;
            if (sc < N) { const LAS float* s = scr + (8 * c) * 33 + n;
                u32x4 o; o.x = pk2(s[0 * 33], s[1 * 33]); o.y = pk2(s[2 * 33], s[3 * 33]); o.z = pk2(s[4 * 33], s[5 * 33]); o.w = pk2(s[6 * 33], s[7 * 33]);
                const int dr = MODE == 1 ? map_ffn(sc) : (MODE == 2 ? map_win(sc) : sc);
                *(u32x4*)(WT + (size_t)dr * ldt + dc) = o; } }
        LDS_WAIT(); asm volatile("" ::: "memory");
    }
}
__device__ __forceinline__ void cvt_copy(const float* __restrict__ src, bf16_t* dst, size_t n, size_t gt, size_t NTH) {
    size_t i = gt * 8;
    for (; i + 3 * NTH * 8 < n; i += 4 * NTH * 8) {
        f32x4 a[4], b[4];
#pragma unroll
        for (int u = 0; u < 4; ++u) { a[u] = __builtin_nontemporal_load((const f32x4*)(src + i + u * NTH * 8)); b[u] = __builtin_nontemporal_load((const f32x4*)(src + i + u * NTH * 8 + 4)); }
#pragma unroll
        for (int u = 0; u < 4; ++u) { u32x4 o; o.x = pk2(a[u][0], a[u][1]); o.y = pk2(a[u][2], a[u][3]); o.z = pk2(b[u][0], b[u][1]); o.w = pk2(b[u][2], b[u][3]); *(u32x4*)(dst + i + u * NTH * 8) = o; }
    }
    for (; i < n; i += NTH * 8) { const f32x4 a = *(const f32x4*)(src + i), b = *(const f32x4*)(src + i + 4);
        u32x4 o; o.x = pk2(a[0], a[1]); o.y = pk2(a[2], a[3]); o.z = pk2(b[0], b[1]); o.w = pk2(b[2], b[3]); *(u32x4*)(dst + i) = o; }
}
__device__ __forceinline__ void ln_row(const float* xrow, const float* __restrict__ g, const float* __restrict__ b, float* outf, bf16_t* outb, int lane) {
    f32x4 v[4]; float s = 0.f;
#pragma unroll
    for (int j = 0; j < 4; ++j) { v[j] = *(const f32x4*)(xrow + 4 * lane + 256 * j); s += (v[j][0] + v[j][1]) + (v[j][2] + v[j][3]); }
    const float mean = wave_sum(s) * (1.f / D); float s2 = 0.f;
#pragma unroll
    for (int j = 0; j < 4; ++j) { v[j] = v[j] - mean; s2 += (v[j][0] * v[j][0] + v[j][1] * v[j][1]) + (v[j][2] * v[j][2] + v[j][3] * v[j][3]); }
    const float rstd = 1.f / sqrtf(wave_sum(s2) * (1.f / D) + 1e-5f);
#pragma unroll
    for (int j = 0; j < 4; ++j) { const f32x4 gg = *(const f32x4*)(g + 4 * lane + 256 * j), bb = *(const f32x4*)(b + 4 * lane + 256 * j);
        const f32x4 y = v[j] * rstd * gg + bb;
        if (outf) *(f32x4*)(outf + 4 * lane + 256 * j) = y;
        if (outb) { unsigned long long w = (unsigned long long)pk2(y[0], y[1]) | ((unsigned long long)pk2(y[2], y[3]) << 32); *(unsigned long long*)(outb + 4 * lane + 256 * j) = w; } }
}

#define XB_TMO      128
#define XB_XCNT(j)  (256  + 64 * (j))
#define XB_XSUB(j)  (1280 + 64 * (j))
#define XB_XGEN(j)  (2304 + 64 * (j))
#define XB_TOP      3328
#define XB_TOPGEN   3392
#define XCD_BAR_WORDS 3456
#define XB_SPIN_CAP (1u << 18)

__device__ __forceinline__ unsigned xb_ld(unsigned* p)              { return __hip_atomic_load(p, __ATOMIC_RELAXED, __HIP_MEMORY_SCOPE_AGENT); }
__device__ __forceinline__ unsigned xb_add(unsigned* p, unsigned v) { return __hip_atomic_fetch_add(p, v, __ATOMIC_RELAXED, __HIP_MEMORY_SCOPE_AGENT); }
__device__ __forceinline__ unsigned xb_xcc_id() { return (unsigned)__builtin_amdgcn_s_getreg((3 << 11) | 20) & 0xFu; }
#define XB_SPIN(cond, bar) do { unsigned _sp = 0; while (cond) { __builtin_amdgcn_s_sleep(1); \
    if ((++_sp & 255u) == 0u) { if (xb_ld(&(bar)[XB_TMO])) break; if (_sp > XB_SPIN_CAP) { atomicAdd(&(bar)[XB_TMO], 1u); break; } } } } while (0)

struct XcdBarrier {
    unsigned* bar; unsigned x;
    volatile LAS unsigned* st;
};

__device__ __forceinline__ XcdBarrier xcd_barrier_post(unsigned* bar, volatile LAS unsigned* st) {
    XcdBarrier b; b.bar = bar; b.x = xb_xcc_id(); b.st = st;
    if (threadIdx.x == 0) (void)xb_add(&bar[XB_XCNT(b.x)], 1u);
    return b;
}
__device__ __forceinline__ void xcd_barrier_complete(unsigned* bar, unsigned x, unsigned& nloc, unsigned& nx) {
    const unsigned G = gridDim.x * gridDim.y * gridDim.z;
    unsigned sum, cnt, mine, sp = 0u;
    for (;;) {
        sum = 0u; cnt = 0u; mine = 0u;
#pragma unroll
        for (unsigned j = 0; j < 16; ++j) { const unsigned c = xb_ld(&bar[XB_XCNT(j)]); sum += c; cnt += (c > 0u) ? 1u : 0u; mine = (j == x) ? c : mine; }
        if (sum == G) break;
        __builtin_amdgcn_s_sleep(1);
        if ((++sp & 255u) == 0u) { if (xb_ld(&bar[XB_TMO])) break; if (sp > XB_SPIN_CAP) { atomicAdd(&bar[XB_TMO], 1u); break; } }
    }
    nloc = mine > 0u ? mine : 1u; nx = cnt > 0u ? cnt : 1u;
}

__device__ __forceinline__ void xcd_barrier(const XcdBarrier& b) {
    asm volatile("s_waitcnt vmcnt(0)" ::: "memory");
    __syncthreads();
    if (threadIdx.x == 0) {
        unsigned* bar = b.bar;
        __builtin_amdgcn_s_waitcnt(0);
        unsigned nloc = b.st[0], nx = b.st[1];
        if (nloc == 0u) { xcd_barrier_complete(bar, b.x, nloc, nx); b.st[0] = nloc; b.st[1] = nx; }
        const unsigned old = xb_add(&bar[XB_XSUB(b.x)], 1u);
        const unsigned gen = old / nloc;
        if (old + 1u == (gen + 1u) * nloc) {
            __builtin_amdgcn_fence(__ATOMIC_RELEASE, "agent");
            asm volatile("s_waitcnt vmcnt(0)" ::: "memory");
            const unsigned og = xb_add(&bar[XB_TOP], 1u);
            const unsigned tg = og / nx;
            if (og + 1u == (tg + 1u) * nx) xb_add(&bar[XB_TOPGEN], 1u);
            else XB_SPIN(xb_ld(&bar[XB_TOPGEN]) == tg, bar);
            __builtin_amdgcn_fence(__ATOMIC_ACQUIRE, "agent");
            xb_add(&bar[XB_XGEN(b.x)], 1u);
            asm volatile("s_waitcnt vmcnt(0)" ::: "memory");
        } else {
            XB_SPIN(xb_ld(&bar[XB_XGEN(b.x)]) == gen, bar);
            __builtin_amdgcn_fence(__ATOMIC_ACQUIRE, "agent");
            asm volatile("s_waitcnt vmcnt(0)" ::: "memory");
        }
    }
    __syncthreads();
}

#ifndef PH_MASK
#define PH_MASK 0xFFFF
#endif
struct Params { const float* in[25]; float* out; unsigned char* ws; };

__global__ void __launch_bounds__(NWAVES * 64) mega_fwd(Params p) {
    extern __shared__ __attribute__((aligned(16))) unsigned char lds_raw[];
    cg::grid_group grid = cg::this_grid();
    LAS unsigned char* lds = (LAS unsigned char*)lds_raw;
    const int tid = threadIdx.x, lane = tid & 63, wave = __builtin_amdgcn_readfirstlane(tid >> 6);
    const int G = gridDim.x, bx = blockIdx.x;
    const int gw = bx * NWAVES + wave, NGW = G * NWAVES;
    const size_t gt = (size_t)bx * (NWAVES * 64) + tid, NTH = (size_t)G * (NWAVES * 64);
    unsigned char* ws = p.ws;
    const float* x = p.in[0]; const float* mem = p.in[1]; const int* positions = (const int*)p.in[2];
    float* R = p.out;
    float* KMAX = (float*)(ws + WS_RS); float* F2T = (float*)(ws + 1 * MiB); float* RC = (float*)(ws + WS_RC); float* RSN = (float*)(ws + WS_RSN); float* SIDE = (float*)(ws + WS_SIDE);
    bf16_t* MEMB = (bf16_t*)(ws + WS_MEMB); bf16_t* MEMKV = (bf16_t*)(ws + WS_MEMKV);
    bf16_t* WIN = (bf16_t*)(ws + WS_WIN); bf16_t* WUQ = (bf16_t*)(ws + WS_WUQ); bf16_t* WUKV = (bf16_t*)(ws + WS_WUKV); bf16_t* WMKV = (bf16_t*)(ws + WS_WMKV);
    bf16_t* KR = (bf16_t*)(ws + WS_KR); bf16_t* XB = (bf16_t*)(ws + WS_XB); bf16_t* QM = (bf16_t*)(ws + WS_QM); bf16_t* WBR = (bf16_t*)(ws + WS_WBR); bf16_t* WOUT = (bf16_t*)(ws + WS_WOUT);
    bf16_t* HB = (bf16_t*)(ws + WS_H); bf16_t* GB = (bf16_t*)(ws + WS_G); bf16_t* SLOT0 = (bf16_t*)(ws + WS_SLOT0); bf16_t* CQ = SLOT0; bf16_t* CKV = SLOT0 + (size_t)T * 384; bf16_t* FQ = (bf16_t*)(ws + WS_FQ); bf16_t* MQ = (bf16_t*)(ws + WS_MQ);
    bf16_t* FK = (bf16_t*)(ws + WS_FK); bf16_t* FV = (bf16_t*)(ws + WS_FV); bf16_t* KN = (bf16_t*)(ws + WS_KN); bf16_t* VM = (bf16_t*)(ws + WS_VM); bf16_t* MG = (bf16_t*)(ws + WS_MG);
    bf16_t* WA = (bf16_t*)(ws + WS_WA); bf16_t* WD = (bf16_t*)(ws + WS_WD);
    LAS float* scr = (LAS float*)(lds + wave * 16384);
    volatile LAS unsigned* MISC = (volatile LAS unsigned*)(lds + 131072 + 256);
    if (tid < 2) MISC[tid] = 0u;
    unsigned* barw = (unsigned*)ws;
    __syncthreads();
    const XcdBarrier xb = xcd_barrier_post(barw, MISC);
    if (ws == nullptr) grid.sync();

#if (PH_MASK >> 0) & 1
    tr_mat<1>(p.in[5], D, 2 * FF, nullptr, WA, D, 64, scr, gw, NGW, lane);
    tr_mat<0>(p.in[6], FF, D, nullptr, WD, FF, 64, scr, gw, NGW, lane);
    tr_mat<2>(p.in[7], D, 5800, nullptr, WIN, D, 64, scr, gw, NGW, lane);
    tr_mat<0>(p.in[10], 384, 768, p.in[9], WUQ, 384, 64, scr, gw, NGW, lane);
    tr_mat<0>(p.in[12], 256, 1024, p.in[11], WUKV, 256, 64, scr, gw, NGW, lane);
    tr_mat<0>(p.in[14], D, 1024, nullptr, WMKV, D, 64, scr, gw, NGW, lane);
    for (size_t i = gt * 8; i < (size_t)88 * D; i += NTH * 8) *(u32x4*)(WIN + (size_t)5800 * D + i) = (u32x4){0u, 0u, 0u, 0u};
    if (gt < 32) KMAX[gt] = 0.f;
    cvt_copy(x, XB, (size_t)T * D, gt, NTH);
    cvt_copy(mem, MEMB, (size_t)NB * 256 * D, gt, NTH);
    for (size_t i = gt; i < (size_t)T * 16; i += NTH) {
        const int row = (int)(i >> 4), f = (int)(i & 15);
        const float invf = (float)exp2(-(double)f * (13.287712379549449 / 16.0));
        const float ang = (float)positions[row] * invf;
        const double rev = (double)ang * 0.15915494309189535; const float fr = (float)(rev - __builtin_rint(rev));
        RC[i] = __builtin_amdgcn_cosf(fr); RSN[i] = __builtin_amdgcn_sinf(fr);
    }
#endif
    xcd_barrier(xb);

#if (PH_MASK >> 1) & 1
    { pg8::Gemm g{XB, WA, T, 2 * FF, D}; pg8::StaticOrder so; so.init(T, 2 * FF, G, bx);
      pg8::EpiSwiglu E{HB, FF}; pg8::gemm_phase<pg8::EpiSwiglu, pg8::StaticOrder, true>(lds, g, so, E); }
#endif
    xcd_barrier(xb);
#if (PH_MASK >> 2) & 1
    { pg8::Gemm g{HB, WD, T, D, FF}; pg8::StaticOrder so; so.init(T, D, G, bx);
      pg8::EpiRes E{x, R, ALPHA, 0.5f}; pg8::gemm_phase<pg8::EpiRes, pg8::StaticOrder, true>(lds, g, so, E); }
#endif
    xcd_barrier(xb);
#if (PH_MASK >> 3) & 1
    for (int m = gw; m < T; m += NGW) ln_row(R + (size_t)m * D, p.in[3], p.in[4], R + (size_t)m * D, XB + (size_t)m * D, lane);
#endif
    xcd_barrier(xb);
#if (PH_MASK >> 4) & 1
    { pg8::Gemm g{XB, WIN, T, NPROJ, D}; pg8::StaticOrder so; so.init(T, NPROJ, G, bx);
      pg8::EpiProj E{GB, FQ, FK, FV, MQ, CQ, CKV, SIDE, p.in[8]}; pg8::gemm_phase<pg8::EpiProj, pg8::StaticOrder, true>(lds, g, so, E); }
    { pg8::Gemm g{MEMB, WMKV, NB * 256, 1024, D}; pg8::StaticOrder so; so.init(NB * 256, 1024, G, (bx + 128) % G);
      pg8::EpiPlain E{MEMKV, 1024, 1.f}; pg8::gemm_phase<pg8::EpiPlain, pg8::StaticOrder, true>(lds, g, so, E); }
#endif
    xcd_barrier(xb);
#if (PH_MASK >> 5) & 1
    if (bx < 32) {
        const int b = bx >> 3, h = bx & 7; LAS double* sh = (LAS double*)lds;
        const float bfh = p.in[13][h]; float lf[16]; double loc = 0.0;
#pragma unroll
        for (int j = 0; j < 16; ++j) { const float xx = SIDE[((size_t)b * S + 16 * tid + j) * 40 + 32 + h] + bfh; lf[j] = fminf(xx, 0.f) - log1pf(__expf(-fabsf(xx))); loc += (double)lf[j]; }
        double incl = loc;
#pragma unroll
        for (int o = 1; o < 64; o <<= 1) { const double v = __shfl_up(incl, o); if (lane >= o) incl += v; }
        if (lane == 63) sh[wave] = incl;
        __syncthreads();
        double run = incl - loc;
        for (int w = 0; w < wave; ++w) run += sh[w];
#pragma unroll
        for (int j = 0; j < 16; ++j) { run += (double)lf[j];
            const float f2 = (float)(run * 1.4426950408889634);
            F2T[(size_t)bx * S + 16 * tid + j] = f2; }
        __syncthreads();
    }
    float kmrun = 0.f; int curb = gw >> 13;
    for (int m = gw; m < T; m += NGW) {
        { const int bb = m >> 13;
          if (bb != curb) { if ((lane & 7) == 0) atomicMax((unsigned*)KMAX + curb * 8 + (lane >> 3), __float_as_uint(kmrun)); kmrun = 0.f; curb = bb; }
          f32x4 k0, k1; pg8::unpack8(*(const u32x4*)(FK + (size_t)m * 512 + lane * 8), k0, k1); float ks = 0.f;
#pragma unroll
          for (int i = 0; i < 4; ++i) ks += k0[i] * k0[i] + k1[i] * k1[i];
          ks += __shfl_xor(ks, 1); ks += __shfl_xor(ks, 2); ks += __shfl_xor(ks, 4);
          kmrun = fmaxf(kmrun, ks); }
        f32x4 a0, a1, c0, c1; float sq = 0.f, sq2 = 0.f;
        if (lane < 48) { pg8::unpack8(*(const u32x4*)(CQ + (size_t)m * 384 + lane * 8), a0, a1);
#pragma unroll
            for (int i = 0; i < 4; ++i) sq += a0[i] * a0[i] + a1[i] * a1[i]; }
        if (lane < 32) { pg8::unpack8(*(const u32x4*)(CKV + (size_t)m * 256 + lane * 8), c0, c1);
#pragma unroll
            for (int i = 0; i < 4; ++i) sq2 += c0[i] * c0[i] + c1[i] * c1[i]; }
        const float rq = 1.f / sqrtf(wave_sum(sq) * (1.f / 384.f) + 1e-6f), rkv = 1.f / sqrtf(wave_sum(sq2) * (1.f / 256.f) + 1e-6f);
        if (lane < 48) *(u32x4*)(CQ + (size_t)m * 384 + lane * 8) = pg8::pack8(a0 * rq, a1 * rq);
        if (lane < 32) *(u32x4*)(CKV + (size_t)m * 256 + lane * 8) = pg8::pack8(c0 * rkv, c1 * rkv);
        if (lane < 16) { const float x1 = SIDE[(size_t)m * 40 + lane], x2 = SIDE[(size_t)m * 40 + 16 + lane], c = RC[(size_t)m * 16 + lane], s = RSN[(size_t)m * 16 + lane];
            KR[(size_t)m * 32 + lane] = (bf16_t)f2bf(x1 * c - x2 * s); KR[(size_t)m * 32 + 16 + lane] = (bf16_t)f2bf(x2 * c + x1 * s); }
    }
    if ((lane & 7) == 0) atomicMax((unsigned*)KMAX + curb * 8 + (lane >> 3), __float_as_uint(kmrun));
    tr_mat<0>(p.in[15], 512, D, nullptr, WBR, 512, 64, scr, gw, NGW, lane);
    tr_mat<0>(p.in[16], 512, D, nullptr, WBR + (size_t)1024 * 512, 512, 64, scr, gw, NGW, lane);
    tr_mat<0>(p.in[17], 512, D, nullptr, WBR + (size_t)2048 * 512, 512, 64, scr, gw, NGW, lane);
    tr_mat<0>(p.in[18], D, D, nullptr, WOUT, D, 64, scr, gw, NGW, lane);
    __syncthreads();
    for (int u = bx; u < NB * 4 * 32; u += G) {
        const int b = u >> 7, hm = (u >> 5) & 3, qb = u & 31;
        att::Args a{MQ + hm * 128, 512, MEMKV + hm * 128, 1024, MEMKV + hm * 128 + 64, 1024, MEMKV + 512 + hm * 128, 1024, MQ + hm * 128, 512, nullptr, nullptr, nullptr, 0.f};
        att::attn_unit<8, 4, false, false, 1, false>(a, (long)b * S + qb * 256, (long)b * 256, 0, 4, lds);
    }
#endif
    xcd_barrier(xb);
#if (PH_MASK >> 6) & 1
    for (int u = bx; u < 512; u += G) {
        const int v = u & 255, i = u >> 8, vcu = (v & 7) * 32 + (v >> 3), bh = vcu >> 3, s = vcu & 7;
        const int qb = (i == 0) ? s : 15 - s; const int b = bh >> 3, h = bh & 7;
        att::Args a{FQ + h * 64, 512, FK + h * 64, 512, nullptr, 0, FV + h * 64, 512, FQ + h * 64, 512, nullptr, nullptr, F2T + (size_t)bh * S, sqrtf(KMAX[bh]) * 1.001f};
        att::attn_unit<5, 2, true, false, 2, true>(a, (long)b * S + qb * 512, (long)b * S, qb * 512, 8 * (qb + 1), lds);
    }
#endif
    xcd_barrier(xb);
#if (PH_MASK >> 7) & 1
    { pg8::Gemm g{CQ, WUQ, T, 768, 384}; pg8::StaticOrder so; so.init(T, 768, G, bx);
      pg8::EpiPlain E{QM, 768, 0.10206207261596577f * pg8::LOG2E}; pg8::gemm_phase<pg8::EpiPlain, pg8::StaticOrder, true>(lds, g, so, E); }
    { pg8::Gemm g{CKV, WUKV, T, 1024, 256}; pg8::StaticOrder so; so.init(T, 1024, G, bx);
      pg8::EpiKvup E{KN, VM}; pg8::gemm_phase<pg8::EpiKvup, pg8::StaticOrder, true>(lds, g, so, E); }
#endif
    xcd_barrier(xb);
#if (PH_MASK >> 8) & 1
    for (int u = bx; u < 512; u += G) {
        const int v = u & 255, i = u >> 8, vcu = (v & 7) * 32 + (v >> 3), bh = vcu >> 3, s = vcu & 7;
        const int qb = (i == 0) ? s : 15 - s; const int b = bh >> 3, h = bh & 7;
        att::Args a{QM + h * 96, 768, KN + h * 64, 512, KR, 32, VM + h * 64, 512, SLOT0 + h * 64, 512, RC, RSN, nullptr, 0.f};
        att::attn_unit<6, 2, true, true, 2, false>(a, (long)b * S + qb * 512, (long)b * S, qb * 512, 8 * (qb + 1), lds);
    }
#endif
    xcd_barrier(xb);
#if (PH_MASK >> 9) & 1
    { pg8::Gemm g{SLOT0, WBR, T, D, 512}; pg8::SegOrder so; so.init(T, D, G, bx, (int)((WS_FQ - WS_SLOT0) / ATILE), (int)((WS_MQ - WS_SLOT0) / ATILE));
      pg8::EpiBranch E{GB, MG}; pg8::gemm_phase<pg8::EpiBranch, pg8::SegOrder, true>(lds, g, so, E); }
#endif
    xcd_barrier(xb);
#if (PH_MASK >> 10) & 1
    { pg8::Gemm g{MG, WOUT, T, D, D}; pg8::StaticOrder so; so.init(T, D, G, bx);
      pg8::EpiRes E{R, R, ALPHA, 1.f}; pg8::gemm_phase<pg8::EpiRes, pg8::StaticOrder, true>(lds, g, so, E); }
#endif
    xcd_barrier(xb);
#if (PH_MASK >> 11) & 1
    for (int m = gw; m < T; m += NGW) ln_row(R + (size_t)m * D, p.in[19], p.in[20], R + (size_t)m * D, XB + (size_t)m * D, lane);
    tr_mat<1>(p.in[21], D, 2 * FF, nullptr, WA, D, 64, scr, gw, NGW, lane);
    tr_mat<0>(p.in[22], FF, D, nullptr, WD, FF, 64, scr, gw, NGW, lane);
#endif
    xcd_barrier(xb);
#if (PH_MASK >> 12) & 1
    { pg8::Gemm g{XB, WA, T, 2 * FF, D}; pg8::StaticOrder so; so.init(T, 2 * FF, G, bx);
      pg8::EpiSwiglu E{HB, FF}; pg8::gemm_phase<pg8::EpiSwiglu, pg8::StaticOrder, true>(lds, g, so, E); }
#endif
    xcd_barrier(xb);
#if (PH_MASK >> 13) & 1
    { pg8::Gemm g{HB, WD, T, D, FF}; pg8::StaticOrder so; so.init(T, D, G, bx);
      pg8::EpiRes E{R, R, ALPHA, 0.5f}; pg8::gemm_phase<pg8::EpiRes, pg8::StaticOrder, true>(lds, g, so, E); }
#endif
    xcd_barrier(xb);
#if (PH_MASK >> 14) & 1
    for (int m = gw; m < T; m += NGW) ln_row(R + (size_t)m * D, p.in[23], p.in[24], R + (size_t)m * D, nullptr, lane);
#endif
}

extern "C" void kernel_launch(void* const* d_in, const int* in_sizes, int n_in, void* d_out, int out_size, void* d_ws, size_t ws_size, hipStream_t stream) {
    static int grid = 0;
    if (grid == 0) {
        if (n_in != 25 || out_size != T * D || ws_size < WS_END) { fprintf(stderr, "kernel_launch: unexpected shapes (n_in %d out %d ws %zu)\n", n_in, out_size, ws_size); grid = -1; return; }
        int dev = 0, cus = 0, per = 0;
        (void)hipGetDevice(&dev); (void)hipDeviceGetAttribute(&cus, hipDeviceAttributeMultiprocessorCount, dev);
        (void)hipFuncSetAttribute((const void*)mega_fwd, hipFuncAttributeMaxDynamicSharedMemorySize, LDS_BYTES);
        (void)hipOccupancyMaxActiveBlocksPerMultiprocessor(&per, (const void*)mega_fwd, NWAVES * 64, LDS_BYTES);
        if (per < 1) per = 1;
        grid = cus * per;
        fprintf(stderr, "kernel_launch: grid %d (cus %d x %d), ws %zu\n", grid, cus, per, ws_size);
    }
    if (grid < 0) return;
    (void)hipMemsetAsync(d_ws, 0, 16384, stream);
    Params p{};
    for (int i = 0; i < 25; ++i) p.in[i] = (const float*)d_in[i];
    p.out = (float*)d_out; p.ws = (unsigned char*)d_ws;
    void* args[] = {&p};
    const hipError_t e = hipLaunchCooperativeKernel((const void*)mega_fwd, dim3(grid), dim3(NWAVES * 64), args, LDS_BYTES, stream);
    if (e != hipSuccess) fprintf(stderr, "kernel_launch: cooperative launch failed: %s (grid %d)\n", hipGetErrorString(e), grid);
}
```

```cpp
#include <hip/hip_runtime.h>
#include <hip/hip_cooperative_groups.h>
#include <cstdio>
#include <cstdint>
#include <cmath>
namespace cg = cooperative_groups;
namespace pg8 {
#define PG8_LAS __attribute__((address_space(3)))
typedef unsigned short bf16_t;
typedef short bf16x8 __attribute__((ext_vector_type(8)));
typedef float f32x4 __attribute__((ext_vector_type(4)));
typedef unsigned u32x4 __attribute__((ext_vector_type(4)));
constexpr int BM = 256, BK = 64, HALF = 128, HTB = HALF * BK * 2  , STAGE_BYTES = 8 * HTB, NXCD = 8, WGM = 8;

__host__ __device__ __forceinline__ int lds_byte(int r, int c) { const int st = (r >> 4) * 2 + (c >> 5), rr = r & 15, cc = c & 31, ob = rr * 64 + cc * 2; return st * 1024 + (ob ^ (((ob >> 9) & 1) << 5)); }
__host__ __device__ __forceinline__ void stage_rc(int b, int& R, int& C) { const int st = b / 1024, sb = b % 1024, swz = sb ^ (((sb >> 9) & 1) << 5); R = (st >> 1) * 16 + swz / 64; C = (st & 1) * 32 + (swz % 64) / 2; }
__host__ __device__ __forceinline__ int perm32(int rho) { const int n = rho >> 4, i = rho & 15; return 8 * (i >> 2) + 4 * n + (i & 3); }

struct Unit { int pm, pn, am, bn, seg; };
struct Gemm { const bf16_t* A; const bf16_t* Bt; int M, N, K; };

struct StaticOrder {
    int nM, nN, nwg, G, c;
    __host__ __device__ void init(int M, int N, int G_, int c_) { nM = M / BM; nN = N / BM; nwg = nM * nN; G = G_; c = c_; }
    __host__ __device__ bool next(int i, Unit& u) const {
        const long L = (long)i * G + c; if (L >= nwg) return false;
        int wgid = (int)L; { const int q = nwg / NXCD, r = nwg % NXCD, xcd = wgid % NXCD, off = wgid / NXCD; wgid = (xcd < r ? xcd * (q + 1) : r * (q + 1) + (xcd - r) * q) + off; }
        const int nig = WGM * nN, gid = wgid / nig, fm = gid * WGM, gsz = (nM - fm) < WGM ? (nM - fm) : WGM;
        u.pm = fm + ((wgid % nig) % gsz); u.pn = (wgid % nig) / gsz; u.am = u.pm; u.bn = u.pn; u.seg = 0; return true;
    }
};

__device__ __forceinline__ unsigned cvt_pk_bf16(float lo, float hi) { unsigned r; asm volatile("v_cvt_pk_bf16_f32 %0, %1, %2" : "=v"(r) : "v"(lo), "v"(hi)); return r; }
typedef float f32x2 __attribute__((ext_vector_type(2)));
template <class Epi, class Sched, bool ALIGN_EPI = false, bool SP2 = true>
__device__ __forceinline__ void gemm_phase(PG8_LAS unsigned char* lds, const Gemm g, const Sched& S, const Epi& E) {
    int tid_ = threadIdx.x; asm volatile("" : "+v"(tid_));
    const int tid = tid_, wid = __builtin_amdgcn_readfirstlane(tid >> 6), lane = tid & 63, wr = wid >> 2, wc = wid & 3, fr = lane & 15, fq = lane >> 4;
    const int K = g.K, nt = K / BK;
    unsigned voffA[2], voffB[2];
#pragma unroll
    for (int i = 0; i < 2; ++i) { int R, C; stage_rc(tid * 16 + i * 8192, R, C); const int Rb = Epi::PERM ? ((R & ~31) + perm32(R & 31)) : R;
        voffA[i] = (unsigned)(R * K + C) * 2u; voffB[i] = (unsigned)(Rb * K + C) * 2u; }
    const size_t kstep = (size_t)(BK * 2);
    const size_t hstep = (size_t)HALF * K * 2;
    const size_t tstep = 2 * hstep;
    const unsigned ldsw = (unsigned)wid * 1024u;
    const int aoff = lds_byte(wr * 64 + fr, fq * 8), boff = lds_byte(wc * 32 + fr, fq * 8);
#define PG8_SA(b, h) (((b) * 2 + (h)) * HTB)
#define PG8_SB(b, h) ((4 + (b) * 2 + (h)) * HTB)
#define PG8_STAGE(bufoff, gbase, voff) do { _Pragma("unroll") for (int _i = 0; _i < 2; ++_i) \
        __builtin_amdgcn_global_load_lds((const unsigned*)((const char*)(gbase) + (voff)[_i]), (PG8_LAS unsigned*)(lds + (bufoff) + ldsw + _i * 8192), 16, 0, 0); } while (0)
#define PG8_LDA(dst, b, h) do { _Pragma("unroll") for (int m = 0; m < 4; ++m) _Pragma("unroll") for (int k = 0; k < 2; ++k) dst[m][k] = *(const PG8_LAS bf16x8*)(lds + PG8_SA(b, h) + aoff + m * 2048 + k * 1024); } while (0)
#define PG8_LDB(dst, b, h) do { _Pragma("unroll") for (int n = 0; n < 2; ++n) _Pragma("unroll") for (int k = 0; k < 2; ++k) dst[n][k] = *(const PG8_LAS bf16x8*)(lds + PG8_SB(b, h) + boff + n * 2048 + k * 1024); } while (0)
#define PG8_MMA(ai, bj, At, Bt) do { __builtin_amdgcn_s_setprio(1); _Pragma("unroll") for (int m = 0; m < 4; ++m) _Pragma("unroll") for (int n = 0; n < 2; ++n) _Pragma("unroll") for (int k = 0; k < 2; ++k) \
        acc[ai][bj][m][n] = __builtin_amdgcn_mfma_f32_16x16x32_bf16(Bt[n][k], At[m][k], acc[ai][bj][m][n], 0, 0, 0); __builtin_amdgcn_s_setprio(0); } while (0)
#define PG8_WAIT_V(n) asm volatile("s_waitcnt vmcnt(" #n ")" ::: "memory")
#define PG8_WAIT_L(n) asm volatile("s_waitcnt lgkmcnt(" #n ")" ::: "memory")
#define PG8_BAR __builtin_amdgcn_s_barrier()
#define PG8_SCHED __builtin_amdgcn_sched_barrier(0)
    Unit cur, nxt; int ui = 0;
    if (!S.next(0, cur)) return;
    f32x4 acc[2][2][4][2];
#pragma unroll
    for (int a = 0; a < 2; ++a)
#pragma unroll
        for (int b = 0; b < 2; ++b)
#pragma unroll
            for (int m = 0; m < 4; ++m)
#pragma unroll
                for (int n = 0; n < 2; ++n) acc[a][b][m][n] = (f32x4){0.f, 0.f, 0.f, 0.f};
    bf16x8 At[4][2], B0[2][2], B1[2][2];
    const char* cA = (const char*)g.A + (size_t)cur.am * tstep; const char* cB = (const char*)g.Bt + (size_t)cur.bn * tstep;
    if constexpr (SP2) {
        PG8_STAGE(PG8_SB(0, 0), cB, voffB); PG8_STAGE(PG8_SB(0, 1), cB + hstep, voffB); PG8_STAGE(PG8_SA(0, 0), cA, voffA); PG8_STAGE(PG8_SA(0, 1), cA + hstep, voffA);
        if (wr == 1) PG8_BAR;
        PG8_WAIT_V(2); PG8_BAR;
        PG8_STAGE(PG8_SB(1, 0), cB + kstep, voffB); PG8_STAGE(PG8_SA(1, 0), cA + kstep, voffA); PG8_STAGE(PG8_SB(1, 1), cB + hstep + kstep, voffB);
        PG8_WAIT_V(6); PG8_BAR;
    } else {
        PG8_STAGE(PG8_SB(0, 0), cB, voffB); PG8_STAGE(PG8_SA(0, 0), cA, voffA); PG8_STAGE(PG8_SB(0, 1), cB + hstep, voffB); PG8_STAGE(PG8_SA(0, 1), cA + hstep, voffA);
        if (wr == 1) PG8_BAR;
        PG8_WAIT_V(4); PG8_BAR;
        PG8_STAGE(PG8_SB(1, 0), cB + kstep, voffB); PG8_STAGE(PG8_SA(1, 0), cA + kstep, voffA); PG8_STAGE(PG8_SB(1, 1), cB + hstep + kstep, voffB);
        PG8_WAIT_V(6); PG8_BAR;
    }
    for (;;) {
        const bool has_next = S.next(ui + 1, nxt);
        const char* nA = has_next ? (const char*)g.A + (size_t)nxt.am * tstep : cA; const char* nB = has_next ? (const char*)g.Bt + (size_t)nxt.bn * tstep : cB;
#pragma nounroll
        for (int t = 0; t < nt; t += 2) {
            const bool last = (t == nt - 2);
            const char* a1 = cA + (size_t)(t + 1) * kstep;
            const char* a2 = last ? nA : cA + (size_t)(t + 2) * kstep; const char* b2 = last ? nB : cB + (size_t)(t + 2) * kstep;
            const char* a3 = a2 + kstep; const char* b3 = b2 + kstep;
            if constexpr (SP2) {
            PG8_LDB(B0, 0, 0); PG8_LDB(B1, 0, 1); PG8_SCHED; PG8_LDA(At, 0, 0); PG8_STAGE(PG8_SA(1, 1), a1 + hstep, voffA);
            PG8_WAIT_V(8); PG8_WAIT_L(0); PG8_BAR; PG8_MMA(0, 0, At, B0); PG8_MMA(0, 1, At, B1); PG8_BAR; PG8_SCHED;
            PG8_LDA(At, 0, 1); PG8_STAGE(PG8_SB(0, 0), b2, voffB); PG8_STAGE(PG8_SB(0, 1), b2 + hstep, voffB); PG8_STAGE(PG8_SA(0, 0), a2, voffA);
            PG8_WAIT_V(8); PG8_WAIT_L(0); PG8_BAR; PG8_MMA(1, 0, At, B0); PG8_MMA(1, 1, At, B1); PG8_BAR; PG8_SCHED;
            PG8_LDB(B0, 1, 0); PG8_LDB(B1, 1, 1); PG8_SCHED; PG8_LDA(At, 1, 0); PG8_STAGE(PG8_SA(0, 1), a2 + hstep, voffA);
            PG8_WAIT_V(8); PG8_WAIT_L(0); PG8_BAR; PG8_MMA(0, 0, At, B0); PG8_MMA(0, 1, At, B1); PG8_BAR; PG8_SCHED;
            PG8_LDA(At, 1, 1); PG8_STAGE(PG8_SB(1, 0), b3, voffB); PG8_STAGE(PG8_SB(1, 1), b3 + hstep, voffB); PG8_STAGE(PG8_SA(1, 0), a3, voffA);
            PG8_WAIT_V(8); PG8_WAIT_L(0); PG8_BAR; PG8_MMA(1, 0, At, B0); PG8_MMA(1, 1, At, B1); PG8_BAR; PG8_SCHED;
            } else {
            PG8_LDB(B0, 0, 0); PG8_SCHED; PG8_LDA(At, 0, 0); PG8_STAGE(PG8_SA(1, 1), a1 + hstep, voffA);
            PG8_WAIT_L(8); PG8_BAR; PG8_WAIT_L(0); PG8_MMA(0, 0, At, B0); PG8_BAR; PG8_SCHED;
            PG8_LDB(B1, 0, 1); PG8_STAGE(PG8_SB(0, 0), b2, voffB);
            PG8_BAR; PG8_WAIT_L(0); PG8_MMA(0, 1, At, B1); PG8_BAR;
            PG8_LDA(At, 0, 1); PG8_STAGE(PG8_SA(0, 0), a2, voffA);
            PG8_BAR; PG8_WAIT_L(0); PG8_MMA(1, 0, At, B0); PG8_BAR; PG8_SCHED;
            PG8_STAGE(PG8_SB(0, 1), b2 + hstep, voffB);
            PG8_WAIT_V(6); PG8_BAR; PG8_MMA(1, 1, At, B1); PG8_BAR;
            PG8_LDB(B0, 1, 0); PG8_SCHED; PG8_LDA(At, 1, 0); PG8_STAGE(PG8_SA(0, 1), a2 + hstep, voffA);
            PG8_WAIT_L(8); PG8_BAR; PG8_WAIT_L(0); PG8_MMA(0, 0, At, B0); PG8_BAR; PG8_SCHED;
            PG8_LDB(B1, 1, 1); PG8_STAGE(PG8_SB(1, 0), b3, voffB);
            PG8_BAR; PG8_WAIT_L(0); PG8_MMA(0, 1, At, B1); PG8_BAR;
            PG8_LDA(At, 1, 1); PG8_STAGE(PG8_SA(1, 0), a3, voffA);
            PG8_BAR; PG8_WAIT_L(0); PG8_MMA(1, 0, At, B0); PG8_BAR; PG8_SCHED;
            PG8_STAGE(PG8_SB(1, 1), b3 + hstep, voffB);
            PG8_WAIT_V(6); PG8_BAR; PG8_MMA(1, 1, At, B1); PG8_BAR;
            }
        }
        if constexpr (ALIGN_EPI) { if (wr == 0) PG8_BAR; }
        E(acc, cur, wr, wc, fr, fq);
        if (!has_next) break;
        if (!Epi::keep(cur)) {
#pragma unroll
        for (int a = 0; a < 2; ++a)
#pragma unroll
            for (int b = 0; b < 2; ++b)
#pragma unroll
                for (int m = 0; m < 4; ++m)
#pragma unroll
                    for (int n = 0; n < 2; ++n) acc[a][b][m][n] = (f32x4){0.f, 0.f, 0.f, 0.f};
        }
        cur = nxt; cA = nA; cB = nB; ++ui;
        if constexpr (ALIGN_EPI) { if (wr == 1) PG8_BAR; }
    }
    PG8_WAIT_V(0);
    if constexpr (!ALIGN_EPI) { if (wr == 0) PG8_BAR; }
    PG8_BAR;
#undef PG8_SA
#undef PG8_SB
#undef PG8_STAGE
#undef PG8_LDA
#undef PG8_LDB
#undef PG8_MMA
#undef PG8_WAIT_V
#undef PG8_WAIT_L
#undef PG8_BAR
#undef PG8_SCHED
}

struct SegOrder {
    StaticOrder b; int a1, a2, bN;
    __device__ void init(int M, int N, int G_, int c_, int a1_, int a2_) { b.init(M, N, G_, c_); a1 = a1_; a2 = a2_; bN = N / BM; }
    __device__ bool next(int i, Unit& u) const { if (!b.next(i / 3, u)) return false; const int s = i % 3; u.seg = s; u.am = u.pm + (s == 0 ? 0 : (s == 1 ? a1 : a2)); u.bn = u.pn + s * bN; return true; }
};

constexpr float LOG2E = 1.4426950408889634f;
__device__ __forceinline__ float sigm(float x) { return __builtin_amdgcn_rcpf(1.f + __expf(-x)); }
__device__ __forceinline__ u32x4 pack8(const f32x4 v0, const f32x4 v1) { u32x4 w; w.x = cvt_pk_bf16(v0[0], v0[1]); w.y = cvt_pk_bf16(v0[2], v0[3]); w.z = cvt_pk_bf16(v1[0], v1[1]); w.w = cvt_pk_bf16(v1[2], v1[3]); return w; }
__device__ __forceinline__ void unpack8(const u32x4 w, f32x4& v0, f32x4& v1) {
    v0[0] = __uint_as_float(w.x << 16); v0[1] = __uint_as_float(w.x & 0xffff0000u); v0[2] = __uint_as_float(w.y << 16); v0[3] = __uint_as_float(w.y & 0xffff0000u);
    v1[0] = __uint_as_float(w.z << 16); v1[1] = __uint_as_float(w.z & 0xffff0000u); v1[2] = __uint_as_float(w.w << 16); v1[3] = __uint_as_float(w.w & 0xffff0000u); }

struct EpiPlain {
    static constexpr bool PERM = true; static __device__ __forceinline__ bool keep(const Unit&) { return false; }
    bf16_t* O; int ldc; float sc;
    __device__ __forceinline__ void operator()(f32x4 (&acc)[2][2][4][2], const Unit& u, int wr, int wc, int fr, int fq) const {
        const int row0 = u.pm * BM + wr * 64 + fr, col0 = u.pn * BM + wc * 32 + 8 * fq;
#pragma unroll
        for (int ai = 0; ai < 2; ++ai)
#pragma unroll
            for (int m = 0; m < 4; ++m) { bf16_t* rowp = O + (size_t)(row0 + ai * HALF + m * 16) * ldc + col0;
#pragma unroll
                for (int bj = 0; bj < 2; ++bj) *(u32x4*)(rowp + bj * HALF) = pack8(acc[ai][bj][m][0] * sc, acc[ai][bj][m][1] * sc); }
    }
};
struct EpiSwiglu {
    static constexpr bool PERM = true; static __device__ __forceinline__ bool keep(const Unit&) { return false; }
    bf16_t* H; int ldh;
    __device__ __forceinline__ void operator()(f32x4 (&acc)[2][2][4][2], const Unit& u, int wr, int wc, int fr, int fq) const {
        const int row0 = u.pm * BM + wr * 64 + fr, col0 = u.pn * HALF + wc * 32 + 8 * fq;
#pragma unroll
        for (int ai = 0; ai < 2; ++ai)
#pragma unroll
            for (int m = 0; m < 4; ++m) {
                f32x4 v0, v1;
#pragma unroll
                for (int i = 0; i < 4; ++i) { const float a0 = acc[ai][0][m][0][i], a1 = acc[ai][0][m][1][i];
                    v0[i] = a0 * sigm(a0) * acc[ai][1][m][0][i]; v1[i] = a1 * sigm(a1) * acc[ai][1][m][1][i]; }
                *(u32x4*)(H + (size_t)(row0 + ai * HALF + m * 16) * ldh + col0) = pack8(v0, v1); }
    }
};
struct EpiRes {
    static constexpr bool PERM = false; static __device__ __forceinline__ bool keep(const Unit&) { return false; }
    const float* res; float* out; float alpha, beta;
    __device__ __forceinline__ void operator()(f32x4 (&acc)[2][2][4][2], const Unit& u, int wr, int wc, int fr, int fq) const {
        const int row0 = u.pm * BM + wr * 64 + fr, col0 = u.pn * BM + wc * 32 + 4 * fq;
#pragma unroll
        for (int ai = 0; ai < 2; ++ai)
#pragma unroll
            for (int m = 0; m < 4; ++m) { const size_t off = (size_t)(row0 + ai * HALF + m * 16) * 1024 + col0;
#pragma unroll
                for (int bj = 0; bj < 2; ++bj)
#pragma unroll
                    for (int n = 0; n < 2; ++n) { const f32x4 r = *(const f32x4*)(res + off + bj * HALF + n * 16); *(f32x4*)(out + off + bj * HALF + n * 16) = r * alpha + acc[ai][bj][m][n] * beta; } }
    }
};
struct EpiProj {
    static constexpr bool PERM = true; static __device__ __forceinline__ bool keep(const Unit&) { return false; }
    bf16_t *G, *FQ, *FK, *FV, *MQ, *CQ, *CKV; float* SIDE; const float* bgate;
    __device__ __forceinline__ void operator()(f32x4 (&acc)[2][2][4][2], const Unit& u, int wr, int wc, int fr, int fq) const {
        const int row0 = u.pm * BM + wr * 64 + fr, pn = u.pn;
#pragma unroll
        for (int bj = 0; bj < 2; ++bj) {
            const int col = pn * BM + bj * HALF + wc * 32 + 8 * fq;
            bf16_t* base; int ld, dcol; float sc = 1.f; bool gate = false;
            if (pn < 12) { base = G; ld = 3072; dcol = col; gate = true; }
            else if (pn < 14) { base = FQ; ld = 512; dcol = col - 3072; sc = 0.125f * LOG2E; }
            else if (pn < 16) { base = FK; ld = 512; dcol = col - 3584; }
            else if (pn < 18) { base = FV; ld = 512; dcol = col - 4096; }
            else if (pn < 20) { base = MQ; ld = 512; dcol = col - 4608; sc = 0.08838834764831845f * LOG2E; }
            else { const int bc = col - 5120;
                if (bc < 384) { base = CQ; ld = 384; dcol = bc; } else if (bc < 640) { base = CKV; ld = 256; dcol = bc - 384; } else { base = nullptr; ld = 0; dcol = bc; } }
            f32x4 b0 = (f32x4){0.f, 0.f, 0.f, 0.f}, b1 = b0;
            if (gate) { b0 = *(const f32x4*)(bgate + col); b1 = *(const f32x4*)(bgate + col + 4); }
            const bool side = (pn == 22) && (bj == 1) && (wc == 0 || (wc == 1 && fq == 0));
#pragma unroll
            for (int ai = 0; ai < 2; ++ai)
#pragma unroll
                for (int m = 0; m < 4; ++m) { const size_t row = (size_t)(row0 + ai * HALF + m * 16);
                    f32x4 v0 = acc[ai][bj][m][0], v1 = acc[ai][bj][m][1];
                    if (gate) {
#pragma unroll
                        for (int i = 0; i < 4; ++i) { v0[i] = sigm(v0[i] + b0[i]); v1[i] = sigm(v1[i] + b1[i]); } }
                    else { v0 = v0 * sc; v1 = v1 * sc; }
                    if (base) *(u32x4*)(base + row * ld + dcol) = pack8(v0, v1);
                    if (side) { float* sp = SIDE + row * 40 + (dcol - 640); *(f32x4*)sp = v0; *(f32x4*)(sp + 4) = v1; } }
        }
    }
};
struct EpiKvup {
    static constexpr bool PERM = true; static __device__ __forceinline__ bool keep(const Unit&) { return false; }
    bf16_t* KN; bf16_t* VM;
    __device__ __forceinline__ void operator()(f32x4 (&acc)[2][2][4][2], const Unit& u, int wr, int wc, int fr, int fq) const {
        const int row0 = u.pm * BM + wr * 64 + fr; bf16_t* base = ((wc < 2) ? KN : VM) + (2 * u.pn) * 64 + (wc & 1) * 32 + 8 * fq;
#pragma unroll
        for (int ai = 0; ai < 2; ++ai)
#pragma unroll
            for (int m = 0; m < 4; ++m) { bf16_t* rowp = base + (size_t)(row0 + ai * HALF + m * 16) * 512;
#pragma unroll
                for (int bj = 0; bj < 2; ++bj) *(u32x4*)(rowp + bj * 64) = pack8(acc[ai][bj][m][0], acc[ai][bj][m][1]); }
    }
};
struct EpiBranch {
    static constexpr bool PERM = true; static __device__ __forceinline__ bool keep(const Unit& u) { return u.seg < 2; }
    const bf16_t* G; bf16_t* MG;
    __device__ __forceinline__ void operator()(f32x4 (&acc)[2][2][4][2], const Unit& u, int wr, int wc, int fr, int fq) const {
        const int row0 = u.pm * BM + wr * 64 + fr, col0 = u.pn * BM + wc * 32 + 8 * fq, seg = u.seg;
#pragma unroll
        for (int ai = 0; ai < 2; ++ai)
#pragma unroll
            for (int m = 0; m < 4; ++m) { const size_t row = (size_t)(row0 + ai * HALF + m * 16);
#pragma unroll
                for (int bj = 0; bj < 2; ++bj) { const int col = col0 + bj * HALF;
                    f32x4 ga0, ga1; unpack8(*(const u32x4*)(G + row * 3072 + seg * 1024 + col), ga0, ga1);
                    if (seg < 2) { f32x4 gb0, gb1; unpack8(*(const u32x4*)(G + row * 3072 + (seg + 1) * 1024 + col), gb0, gb1);
#pragma unroll
                        for (int i = 0; i < 4; ++i) { acc[ai][bj][m][0][i] *= fmaxf(ga0[i], 1e-30f) * __builtin_amdgcn_rcpf(fmaxf(gb0[i], 1e-30f)); acc[ai][bj][m][1][i] *= fmaxf(ga1[i], 1e-30f) * __builtin_amdgcn_rcpf(fmaxf(gb1[i], 1e-30f)); } }
                    else { f32x4 v0, v1;
#pragma unroll
                        for (int i = 0; i < 4; ++i) { v0[i] = acc[ai][bj][m][0][i] * fmaxf(ga0[i], 1e-30f); v1[i] = acc[ai][bj][m][1][i] * fmaxf(ga1[i], 1e-30f); }
                        *(u32x4*)(MG + row * 1024 + col) = pack8(v0, v1); } } }
    }
};
}

namespace att {
using pg8::bf16_t;
typedef short bf16x8 __attribute__((ext_vector_type(8)));
typedef short s16x4 __attribute__((ext_vector_type(4)));
typedef float f32x16 __attribute__((ext_vector_type(16)));
typedef unsigned u32x4 __attribute__((ext_vector_type(4)));
typedef unsigned u32x2 __attribute__((ext_vector_type(2)));
typedef float f32x4 __attribute__((ext_vector_type(4)));
#define ATT_LAS __attribute__((address_space(3)))
struct Args {
    const bf16_t* Q; int qp;
    const bf16_t* KA; int kap;
    const bf16_t* KB; int kbp;
    const bf16_t* V; int vp;
    bf16_t* O; int op;
    const float* RC; const float* RSN;
    const float* F2; float kmax;
};
__device__ __forceinline__ unsigned cvtpk(float lo, float hi) { unsigned r; asm volatile("v_cvt_pk_bf16_f32 %0, %1, %2" : "=v"(r) : "v"(lo), "v"(hi)); return r; }
__device__ __forceinline__ s16x4 vtr(const ATT_LAS unsigned char* p) { return __builtin_bit_cast(s16x4, __builtin_amdgcn_ds_read_tr16_b64_v4i16((ATT_LAS s16x4*)p)); }

template <int DKC, int DVB, bool CAUSAL, bool ROPE, int RG, bool PRUNE>
__device__ __forceinline__ void attn_unit(const Args a, long qrow0, long krow0, int q0, int NT, ATT_LAS unsigned char* lds) {
    int tid_ = threadIdx.x; asm volatile("" : "+v"(tid_));
    const int tid = tid_, lane = tid & 63, r32 = lane & 31, hi = lane >> 5;
    const int wid = __builtin_amdgcn_readfirstlane(tid >> 6);
    constexpr int KSLOT = DKC * 2048, VSLOT = DVB * 4096, NKC = PRUNE ? 8 : 2 * DKC, KL = (NKC + 7) / 8, VL = (DVB * 4 + 7) / 8;
    ATT_LAS unsigned char* Kb = lds; ATT_LAS unsigned char* Vb = lds + 2 * KSLOT;
    const int wrow = wid * 32 * RG;
    bf16x8 qr[RG][DKC];
#pragma unroll
    for (int g = 0; g < RG; ++g) {
        const bf16_t* qrow = a.Q + (size_t)(qrow0 + wrow + g * 32 + r32) * a.qp + hi * 8;
#pragma unroll
        for (int c = 0; c < (PRUNE ? 4 : DKC); ++c) qr[g][c] = *(const bf16x8*)(qrow + c * 16);
        if constexpr (PRUNE) {
            const float f2 = a.F2[q0 + wrow + g * 32 + r32];
            const unsigned h1 = cvtpk(f2, 0.f) & 0xffffu; const float r1 = f2 - __uint_as_float(h1 << 16);
            const unsigned h2 = cvtpk(r1, 0.f) & 0xffffu; const float r2 = r1 - __uint_as_float(h2 << 16); const unsigned h3 = cvtpk(r2, 0.f) & 0xffffu;
            u32x4 w = (u32x4){0x3f803f80u, 0x3f80u | (h1 << 16), h2 | (h3 << 16), 0u};
            if (hi) w = (u32x4){0u, 0u, 0u, 0u};
            qr[g][4] = __builtin_bit_cast(bf16x8, w);
        }
        if constexpr (ROPE) {
            const size_t trow = (size_t)(qrow0 + wrow + g * 32 + r32) * 16 + 8 * hi;
            const f32x4 c0 = *(const f32x4*)(a.RC + trow), c1 = *(const f32x4*)(a.RC + trow + 4), s0 = *(const f32x4*)(a.RSN + trow), s1 = *(const f32x4*)(a.RSN + trow + 4);
            bf16x8 x1 = qr[g][4], x2 = qr[g][5];
#pragma unroll
            for (int j = 0; j < 8; ++j) { const float cc = j < 4 ? c0[j & 3] : c1[j & 3], ss = j < 4 ? s0[j & 3] : s1[j & 3];
                const float a1 = __uint_as_float((unsigned)(unsigned short)x1[j] << 16), a2 = __uint_as_float((unsigned)(unsigned short)x2[j] << 16);
                const float r1 = a1 * cc - a2 * ss, r2 = a2 * cc + a1 * ss;
                x1[j] = (short)(cvtpk(r1, 0.f) & 0xffffu); x2[j] = (short)(cvtpk(r2, 0.f) & 0xffffu); }
            qr[g][4] = x1; qr[g][5] = x2;
        }
    }
#define ATT_DMA(t, buf) do { const size_t kr_ = (size_t)(krow0 + 64 * (t)); \
    _Pragma("unroll") for (int j = 0; j < KL; ++j) { const int c8 = wid + 8 * j; if (c8 < NKC) { \
        const bf16_t* src = (c8 < 8) ? (a.KA + (kr_ + lane) * a.kap + c8 * 8) : (a.KB + (kr_ + lane) * a.kbp + (c8 - 8) * 8); \
        __builtin_amdgcn_global_load_lds((const unsigned*)src, (ATT_LAS unsigned*)(Kb + (buf) * KSLOT + c8 * 1024), 16, 0, 0); } } \
    _Pragma("unroll") for (int j = 0; j < VL; ++j) { const int pc = wid + 8 * j; if (pc < DVB * 4) { \
        __builtin_amdgcn_global_load_lds((const unsigned*)(a.V + (kr_ + 16 * (pc & 3) + (lane >> 2)) * a.vp + 32 * (pc >> 2) + (lane & 3) * 8), (ATT_LAS unsigned*)(Vb + (buf) * VSLOT + pc * 1024), 16, 0, 0); } } } while (0)
    float ub[RG]; bool gdone[RG]; bool wdone = false;
    ATT_LAS unsigned* cnt = (ATT_LAS unsigned*)(lds + 2 * KSLOT + 2 * VSLOT);
    if constexpr (PRUNE) {
#pragma unroll
        for (int g = 0; g < RG; ++g) { float nq = 0.f;
#pragma unroll
            for (int c = 0; c < 4; ++c)
#pragma unroll
                for (int j = 0; j < 8; ++j) { const float v = __uint_as_float((unsigned)(unsigned short)qr[g][c][j] << 16); nq += v * v; }
            nq += __shfl_xor(nq, 32);
            ub[g] = sqrtf(nq) * a.kmax + 2.f + a.F2[q0 + wrow + g * 32 + r32]; gdone[g] = false; }
        if (tid == 0) cnt[0] = 0u;
    }
    float fst = 0.f;
#define ATT_KBIAS(buf) do { const unsigned h1 = cvtpk(fst, 0.f) & 0xffffu; const float r1 = fst - __uint_as_float(h1 << 16); \
        const unsigned h2 = cvtpk(r1, 0.f) & 0xffffu; const float r2 = r1 - __uint_as_float(h2 << 16); const unsigned h3 = cvtpk(r2, 0.f) & 0xffffu; \
        *(ATT_LAS u32x4*)(Kb + (buf) * KSLOT + 8 * 1024 + lane * 16) = (u32x4){(h1 ^ 0x8000u) | ((h2 ^ 0x8000u) << 16), (h3 ^ 0x8000u) | 0x3f800000u, 0x3f803f80u, 0u}; } while (0)
    if constexpr (PRUNE) {
        if (wid == 0) { fst = a.F2[64 * (NT - 1) + lane]; ATT_KBIAS(0); }
        if (wid == 1) { *(ATT_LAS u32x4*)(Kb + 9 * 1024 + lane * 16) = (u32x4){0u, 0u, 0u, 0u}; *(ATT_LAS u32x4*)(Kb + KSLOT + 9 * 1024 + lane * 16) = (u32x4){0u, 0u, 0u, 0u}; }
    }
    ATT_DMA(PRUNE ? NT - 1 : 0, 0);
    asm volatile("s_waitcnt vmcnt(0)" ::: "memory");
    __syncthreads();
    f32x16 o[RG][DVB];
    float mrun[RG], lrun[RG];
#pragma unroll
    for (int g = 0; g < RG; ++g) { mrun[g] = -1e30f; lrun[g] = 0.f;
#pragma unroll
        for (int d = 0; d < DVB; ++d)
#pragma unroll
            for (int r = 0; r < 16; ++r) o[g][d][r] = 0.f; }
    const int koff = hi * 1024 + r32 * 16;
    const int voff = ((lane >> 4) & 1) * 32 + (lane & 3) * 8 + (4 * hi + ((lane & 15) >> 2)) * 64;
    const int qw0 = q0 + wrow;
    for (int it = 0; it < NT; ++it) {
        const int t = PRUNE ? NT - 1 - it : it, buf = it & 1;
        if constexpr (PRUNE) { if (tid == 0) cnt[(it + 1) % 3] = 0u; }
        if (it + 1 < NT) { ATT_DMA(PRUNE ? t - 1 : t + 1, buf ^ 1); if constexpr (PRUNE) { if (wid == 0) fst = a.F2[64 * (t - 1) + lane]; } }
        const bool active = (!CAUSAL || (64 * t <= qw0 + 32 * RG - 1)) && !(PRUNE && wdone);
        if (active) {
            f32x16 s0[RG], s1[RG];
#pragma unroll
            for (int g = 0; g < RG; ++g)
#pragma unroll
                for (int r = 0; r < 16; ++r) { s0[g][r] = 0.f; s1[g][r] = 0.f; }
            const ATT_LAS unsigned char* kp = Kb + buf * KSLOT + koff;
#pragma unroll
            for (int c = 0; c < DKC; ++c) {
                const bf16x8 k0 = *(const ATT_LAS bf16x8*)(kp + c * 2048), k1 = *(const ATT_LAS bf16x8*)(kp + c * 2048 + 512);
#pragma unroll
                for (int g = 0; g < RG; ++g) {
                    s0[g] = __builtin_amdgcn_mfma_f32_32x32x16_bf16(k0, qr[g][c], s0[g], 0, 0, 0);
                    s1[g] = __builtin_amdgcn_mfma_f32_32x32x16_bf16(k1, qr[g][c], s1[g], 0, 0, 0);
                }
            }
            u32x4 pw[RG][4];
#pragma unroll
            for (int g = 0; g < RG; ++g) {
                if (CAUSAL && (64 * t + 63 > qw0 + 32 * g)) {
                    const int kb = 64 * t + 4 * hi, qpos = qw0 + 32 * g + r32;
#pragma unroll
                    for (int r = 0; r < 16; ++r) { const int kv = kb + (r & 3) + 8 * (r >> 2); if (kv > qpos) s0[g][r] = -INFINITY; if (kv + 32 > qpos) s1[g][r] = -INFINITY; }
                }
                float rm = __builtin_fmaxf(s0[g][0], s1[g][0]);
#pragma unroll
                for (int r = 1; r < 16; ++r) rm = __builtin_fmaxf(__builtin_fmaxf(rm, s0[g][r]), s1[g][r]);
                rm = __builtin_fmaxf(rm, __shfl_xor(rm, 32));
                const float mn = __builtin_fmaxf(mrun[g], rm);
                if (__builtin_amdgcn_ballot_w64(mn > mrun[g]) != 0ull) {
                    const float alpha = __builtin_amdgcn_exp2f(mrun[g] - mn);
                    lrun[g] *= alpha;
#pragma unroll
                    for (int d = 0; d < DVB; ++d)
#pragma unroll
                        for (int r = 0; r < 16; ++r) o[g][d][r] *= alpha;
                    mrun[g] = mn;
                }
                float sum = 0.f;
#pragma unroll
                for (int r = 0; r < 16; ++r) { s0[g][r] = __builtin_amdgcn_exp2f(s0[g][r] - mn); s1[g][r] = __builtin_amdgcn_exp2f(s1[g][r] - mn); sum += s0[g][r] + s1[g][r]; }
                lrun[g] += sum;
                if constexpr (PRUNE) { if (t > 0) { const float f2e = a.F2[64 * t - 1];
                    if (__builtin_amdgcn_ballot_w64((ub[g] - f2e - mrun[g]) < -40.f) == ~0ull) gdone[g] = true; } }
#pragma unroll
                for (int i = 0; i < 4; ++i) { pw[g][0][i] = cvtpk(s0[g][2 * i], s0[g][2 * i + 1]); pw[g][1][i] = cvtpk(s0[g][8 + 2 * i], s0[g][9 + 2 * i]);
                    pw[g][2][i] = cvtpk(s1[g][2 * i], s1[g][2 * i + 1]); pw[g][3][i] = cvtpk(s1[g][8 + 2 * i], s1[g][9 + 2 * i]); }
            }
            const ATT_LAS unsigned char* vpp = Vb + buf * VSLOT + voff;
#pragma unroll
            for (int d = 0; d < DVB; ++d)
#pragma unroll
                for (int ks = 0; ks < 4; ++ks) {
                    const s16x4 lo = vtr(vpp + d * 4096 + ks * 1024), hh = vtr(vpp + d * 4096 + ks * 1024 + 512);
                    const bf16x8 vf = (bf16x8){lo[0], lo[1], lo[2], lo[3], hh[0], hh[1], hh[2], hh[3]};
#pragma unroll
                    for (int g = 0; g < RG; ++g) o[g][d] = __builtin_amdgcn_mfma_f32_32x32x16_bf16(vf, __builtin_bit_cast(bf16x8, pw[g][ks]), o[g][d], 0, 0, 0);
                }
        }
        if constexpr (PRUNE) { if (wid == 0 && it + 1 < NT) ATT_KBIAS(buf ^ 1);
            bool all = true;
#pragma unroll
            for (int g = 0; g < RG; ++g) all = all && gdone[g];
            wdone = wdone || all;
            if (wdone && lane == 0) __hip_atomic_fetch_add(cnt + (it % 3), 1u, __ATOMIC_RELAXED, __HIP_MEMORY_SCOPE_WORKGROUP); }
        asm volatile("s_waitcnt vmcnt(0) lgkmcnt(0)" ::: "memory");
        __syncthreads();
        if constexpr (PRUNE) { if (((volatile ATT_LAS unsigned*)cnt)[it % 3] == 8u) break; }
    }
    if constexpr (PRUNE) __syncthreads();
#pragma unroll
    for (int g = 0; g < RG; ++g) {
        const float lt = lrun[g] + __shfl_xor(lrun[g], 32);
        const float inv = 1.f / lt;
        bf16_t* orow = a.O + (size_t)(qrow0 + wrow + g * 32 + r32) * a.op + 4 * hi;
#pragma unroll
        for (int d = 0; d < DVB; ++d)
#pragma unroll
            for (int gg = 0; gg < 4; ++gg) { u32x2 w; w.x = cvtpk(o[g][d][4 * gg] * inv, o[g][d][4 * gg + 1] * inv); w.y = cvtpk(o[g][d][4 * gg + 2] * inv, o[g][d][4 * gg + 3] * inv);
                *(u32x2*)(orow + 32 * d + 8 * gg) = w; }
    }
#undef ATT_DMA
#undef ATT_KBIAS
}
}

using pg8::bf16_t; using pg8::f32x4; using pg8::u32x4;
#define LAS __attribute__((address_space(3)))
constexpr int NB = 4, S = 8192, T = NB * S, D = 1024, FF = 2816, NPROJ = 5888, NWAVES = 8;
constexpr float ALPHA = 1.189207115002721f;
constexpr size_t MiB = 1u << 20;
constexpr size_t WS_RS = 2 * MiB;
constexpr size_t WS_RC = 3 * MiB;
constexpr size_t WS_RSN = 5 * MiB;
constexpr size_t WS_SIDE = 7 * MiB;
constexpr size_t WS_MEMB = 12 * MiB;
constexpr size_t WS_MEMKV = 14 * MiB;
constexpr size_t WS_WIN = 16 * MiB;
constexpr size_t WS_WUQ = 28 * MiB;
constexpr size_t WS_WUKV = 29 * MiB;
constexpr size_t WS_WMKV = 30 * MiB;
constexpr size_t WS_KR = 32 * MiB;
constexpr size_t WS_XB = 34 * MiB;
constexpr size_t WS_QM = 34 * MiB;
constexpr size_t WS_WBR = 82 * MiB;
constexpr size_t WS_WOUT = 87 * MiB;
constexpr size_t WS_H = 98 * MiB;
constexpr size_t WS_G = 98 * MiB;
constexpr size_t WS_SLOT0 = 290 * MiB;
constexpr size_t WS_FQ = 338 * MiB;
constexpr size_t WS_MQ = 434 * MiB;
constexpr size_t WS_FK = 370 * MiB;
constexpr size_t WS_FV = 402 * MiB;
constexpr size_t WS_KN = 370 * MiB;
constexpr size_t WS_VM = 402 * MiB;
constexpr size_t WS_MG = 370 * MiB;
constexpr size_t WS_WA = 480 * MiB;
constexpr size_t WS_WD = 491 * MiB;
constexpr size_t WS_END = 512 * MiB;
constexpr size_t ATILE = (size_t)256 * 512 * 2;
static_assert(WS_MQ + (size_t)T * 512 * 2 <= WS_WA && WS_WD + (size_t)1024 * 2816 * 2 <= WS_END && (WS_FQ - WS_SLOT0) % ATILE == 0 && (WS_MQ - WS_SLOT0) % ATILE == 0 && WS_MG + (size_t)T * 1024 * 2 <= WS_MQ, "ws map");
constexpr int LDS_BYTES = 147456;

__device__ __forceinline__ unsigned f2bf(float f) { unsigned u = __builtin_bit_cast(unsigned, f); return (u + 0x7fffu + ((u >> 16) & 1u)) >> 16; }
__device__ __forceinline__ unsigned pk2(float lo, float hi) { return f2bf(lo) | (f2bf(hi) << 16); }
__device__ __forceinline__ float bf2f(unsigned b) { return __uint_as_float(b << 16); }
__device__ __forceinline__ float wave_sum(float v) {
#pragma unroll
    for (int o = 1; o < 64; o <<= 1) v += __shfl_xor(v, o);
    return v;
}
#define LDS_WAIT() asm volatile("s_waitcnt lgkmcnt(0)" ::: "memory")

__device__ __forceinline__ int map_ffn(int c) { return c < FF ? ((c >> 7) << 8) + (c & 127) : (((c - FF) >> 7) << 8) + 128 + ((c - FF) & 127); }
__device__ __forceinline__ int map_win(int c) {
    if (c < 384) return 5120 + c;
    if (c < 640) return 5504 + (c - 384);
    if (c < 672) return 5760 + (c - 640);
    if (c < 1184) return 3072 + (c - 672);
    if (c < 1696) return 3584 + (c - 1184);
    if (c < 2208) return 4096 + (c - 1696);
    if (c < 2216) return 5792 + (c - 2208);
    if (c < 2728) return 4608 + (c - 2216);
    return c - 2728;
}
template <int MODE>
__device__ __forceinline__ void tr_mat(const float* __restrict__ W, int K, int N, const float* __restrict__ ks, bf16_t* WT, int ldt, int kmul, LAS float* scr, int gw, int NGW, int lane) {
    const int nblk = (N + 31) / 32, items = (K / 64) * nblk;
    for (int it = gw; it < items; it += NGW) {
        const int kb = it / nblk, nb = it % nblk, k0 = 64 * kb, n0 = 32 * nb;
        const int nn = n0 + (lane & 31); const bool ok = nn < N;
#pragma unroll 8
        for (int i = 0; i < 32; ++i) { const int kk = 2 * i + (lane >> 5); float v = ok ? W[(size_t)(k0 + kk) * N + nn] : 0.f; if (ks) v *= ks[k0 + kk]; scr[kk * 33 + (lane & 31)] = v; }
        LDS_WAIT(); asm volatile("" ::: "memory");
        const int c = lane & 7, dc = kb * kmul + 8 * c;
#pragma unroll
        for (int j = 0; j < 4; ++j) { const int n = (lane >> 3) + 8 * j, sc = n0 + n;
            if (sc < N) { const LAS float* s = scr + (8 * c) * 33 + n;
                u32x4 o; o.x = pk2(s[0 * 33], s[1 * 33]); o.y = pk2(s[2 * 33], s[3 * 33]); o.z = pk2(s[4 * 33], s[5 * 33]); o.w = pk2(s[6 * 33], s[7 * 33]);
                const int dr = MODE == 1 ? map_ffn(sc) : (MODE == 2 ? map_win(sc) : sc);
                *(u32x4*)(WT + (size_t)dr * ldt + dc) = o; } }
        LDS_WAIT(); asm volatile("" ::: "memory");
    }
}
__device__ __forceinline__ void cvt_copy(const float* __restrict__ src, bf16_t* dst, size_t n, size_t gt, size_t NTH) {
    size_t i = gt * 8;
    for (; i + 3 * NTH * 8 < n; i += 4 * NTH * 8) {
        f32x4 a[4], b[4];
#pragma unroll
        for (int u = 0; u < 4; ++u) { a[u] = __builtin_nontemporal_load((const f32x4*)(src + i + u * NTH * 8)); b[u] = __builtin_nontemporal_load((const f32x4*)(src + i + u * NTH * 8 + 4)); }
#pragma unroll
        for (int u = 0; u < 4; ++u) { u32x4 o; o.x = pk2(a[u][0], a[u][1]); o.y = pk2(a[u][2], a[u][3]); o.z = pk2(b[u][0], b[u][1]); o.w = pk2(b[u][2], b[u][3]); *(u32x4*)(dst + i + u * NTH * 8) = o; }
    }
    for (; i < n; i += NTH * 8) { const f32x4 a = *(const f32x4*)(src + i), b = *(const f32x4*)(src + i + 4);
        u32x4 o; o.x = pk2(a[0], a[1]); o.y = pk2(a[2], a[3]); o.z = pk2(b[0], b[1]); o.w = pk2(b[2], b[3]); *(u32x4*)(dst + i) = o; }
}
__device__ __forceinline__ void ln_row(const float* xrow, const float* __restrict__ g, const float* __restrict__ b, float* outf, bf16_t* outb, int lane) {
    f32x4 v[4]; float s = 0.f;
#pragma unroll
    for (int j = 0; j < 4; ++j) { v[j] = *(const f32x4*)(xrow + 4 * lane + 256 * j); s += (v[j][0] + v[j][1]) + (v[j][2] + v[j][3]); }
    const float mean = wave_sum(s) * (1.f / D); float s2 = 0.f;
#pragma unroll
    for (int j = 0; j < 4; ++j) { v[j] = v[j] - mean; s2 += (v[j][0] * v[j][0] + v[j][1] * v[j][1]) + (v[j][2] * v[j][2] + v[j][3] * v[j][3]); }
    const float rstd = 1.f / sqrtf(wave_sum(s2) * (1.f / D) + 1e-5f);
#pragma unroll
    for (int j = 0; j < 4; ++j) { const f32x4 gg = *(const f32x4*)(g + 4 * lane + 256 * j), bb = *(const f32x4*)(b + 4 * lane + 256 * j);
        const f32x4 y = v[j] * rstd * gg + bb;
        if (outf) *(f32x4*)(outf + 4 * lane + 256 * j) = y;
        if (outb) { unsigned long long w = (unsigned long long)pk2(y[0], y[1]) | ((unsigned long long)pk2(y[2], y[3]) << 32); *(unsigned long long*)(outb + 4 * lane + 256 * j) = w; } }
}

#define XB_TMO      128
#define XB_XCNT(j)  (256  + 64 * (j))
#define XB_XSUB(j)  (1280 + 64 * (j))
#define XB_XGEN(j)  (2304 + 64 * (j))
#define XB_TOP      3328
#define XB_TOPGEN   3392
#define XCD_BAR_WORDS 3456
#define XB_SPIN_CAP (1u << 18)

__device__ __forceinline__ unsigned xb_ld(unsigned* p)              { return __hip_atomic_load(p, __ATOMIC_RELAXED, __HIP_MEMORY_SCOPE_AGENT); }
__device__ __forceinline__ unsigned xb_add(unsigned* p, unsigned v) { return __hip_atomic_fetch_add(p, v, __ATOMIC_RELAXED, __HIP_MEMORY_SCOPE_AGENT); }
__device__ __forceinline__ unsigned xb_xcc_id() { return (unsigned)__builtin_amdgcn_s_getreg((3 << 11) | 20) & 0xFu; }
#define XB_SPIN(cond, bar) do { unsigned _sp = 0; while (cond) { __builtin_amdgcn_s_sleep(1); \
    if ((++_sp & 255u) == 0u) { if (xb_ld(&(bar)[XB_TMO])) break; if (_sp > XB_SPIN_CAP) { atomicAdd(&(bar)[XB_TMO], 1u); break; } } } } while (0)

struct XcdBarrier {
    unsigned* bar; unsigned x;
    volatile LAS unsigned* st;
};

__device__ __forceinline__ XcdBarrier xcd_barrier_post(unsigned* bar, volatile LAS unsigned* st) {
    XcdBarrier b; b.bar = bar; b.x = xb_xcc_id(); b.st = st;
    if (threadIdx.x == 0) (void)xb_add(&bar[XB_XCNT(b.x)], 1u);
    return b;
}
__device__ __forceinline__ void xcd_barrier_complete(unsigned* bar, unsigned x, unsigned& nloc, unsigned& nx) {
    const unsigned G = gridDim.x * gridDim.y * gridDim.z;
    unsigned sum, cnt, mine, sp = 0u;
    for (;;) {
        sum = 0u; cnt = 0u; mine = 0u;
#pragma unroll
        for (unsigned j = 0; j < 16; ++j) { const unsigned c = xb_ld(&bar[XB_XCNT(j)]); sum += c; cnt += (c > 0u) ? 1u : 0u; mine = (j == x) ? c : mine; }
        if (sum == G) break;
        __builtin_amdgcn_s_sleep(1);
        if ((++sp & 255u) == 0u) { if (xb_ld(&bar[XB_TMO])) break; if (sp > XB_SPIN_CAP) { atomicAdd(&bar[XB_TMO], 1u); break; } }
    }
    nloc = mine > 0u ? mine : 1u; nx = cnt > 0u ? cnt : 1u;
}

__device__ __forceinline__ void xcd_barrier(const XcdBarrier& b) {
    asm volatile("s_waitcnt vmcnt(0)" ::: "memory");
    __syncthreads();
    if (threadIdx.x == 0) {
        unsigned* bar = b.bar;
        __builtin_amdgcn_s_waitcnt(0);
        unsigned nloc = b.st[0], nx = b.st[1];
        if (nloc == 0u) { xcd_barrier_complete(bar, b.x, nloc, nx); b.st[0] = nloc; b.st[1] = nx; }
        const unsigned old = xb_add(&bar[XB_XSUB(b.x)], 1u);
        const unsigned gen = old / nloc;
        if (old + 1u == (gen + 1u) * nloc) {
            __builtin_amdgcn_fence(__ATOMIC_RELEASE, "agent");
            asm volatile("s_waitcnt vmcnt(0)" ::: "memory");
            const unsigned og = xb_add(&bar[XB_TOP], 1u);
            const unsigned tg = og / nx;
            if (og + 1u == (tg + 1u) * nx) xb_add(&bar[XB_TOPGEN], 1u);
            else XB_SPIN(xb_ld(&bar[XB_TOPGEN]) == tg, bar);
            __builtin_amdgcn_fence(__ATOMIC_ACQUIRE, "agent");
            xb_add(&bar[XB_XGEN(b.x)], 1u);
            asm volatile("s_waitcnt vmcnt(0)" ::: "memory");
        } else {
            XB_SPIN(xb_ld(&bar[XB_XGEN(b.x)]) == gen, bar);
            __builtin_amdgcn_fence(__ATOMIC_ACQUIRE, "agent");
            asm volatile("s_waitcnt vmcnt(0)" ::: "memory");
        }
    }
    __syncthreads();
}

#ifndef PH_MASK
#define PH_MASK 0xFFFF
#endif
struct Params { const float* in[25]; float* out; unsigned char* ws; };

__global__ void __launch_bounds__(NWAVES * 64) mega_fwd(Params p) {
    extern __shared__ __attribute__((aligned(16))) unsigned char lds_raw[];
    cg::grid_group grid = cg::this_grid();
    LAS unsigned char* lds = (LAS unsigned char*)lds_raw;
    const int tid = threadIdx.x, lane = tid & 63, wave = __builtin_amdgcn_readfirstlane(tid >> 6);
    const int G = gridDim.x, bx = blockIdx.x;
    const int gw = bx * NWAVES + wave, NGW = G * NWAVES;
    const size_t gt = (size_t)bx * (NWAVES * 64) + tid, NTH = (size_t)G * (NWAVES * 64);
    unsigned char* ws = p.ws;
    const float* x = p.in[0]; const float* mem = p.in[1]; const int* positions = (const int*)p.in[2];
    float* R = p.out;
    float* KMAX = (float*)(ws + WS_RS); float* F2T = (float*)(ws + 1 * MiB); float* RC = (float*)(ws + WS_RC); float* RSN = (float*)(ws + WS_RSN); float* SIDE = (float*)(ws + WS_SIDE);
    bf16_t* MEMB = (bf16_t*)(ws + WS_MEMB); bf16_t* MEMKV = (bf16_t*)(ws + WS_MEMKV);
    bf16_t* WIN = (bf16_t*)(ws + WS_WIN); bf16_t* WUQ = (bf16_t*)(ws + WS_WUQ); bf16_t* WUKV = (bf16_t*)(ws + WS_WUKV); bf16_t* WMKV = (bf16_t*)(ws + WS_WMKV);
    bf16_t* KR = (bf16_t*)(ws + WS_KR); bf16_t* XB = (bf16_t*)(ws + WS_XB); bf16_t* QM = (bf16_t*)(ws + WS_QM); bf16_t* WBR = (bf16_t*)(ws + WS_WBR); bf16_t* WOUT = (bf16_t*)(ws + WS_WOUT);
    bf16_t* HB = (bf16_t*)(ws + WS_H); bf16_t* GB = (bf16_t*)(ws + WS_G); bf16_t* SLOT0 = (bf16_t*)(ws + WS_SLOT0); bf16_t* CQ = SLOT0; bf16_t* CKV = SLOT0 + (size_t)T * 384; bf16_t* FQ = (bf16_t*)(ws + WS_FQ); bf16_t* MQ = (bf16_t*)(ws + WS_MQ);
    bf16_t* FK = (bf16_t*)(ws + WS_FK); bf16_t* FV = (bf16_t*)(ws + WS_FV); bf16_t* KN = (bf16_t*)(ws + WS_KN); bf16_t* VM = (bf16_t*)(ws + WS_VM); bf16_t* MG = (bf16_t*)(ws + WS_MG);
    bf16_t* WA = (bf16_t*)(ws + WS_WA); bf16_t* WD = (bf16_t*)(ws + WS_WD);
    LAS float* scr = (LAS float*)(lds + wave * 16384);
    volatile LAS unsigned* MISC = (volatile LAS unsigned*)(lds + 131072 + 256);
    if (tid < 2) MISC[tid] = 0u;
    unsigned* barw = (unsigned*)ws;
    if (bx == 0) for (int i = tid; i < XCD_BAR_WORDS; i += NWAVES * 64) barw[i] = 0u;

#if (PH_MASK >> 0) & 1
    tr_mat<1>(p.in[5], D, 2 * FF, nullptr, WA, D, 64, scr, gw, NGW, lane);
    tr_mat<0>(p.in[6], FF, D, nullptr, WD, FF, 64, scr, gw, NGW, lane);
    tr_mat<2>(p.in[7], D, 5800, nullptr, WIN, D, 64, scr, gw, NGW, lane);
    tr_mat<0>(p.in[10], 384, 768, p.in[9], WUQ, 384, 64, scr, gw, NGW, lane);
    tr_mat<0>(p.in[12], 256, 1024, p.in[11], WUKV, 256, 64, scr, gw, NGW, lane);
    tr_mat<0>(p.in[14], D, 1024, nullptr, WMKV, D, 64, scr, gw, NGW, lane);
    for (size_t i = gt * 8; i < (size_t)88 * D; i += NTH * 8) *(u32x4*)(WIN + (size_t)5800 * D + i) = (u32x4){0u, 0u, 0u, 0u};
    if (gt < 32) KMAX[gt] = 0.f;
    cvt_copy(x, XB, (size_t)T * D, gt, NTH);
    cvt_copy(mem, MEMB, (size_t)NB * 256 * D, gt, NTH);
    for (size_t i = gt; i < (size_t)T * 16; i += NTH) {
        const int row = (int)(i >> 4), f = (int)(i & 15);
        const float invf = (float)exp2(-(double)f * (13.287712379549449 / 16.0));
        const float ang = (float)positions[row] * invf;
        const double rev = (double)ang * 0.15915494309189535; const float fr = (float)(rev - __builtin_rint(rev));
        RC[i] = __builtin_amdgcn_cosf(fr); RSN[i] = __builtin_amdgcn_sinf(fr);
    }
#endif
    grid.sync();
    const XcdBarrier xb = xcd_barrier_post(barw, MISC);

#if (PH_MASK >> 1) & 1
    { pg8::Gemm g{XB, WA, T, 2 * FF, D}; pg8::StaticOrder so; so.init(T, 2 * FF, G, bx);
      pg8::EpiSwiglu E{HB, FF}; pg8::gemm_phase<pg8::EpiSwiglu, pg8::StaticOrder, true>(lds, g, so, E); }
#endif
    xcd_barrier(xb);
#if (PH_MASK >> 2) & 1
    { pg8::Gemm g{HB, WD, T, D, FF}; pg8::StaticOrder so; so.init(T, D, G, bx);
      pg8::EpiRes E{x, R, ALPHA, 0.5f}; pg8::gemm_phase<pg8::EpiRes, pg8::StaticOrder, true>(lds, g, so, E); }
#endif
    xcd_barrier(xb);
#if (PH_MASK >> 3) & 1
    for (int m = gw; m < T; m += NGW) ln_row(R + (size_t)m * D, p.in[3], p.in[4], R + (size_t)m * D, XB + (size_t)m * D, lane);
#endif
    xcd_barrier(xb);
#if (PH_MASK >> 4) & 1
    { pg8::Gemm g{XB, WIN, T, NPROJ, D}; pg8::StaticOrder so; so.init(T, NPROJ, G, bx);
      pg8::EpiProj E{GB, FQ, FK, FV, MQ, CQ, CKV, SIDE, p.in[8]}; pg8::gemm_phase<pg8::EpiProj, pg8::StaticOrder, true>(lds, g, so, E); }
    { pg8::Gemm g{MEMB, WMKV, NB * 256, 1024, D}; pg8::StaticOrder so; so.init(NB * 256, 1024, G, (bx + 128) % G);
      pg8::EpiPlain E{MEMKV, 1024, 1.f}; pg8::gemm_phase<pg8::EpiPlain, pg8::StaticOrder, true>(lds, g, so, E); }
#endif
    xcd_barrier(xb);
#if (PH_MASK >> 5) & 1
    if (bx < 32) {
        const int b = bx >> 3, h = bx & 7; LAS double* sh = (LAS double*)lds;
        const float bfh = p.in[13][h]; float lf[16]; double loc = 0.0;
#pragma unroll
        for (int j = 0; j < 16; ++j) { const float xx = SIDE[((size_t)b * S + 16 * tid + j) * 40 + 32 + h] + bfh; lf[j] = fminf(xx, 0.f) - log1pf(__expf(-fabsf(xx))); loc += (double)lf[j]; }
        double incl = loc;
#pragma unroll
        for (int o = 1; o < 64; o <<= 1) { const double v = __shfl_up(incl, o); if (lane >= o) incl += v; }
        if (lane == 63) sh[wave] = incl;
        __syncthreads();
        double run = incl - loc;
        for (int w = 0; w < wave; ++w) run += sh[w];
#pragma unroll
        for (int j = 0; j < 16; ++j) { run += (double)lf[j];
            const float f2 = (float)(run * 1.4426950408889634);
            F2T[(size_t)bx * S + 16 * tid + j] = f2; }
        __syncthreads();
    }
    float kmrun = 0.f; int curb = gw >> 13;
    for (int m = gw; m < T; m += NGW) {
        { const int bb = m >> 13;
          if (bb != curb) { if ((lane & 7) == 0) atomicMax((unsigned*)KMAX + curb * 8 + (lane >> 3), __float_as_uint(kmrun)); kmrun = 0.f; curb = bb; }
          f32x4 k0, k1; pg8::unpack8(*(const u32x4*)(FK + (size_t)m * 512 + lane * 8), k0, k1); float ks = 0.f;
#pragma unroll
          for (int i = 0; i < 4; ++i) ks += k0[i] * k0[i] + k1[i] * k1[i];
          ks += __shfl_xor(ks, 1); ks += __shfl_xor(ks, 2); ks += __shfl_xor(ks, 4);
          kmrun = fmaxf(kmrun, ks); }
        f32x4 a0, a1, c0, c1; float sq = 0.f, sq2 = 0.f;
        if (lane < 48) { pg8::unpack8(*(const u32x4*)(CQ + (size_t)m * 384 + lane * 8), a0, a1);
#pragma unroll
            for (int i = 0; i < 4; ++i) sq += a0[i] * a0[i] + a1[i] * a1[i]; }
        if (lane < 32) { pg8::unpack8(*(const u32x4*)(CKV + (size_t)m * 256 + lane * 8), c0, c1);
#pragma unroll
            for (int i = 0; i < 4; ++i) sq2 += c0[i] * c0[i] + c1[i] * c1[i]; }
        const float rq = 1.f / sqrtf(wave_sum(sq) * (1.f / 384.f) + 1e-6f), rkv = 1.f / sqrtf(wave_sum(sq2) * (1.f / 256.f) + 1e-6f);
        if (lane < 48) *(u32x4*)(CQ + (size_t)m * 384 + lane * 8) = pg8::pack8(a0 * rq, a1 * rq);
        if (lane < 32) *(u32x4*)(CKV + (size_t)m * 256 + lane * 8) = pg8::pack8(c0 * rkv, c1 * rkv);
        if (lane < 16) { const float x1 = SIDE[(size_t)m * 40 + lane], x2 = SIDE[(size_t)m * 40 + 16 + lane], c = RC[(size_t)m * 16 + lane], s = RSN[(size_t)m * 16 + lane];
            KR[(size_t)m * 32 + lane] = (bf16_t)f2bf(x1 * c - x2 * s); KR[(size_t)m * 32 + 16 + lane] = (bf16_t)f2bf(x2 * c + x1 * s); }
    }
    if ((lane & 7) == 0) atomicMax((unsigned*)KMAX + curb * 8 + (lane >> 3), __float_as_uint(kmrun));
    tr_mat<0>(p.in[15], 512, D, nullptr, WBR, 512, 64, scr, gw, NGW, lane);
    tr_mat<0>(p.in[16], 512, D, nullptr, WBR + (size_t)1024 * 512, 512, 64, scr, gw, NGW, lane);
    tr_mat<0>(p.in[17], 512, D, nullptr, WBR + (size_t)2048 * 512, 512, 64, scr, gw, NGW, lane);
    tr_mat<0>(p.in[18], D, D, nullptr, WOUT, D, 64, scr, gw, NGW, lane);
    __syncthreads();
    for (int u = bx; u < NB * 4 * 32; u += G) {
        const int b = u >> 7, hm = (u >> 5) & 3, qb = u & 31;
        att::Args a{MQ + hm * 128, 512, MEMKV + hm * 128, 1024, MEMKV + hm * 128 + 64, 1024, MEMKV + 512 + hm * 128, 1024, MQ + hm * 128, 512, nullptr, nullptr, nullptr, 0.f};
        att::attn_unit<8, 4, false, false, 1, false>(a, (long)b * S + qb * 256, (long)b * 256, 0, 4, lds);
    }
#endif
    xcd_barrier(xb);
#if (PH_MASK >> 6) & 1
    for (int u = bx; u < 512; u += G) {
        const int v = u & 255, i = u >> 8, vcu = (v & 7) * 32 + (v >> 3), bh = vcu >> 3, s = vcu & 7;
        const int qb = (i == 0) ? s : 15 - s; const int b = bh >> 3, h = bh & 7;
        att::Args a{FQ + h * 64, 512, FK + h * 64, 512, nullptr, 0, FV + h * 64, 512, FQ + h * 64, 512, nullptr, nullptr, F2T + (size_t)bh * S, sqrtf(KMAX[bh]) * 1.001f};
        att::attn_unit<5, 2, true, false, 2, true>(a, (long)b * S + qb * 512, (long)b * S, qb * 512, 8 * (qb + 1), lds);
    }
#endif
    xcd_barrier(xb);
#if (PH_MASK >> 7) & 1
    { pg8::Gemm g{CQ, WUQ, T, 768, 384}; pg8::StaticOrder so; so.init(T, 768, G, bx);
      pg8::EpiPlain E{QM, 768, 0.10206207261596577f * pg8::LOG2E}; pg8::gemm_phase<pg8::EpiPlain, pg8::StaticOrder, true>(lds, g, so, E); }
    { pg8::Gemm g{CKV, WUKV, T, 1024, 256}; pg8::StaticOrder so; so.init(T, 1024, G, bx);
      pg8::EpiKvup E{KN, VM}; pg8::gemm_phase<pg8::EpiKvup, pg8::StaticOrder, true>(lds, g, so, E); }
#endif
    xcd_barrier(xb);
#if (PH_MASK >> 8) & 1
    for (int u = bx; u < 512; u += G) {
        const int v = u & 255, i = u >> 8, vcu = (v & 7) * 32 + (v >> 3), bh = vcu >> 3, s = vcu & 7;
        const int qb = (i == 0) ? s : 15 - s; const int b = bh >> 3, h = bh & 7;
        att::Args a{QM + h * 96, 768, KN + h * 64, 512, KR, 32, VM + h * 64, 512, SLOT0 + h * 64, 512, RC, RSN, nullptr, 0.f};
        att::attn_unit<6, 2, true, true, 2, false>(a, (long)b * S + qb * 512, (long)b * S, qb * 512, 8 * (qb + 1), lds);
    }
#endif
    xcd_barrier(xb);
#if (PH_MASK >> 9) & 1
    { pg8::Gemm g{SLOT0, WBR, T, D, 512}; pg8::SegOrder so; so.init(T, D, G, bx, (int)((WS_FQ - WS_SLOT0) / ATILE), (int)((WS_MQ - WS_SLOT0) / ATILE));
      pg8::EpiBranch E{GB, MG}; pg8::gemm_phase<pg8::EpiBranch, pg8::SegOrder, true>(lds, g, so, E); }
#endif
    xcd_barrier(xb);
#if (PH_MASK >> 10) & 1
    { pg8::Gemm g{MG, WOUT, T, D, D}; pg8::StaticOrder so; so.init(T, D, G, bx);
      pg8::EpiRes E{R, R, ALPHA, 1.f}; pg8::gemm_phase<pg8::EpiRes, pg8::StaticOrder, true>(lds, g, so, E); }
#endif
    xcd_barrier(xb);
#if (PH_MASK >> 11) & 1
    for (int m = gw; m < T; m += NGW) ln_row(R + (size_t)m * D, p.in[19], p.in[20], R + (size_t)m * D, XB + (size_t)m * D, lane);
    tr_mat<1>(p.in[21], D, 2 * FF, nullptr, WA, D, 64, scr, gw, NGW, lane);
    tr_mat<0>(p.in[22], FF, D, nullptr, WD, FF, 64, scr, gw, NGW, lane);
#endif
    xcd_barrier(xb);
#if (PH_MASK >> 12) & 1
    { pg8::Gemm g{XB, WA, T, 2 * FF, D}; pg8::StaticOrder so; so.init(T, 2 * FF, G, bx);
      pg8::EpiSwiglu E{HB, FF}; pg8::gemm_phase<pg8::EpiSwiglu, pg8::StaticOrder, true>(lds, g, so, E); }
#endif
    xcd_barrier(xb);
#if (PH_MASK >> 13) & 1
    { pg8::Gemm g{HB, WD, T, D, FF}; pg8::StaticOrder so; so.init(T, D, G, bx);
      pg8::EpiRes E{R, R, ALPHA, 0.5f}; pg8::gemm_phase<pg8::EpiRes, pg8::StaticOrder, true>(lds, g, so, E); }
#endif
    xcd_barrier(xb);
#if (PH_MASK >> 14) & 1
    for (int m = gw; m < T; m += NGW) ln_row(R + (size_t)m * D, p.in[23], p.in[24], R + (size_t)m * D, nullptr, lane);
#endif
}

extern "C" void kernel_launch(void* const* d_in, const int* in_sizes, int n_in, void* d_out, int out_size, void* d_ws, size_t ws_size, hipStream_t stream) {
    static int grid = 0;
    if (grid == 0) {
        if (n_in != 25 || out_size != T * D || ws_size < WS_END) { fprintf(stderr, "kernel_launch: unexpected shapes (n_in %d out %d ws %zu)\n", n_in, out_size, ws_size); grid = -1; return; }
        int dev = 0, cus = 0, per = 0;
        (void)hipGetDevice(&dev); (void)hipDeviceGetAttribute(&cus, hipDeviceAttributeMultiprocessorCount, dev);
        (void)hipFuncSetAttribute((const void*)mega_fwd, hipFuncAttributeMaxDynamicSharedMemorySize, LDS_BYTES);
        (void)hipOccupancyMaxActiveBlocksPerMultiprocessor(&per, (const void*)mega_fwd, NWAVES * 64, LDS_BYTES);
        if (per < 1) per = 1;
        grid = cus * per;
        fprintf(stderr, "kernel_launch: grid %d (cus %d x %d), ws %zu\n", grid, cus, per, ws_size);
    }
    if (grid < 0) return;
    Params p{};
    for (int i = 0; i < 25; ++i) p.in[i] = (const float*)d_in[i];
    p.out = (float*)d_out; p.ws = (unsigned char*)d_ws;
    void* args[] = {&p};
    const hipError_t e = hipLaunchCooperativeKernel((const void*)mega_fwd, dim3(grid), dim3(NWAVES * 64), args, LDS_BYTES, stream);
    if (e != hipSuccess) fprintf(stderr, "kernel_launch: cooperative launch failed: %s (grid %d)\n", hipGetErrorString(e), grid);
}
```

```cpp
#include <hip/hip_runtime.h>
#include <hip/hip_cooperative_groups.h>
#include <cstdio>
#include <cstdint>
#include <cmath>
namespace cg = cooperative_groups;
namespace pg8 {
#define PG8_LAS __attribute__((address_space(3)))
typedef unsigned short bf16_t;
typedef short bf16x8 __attribute__((ext_vector_type(8)));
typedef float f32x4 __attribute__((ext_vector_type(4)));
typedef unsigned u32x4 __attribute__((ext_vector_type(4)));
constexpr int BM = 256, BK = 64, HALF = 128, HTB = HALF * BK * 2  , STAGE_BYTES = 8 * HTB, NXCD = 8, WGM = 8;

__host__ __device__ __forceinline__ int lds_byte(int r, int c) { const int st = (r >> 4) * 2 + (c >> 5), rr = r & 15, cc = c & 31, ob = rr * 64 + cc * 2; return st * 1024 + (ob ^ (((ob >> 9) & 1) << 5)); }
__host__ __device__ __forceinline__ void stage_rc(int b, int& R, int& C) { const int st = b / 1024, sb = b % 1024, swz = sb ^ (((sb >> 9) & 1) << 5); R = (st >> 1) * 16 + swz / 64; C = (st & 1) * 32 + (swz % 64) / 2; }
__host__ __device__ __forceinline__ int perm32(int rho) { const int n = rho >> 4, i = rho & 15; return 8 * (i >> 2) + 4 * n + (i & 3); }

struct Unit { int pm, pn, am, bn, seg; };
struct Gemm { const bf16_t* A; const bf16_t* Bt; int M, N, K; };

struct StaticOrder {
    int nM, nN, nwg, G, c;
    __host__ __device__ void init(int M, int N, int G_, int c_) { nM = M / BM; nN = N / BM; nwg = nM * nN; G = G_; c = c_; }
    __host__ __device__ bool next(int i, Unit& u) const {
        const long L = (long)i * G + c; if (L >= nwg) return false;
        int wgid = (int)L; { const int q = nwg / NXCD, r = nwg % NXCD, xcd = wgid % NXCD, off = wgid / NXCD; wgid = (xcd < r ? xcd * (q + 1) : r * (q + 1) + (xcd - r) * q) + off; }
        const int nig = WGM * nN, gid = wgid / nig, fm = gid * WGM, gsz = (nM - fm) < WGM ? (nM - fm) : WGM;
        u.pm = fm + ((wgid % nig) % gsz); u.pn = (wgid % nig) / gsz; u.am = u.pm; u.bn = u.pn; u.seg = 0; return true;
    }
};

__device__ __forceinline__ unsigned cvt_pk_bf16(float lo, float hi) { unsigned r; asm volatile("v_cvt_pk_bf16_f32 %0, %1, %2" : "=v"(r) : "v"(lo), "v"(hi)); return r; }
typedef float f32x2 __attribute__((ext_vector_type(2)));
template <class Epi, class Sched, bool ALIGN_EPI = false, bool SP2 = true>
__device__ __forceinline__ void gemm_phase(PG8_LAS unsigned char* lds, const Gemm g, const Sched& S, const Epi& E) {
    int tid_ = threadIdx.x; asm volatile("" : "+v"(tid_));
    const int tid = tid_, wid = __builtin_amdgcn_readfirstlane(tid >> 6), lane = tid & 63, wr = wid >> 2, wc = wid & 3, fr = lane & 15, fq = lane >> 4;
    const int K = g.K, nt = K / BK;
    unsigned voffA[2], voffB[2];
#pragma unroll
    for (int i = 0; i < 2; ++i) { int R, C; stage_rc(tid * 16 + i * 8192, R, C); const int Rb = Epi::PERM ? ((R & ~31) + perm32(R & 31)) : R;
        voffA[i] = (unsigned)(R * K + C) * 2u; voffB[i] = (unsigned)(Rb * K + C) * 2u; }
    const size_t kstep = (size_t)(BK * 2);
    const size_t hstep = (size_t)HALF * K * 2;
    const size_t tstep = 2 * hstep;
    const unsigned ldsw = (unsigned)wid * 1024u;
    const int aoff = lds_byte(wr * 64 + fr, fq * 8), boff = lds_byte(wc * 32 + fr, fq * 8);
#define PG8_SA(b, h) (((b) * 2 + (h)) * HTB)
#define PG8_SB(b, h) ((4 + (b) * 2 + (h)) * HTB)
#define PG8_STAGE(bufoff, gbase, voff) do { _Pragma("unroll") for (int _i = 0; _i < 2; ++_i) \
        __builtin_amdgcn_global_load_lds((const unsigned*)((const char*)(gbase) + (voff)[_i]), (PG8_LAS unsigned*)(lds + (bufoff) + ldsw + _i * 8192), 16, 0, 0); } while (0)
#define PG8_LDA(dst, b, h) do { _Pragma("unroll") for (int m = 0; m < 4; ++m) _Pragma("unroll") for (int k = 0; k < 2; ++k) dst[m][k] = *(const PG8_LAS bf16x8*)(lds + PG8_SA(b, h) + aoff + m * 2048 + k * 1024); } while (0)
#define PG8_LDB(dst, b, h) do { _Pragma("unroll") for (int n = 0; n < 2; ++n) _Pragma("unroll") for (int k = 0; k < 2; ++k) dst[n][k] = *(const PG8_LAS bf16x8*)(lds + PG8_SB(b, h) + boff + n * 2048 + k * 1024); } while (0)
#define PG8_MMA(ai, bj, At, Bt) do { __builtin_amdgcn_s_setprio(1); _Pragma("unroll") for (int m = 0; m < 4; ++m) _Pragma("unroll") for (int n = 0; n < 2; ++n) _Pragma("unroll") for (int k = 0; k < 2; ++k) \
        acc[ai][bj][m][n] = __builtin_amdgcn_mfma_f32_16x16x32_bf16(Bt[n][k], At[m][k], acc[ai][bj][m][n], 0, 0, 0); __builtin_amdgcn_s_setprio(0); } while (0)
#define PG8_WAIT_V(n) asm volatile("s_waitcnt vmcnt(" #n ")" ::: "memory")
#define PG8_WAIT_L(n) asm volatile("s_waitcnt lgkmcnt(" #n ")" ::: "memory")
#define PG8_BAR __builtin_amdgcn_s_barrier()
#define PG8_SCHED __builtin_amdgcn_sched_barrier(0)
    Unit cur, nxt; int ui = 0;
    if (!S.next(0, cur)) return;
    f32x4 acc[2][2][4][2];
#pragma unroll
    for (int a = 0; a < 2; ++a)
#pragma unroll
        for (int b = 0; b < 2; ++b)
#pragma unroll
            for (int m = 0; m < 4; ++m)
#pragma unroll
                for (int n = 0; n < 2; ++n) acc[a][b][m][n] = (f32x4){0.f, 0.f, 0.f, 0.f};
    bf16x8 At[4][2], B0[2][2], B1[2][2];
    const char* cA = (const char*)g.A + (size_t)cur.am * tstep; const char* cB = (const char*)g.Bt + (size_t)cur.bn * tstep;
    if constexpr (SP2) {
        PG8_STAGE(PG8_SB(0, 0), cB, voffB); PG8_STAGE(PG8_SB(0, 1), cB + hstep, voffB); PG8_STAGE(PG8_SA(0, 0), cA, voffA); PG8_STAGE(PG8_SA(0, 1), cA + hstep, voffA);
        if (wr == 1) PG8_BAR;
        PG8_WAIT_V(2); PG8_BAR;
        PG8_STAGE(PG8_SB(1, 0), cB + kstep, voffB); PG8_STAGE(PG8_SA(1, 0), cA + kstep, voffA); PG8_STAGE(PG8_SB(1, 1), cB + hstep + kstep, voffB);
        PG8_WAIT_V(6); PG8_BAR;
    } else {
        PG8_STAGE(PG8_SB(0, 0), cB, voffB); PG8_STAGE(PG8_SA(0, 0), cA, voffA); PG8_STAGE(PG8_SB(0, 1), cB + hstep, voffB); PG8_STAGE(PG8_SA(0, 1), cA + hstep, voffA);
        if (wr == 1) PG8_BAR;
        PG8_WAIT_V(4); PG8_BAR;
        PG8_STAGE(PG8_SB(1, 0), cB + kstep, voffB); PG8_STAGE(PG8_SA(1, 0), cA + kstep, voffA); PG8_STAGE(PG8_SB(1, 1), cB + hstep + kstep, voffB);
        PG8_WAIT_V(6); PG8_BAR;
    }
    for (;;) {
        const bool has_next = S.next(ui + 1, nxt);
        const char* nA = has_next ? (const char*)g.A + (size_t)nxt.am * tstep : cA; const char* nB = has_next ? (const char*)g.Bt + (size_t)nxt.bn * tstep : cB;
#pragma nounroll
        for (int t = 0; t < nt; t += 2) {
            const bool last = (t == nt - 2);
            const char* a1 = cA + (size_t)(t + 1) * kstep;
            const char* a2 = last ? nA : cA + (size_t)(t + 2) * kstep; const char* b2 = last ? nB : cB + (size_t)(t + 2) * kstep;
            const char* a3 = a2 + kstep; const char* b3 = b2 + kstep;
            if constexpr (SP2) {
            PG8_LDB(B0, 0, 0); PG8_LDB(B1, 0, 1); PG8_SCHED; PG8_LDA(At, 0, 0); PG8_STAGE(PG8_SA(1, 1), a1 + hstep, voffA);
            PG8_WAIT_V(8); PG8_WAIT_L(0); PG8_BAR; PG8_MMA(0, 0, At, B0); PG8_MMA(0, 1, At, B1); PG8_BAR; PG8_SCHED;
            PG8_LDA(At, 0, 1); PG8_STAGE(PG8_SB(0, 0), b2, voffB); PG8_STAGE(PG8_SB(0, 1), b2 + hstep, voffB); PG8_STAGE(PG8_SA(0, 0), a2, voffA);
            PG8_WAIT_V(8); PG8_WAIT_L(0); PG8_BAR; PG8_MMA(1, 0, At, B0); PG8_MMA(1, 1, At, B1); PG8_BAR; PG8_SCHED;
            PG8_LDB(B0, 1, 0); PG8_LDB(B1, 1, 1); PG8_SCHED; PG8_LDA(At, 1, 0); PG8_STAGE(PG8_SA(0, 1), a2 + hstep, voffA);
            PG8_WAIT_V(8); PG8_WAIT_L(0); PG8_BAR; PG8_MMA(0, 0, At, B0); PG8_MMA(0, 1, At, B1); PG8_BAR; PG8_SCHED;
            PG8_LDA(At, 1, 1); PG8_STAGE(PG8_SB(1, 0), b3, voffB); PG8_STAGE(PG8_SB(1, 1), b3 + hstep, voffB); PG8_STAGE(PG8_SA(1, 0), a3, voffA);
            PG8_WAIT_V(8); PG8_WAIT_L(0); PG8_BAR; PG8_MMA(1, 0, At, B0); PG8_MMA(1, 1, At, B1); PG8_BAR; PG8_SCHED;
            } else {
            PG8_LDB(B0, 0, 0); PG8_SCHED; PG8_LDA(At, 0, 0); PG8_STAGE(PG8_SA(1, 1), a1 + hstep, voffA);
            PG8_WAIT_L(8); PG8_BAR; PG8_WAIT_L(0); PG8_MMA(0, 0, At, B0); PG8_BAR; PG8_SCHED;
            PG8_LDB(B1, 0, 1); PG8_STAGE(PG8_SB(0, 0), b2, voffB);
            PG8_BAR; PG8_WAIT_L(0); PG8_MMA(0, 1, At, B1); PG8_BAR;
            PG8_LDA(At, 0, 1); PG8_STAGE(PG8_SA(0, 0), a2, voffA);
            PG8_BAR; PG8_WAIT_L(0); PG8_MMA(1, 0, At, B0); PG8_BAR; PG8_SCHED;
            PG8_STAGE(PG8_SB(0, 1), b2 + hstep, voffB);
            PG8_WAIT_V(6); PG8_BAR; PG8_MMA(1, 1, At, B1); PG8_BAR;
            PG8_LDB(B0, 1, 0); PG8_SCHED; PG8_LDA(At, 1, 0); PG8_STAGE(PG8_SA(0, 1), a2 + hstep, voffA);
            PG8_WAIT_L(8); PG8_BAR; PG8_WAIT_L(0); PG8_MMA(0, 0, At, B0); PG8_BAR; PG8_SCHED;
            PG8_LDB(B1, 1, 1); PG8_STAGE(PG8_SB(1, 0), b3, voffB);
            PG8_BAR; PG8_WAIT_L(0); PG8_MMA(0, 1, At, B1); PG8_BAR;
            PG8_LDA(At, 1, 1); PG8_STAGE(PG8_SA(1, 0), a3, voffA);
            PG8_BAR; PG8_WAIT_L(0); PG8_MMA(1, 0, At, B0); PG8_BAR; PG8_SCHED;
            PG8_STAGE(PG8_SB(1, 1), b3 + hstep, voffB);
            PG8_WAIT_V(6); PG8_BAR; PG8_MMA(1, 1, At, B1); PG8_BAR;
            }
        }
        if constexpr (ALIGN_EPI) { if (wr == 0) PG8_BAR; }
        E(acc, cur, wr, wc, fr, fq);
        if (!has_next) break;
        if (!Epi::keep(cur)) {
#pragma unroll
        for (int a = 0; a < 2; ++a)
#pragma unroll
            for (int b = 0; b < 2; ++b)
#pragma unroll
                for (int m = 0; m < 4; ++m)
#pragma unroll
                    for (int n = 0; n < 2; ++n) acc[a][b][m][n] = (f32x4){0.f, 0.f, 0.f, 0.f};
        }
        cur = nxt; cA = nA; cB = nB; ++ui;
        if constexpr (ALIGN_EPI) { if (wr == 1) PG8_BAR; }
    }
    PG8_WAIT_V(0);
    if constexpr (!ALIGN_EPI) { if (wr == 0) PG8_BAR; }
    PG8_BAR;
#undef PG8_SA
#undef PG8_SB
#undef PG8_STAGE
#undef PG8_LDA
#undef PG8_LDB
#undef PG8_MMA
#undef PG8_WAIT_V
#undef PG8_WAIT_L
#undef PG8_BAR
#undef PG8_SCHED
}

struct SegOrder {
    StaticOrder b; int a1, a2, bN;
    __device__ void init(int M, int N, int G_, int c_, int a1_, int a2_) { b.init(M, N, G_, c_); a1 = a1_; a2 = a2_; bN = N / BM; }
    __device__ bool next(int i, Unit& u) const { if (!b.next(i / 3, u)) return false; const int s = i % 3; u.seg = s; u.am = u.pm + (s == 0 ? 0 : (s == 1 ? a1 : a2)); u.bn = u.pn + s * bN; return true; }
};

constexpr float LOG2E = 1.4426950408889634f;
__device__ __forceinline__ float sigm(float x) { return __builtin_amdgcn_rcpf(1.f + __expf(-x)); }
__device__ __forceinline__ u32x4 pack8(const f32x4 v0, const f32x4 v1) { u32x4 w; w.x = cvt_pk_bf16(v0[0], v0[1]); w.y = cvt_pk_bf16(v0[2], v0[3]); w.z = cvt_pk_bf16(v1[0], v1[1]); w.w = cvt_pk_bf16(v1[2], v1[3]); return w; }
__device__ __forceinline__ void unpack8(const u32x4 w, f32x4& v0, f32x4& v1) {
    v0[0] = __uint_as_float(w.x << 16); v0[1] = __uint_as_float(w.x & 0xffff0000u); v0[2] = __uint_as_float(w.y << 16); v0[3] = __uint_as_float(w.y & 0xffff0000u);
    v1[0] = __uint_as_float(w.z << 16); v1[1] = __uint_as_float(w.z & 0xffff0000u); v1[2] = __uint_as_float(w.w << 16); v1[3] = __uint_as_float(w.w & 0xffff0000u); }

struct EpiPlain {
    static constexpr bool PERM = true; static __device__ __forceinline__ bool keep(const Unit&) { return false; }
    bf16_t* O; int ldc; float sc;
    __device__ __forceinline__ void operator()(f32x4 (&acc)[2][2][4][2], const Unit& u, int wr, int wc, int fr, int fq) const {
        const int row0 = u.pm * BM + wr * 64 + fr, col0 = u.pn * BM + wc * 32 + 8 * fq;
#pragma unroll
        for (int ai = 0; ai < 2; ++ai)
#pragma unroll
            for (int m = 0; m < 4; ++m) { bf16_t* rowp = O + (size_t)(row0 + ai * HALF + m * 16) * ldc + col0;
#pragma unroll
                for (int bj = 0; bj < 2; ++bj) *(u32x4*)(rowp + bj * HALF) = pack8(acc[ai][bj][m][0] * sc, acc[ai][bj][m][1] * sc); }
    }
};
struct EpiSwiglu {
    static constexpr bool PERM = true; static __device__ __forceinline__ bool keep(const Unit&) { return false; }
    bf16_t* H; int ldh;
    __device__ __forceinline__ void operator()(f32x4 (&acc)[2][2][4][2], const Unit& u, int wr, int wc, int fr, int fq) const {
        const int row0 = u.pm * BM + wr * 64 + fr, col0 = u.pn * HALF + wc * 32 + 8 * fq;
#pragma unroll
        for (int ai = 0; ai < 2; ++ai)
#pragma unroll
            for (int m = 0; m < 4; ++m) {
                f32x4 v0, v1;
#pragma unroll
                for (int i = 0; i < 4; ++i) { const float a0 = acc[ai][0][m][0][i], a1 = acc[ai][0][m][1][i];
                    v0[i] = a0 * sigm(a0) * acc[ai][1][m][0][i]; v1[i] = a1 * sigm(a1) * acc[ai][1][m][1][i]; }
                *(u32x4*)(H + (size_t)(row0 + ai * HALF + m * 16) * ldh + col0) = pack8(v0, v1); }
    }
};
struct EpiRes {
    static constexpr bool PERM = false; static __device__ __forceinline__ bool keep(const Unit&) { return false; }
    const float* res; float* out; float alpha, beta;
    __device__ __forceinline__ void operator()(f32x4 (&acc)[2][2][4][2], const Unit& u, int wr, int wc, int fr, int fq) const {
        const int row0 = u.pm * BM + wr * 64 + fr, col0 = u.pn * BM + wc * 32 + 4 * fq;
#pragma unroll
        for (int ai = 0; ai < 2; ++ai)
#pragma unroll
            for (int m = 0; m < 4; ++m) { const size_t off = (size_t)(row0 + ai * HALF + m * 16) * 1024 + col0;
#pragma unroll
                for (int bj = 0; bj < 2; ++bj)
#pragma unroll
                    for (int n = 0; n < 2; ++n) { const f32x4 r = *(const f32x4*)(res + off + bj * HALF + n * 16); *(f32x4*)(out + off + bj * HALF + n * 16) = r * alpha + acc[ai][bj][m][n] * beta; } }
    }
};
struct EpiProj {
    static constexpr bool PERM = true; static __device__ __forceinline__ bool keep(const Unit&) { return false; }
    bf16_t *G, *FQ, *FK, *FV, *MQ, *CQ, *CKV; float* SIDE; const float* bgate;
    __device__ __forceinline__ void operator()(f32x4 (&acc)[2][2][4][2], const Unit& u, int wr, int wc, int fr, int fq) const {
        const int row0 = u.pm * BM + wr * 64 + fr, pn = u.pn;
#pragma unroll
        for (int bj = 0; bj < 2; ++bj) {
            const int col = pn * BM + bj * HALF + wc * 32 + 8 * fq;
            bf16_t* base; int ld, dcol; float sc = 1.f; bool gate = false;
            if (pn < 12) { base = G; ld = 3072; dcol = col; gate = true; }
            else if (pn < 14) { base = FQ; ld = 512; dcol = col - 3072; sc = 0.125f * LOG2E; }
            else if (pn < 16) { base = FK; ld = 512; dcol = col - 3584; }
            else if (pn < 18) { base = FV; ld = 512; dcol = col - 4096; }
            else if (pn < 20) { base = MQ; ld = 512; dcol = col - 4608; sc = 0.08838834764831845f * LOG2E; }
            else { const int bc = col - 5120;
                if (bc < 384) { base = CQ; ld = 384; dcol = bc; } else if (bc < 640) { base = CKV; ld = 256; dcol = bc - 384; } else { base = nullptr; ld = 0; dcol = bc; } }
            f32x4 b0 = (f32x4){0.f, 0.f, 0.f, 0.f}, b1 = b0;
            if (gate) { b0 = *(const f32x4*)(bgate + col); b1 = *(const f32x4*)(bgate + col + 4); }
            const bool side = (pn == 22) && (bj == 1) && (wc == 0 || (wc == 1 && fq == 0));
#pragma unroll
            for (int ai = 0; ai < 2; ++ai)
#pragma unroll
                for (int m = 0; m < 4; ++m) { const size_t row = (size_t)(row0 + ai * HALF + m * 16);
                    f32x4 v0 = acc[ai][bj][m][0], v1 = acc[ai][bj][m][1];
                    if (gate) {
#pragma unroll
                        for (int i = 0; i < 4; ++i) { v0[i] = sigm(v0[i] + b0[i]); v1[i] = sigm(v1[i] + b1[i]); } }
                    else { v0 = v0 * sc; v1 = v1 * sc; }
                    if (base) *(u32x4*)(base + row * ld + dcol) = pack8(v0, v1);
                    if (side) { float* sp = SIDE + row * 40 + (dcol - 640); *(f32x4*)sp = v0; *(f32x4*)(sp + 4) = v1; } }
        }
    }
};
struct EpiKvup {
    static constexpr bool PERM = true; static __device__ __forceinline__ bool keep(const Unit&) { return false; }
    bf16_t* KN; bf16_t* VM;
    __device__ __forceinline__ void operator()(f32x4 (&acc)[2][2][4][2], const Unit& u, int wr, int wc, int fr, int fq) const {
        const int row0 = u.pm * BM + wr * 64 + fr; bf16_t* base = ((wc < 2) ? KN : VM) + (2 * u.pn) * 64 + (wc & 1) * 32 + 8 * fq;
#pragma unroll
        for (int ai = 0; ai < 2; ++ai)
#pragma unroll
            for (int m = 0; m < 4; ++m) { bf16_t* rowp = base + (size_t)(row0 + ai * HALF + m * 16) * 512;
#pragma unroll
                for (int bj = 0; bj < 2; ++bj) *(u32x4*)(rowp + bj * 64) = pack8(acc[ai][bj][m][0], acc[ai][bj][m][1]); }
    }
};
struct EpiBranch {
    static constexpr bool PERM = true; static __device__ __forceinline__ bool keep(const Unit& u) { return u.seg < 2; }
    const bf16_t* G; bf16_t* MG;
    __device__ __forceinline__ void operator()(f32x4 (&acc)[2][2][4][2], const Unit& u, int wr, int wc, int fr, int fq) const {
        const int row0 = u.pm * BM + wr * 64 + fr, col0 = u.pn * BM + wc * 32 + 8 * fq, seg = u.seg;
#pragma unroll
        for (int ai = 0; ai < 2; ++ai)
#pragma unroll
            for (int m = 0; m < 4; ++m) { const size_t row = (size_t)(row0 + ai * HALF + m * 16);
#pragma unroll
                for (int bj = 0; bj < 2; ++bj) { const int col = col0 + bj * HALF;
                    f32x4 ga0, ga1; unpack8(*(const u32x4*)(G + row * 3072 + seg * 1024 + col), ga0, ga1);
                    if (seg < 2) { f32x4 gb0, gb1; unpack8(*(const u32x4*)(G + row * 3072 + (seg + 1) * 1024 + col), gb0, gb1);
#pragma unroll
                        for (int i = 0; i < 4; ++i) { acc[ai][bj][m][0][i] *= fmaxf(ga0[i], 1e-30f) * __builtin_amdgcn_rcpf(fmaxf(gb0[i], 1e-30f)); acc[ai][bj][m][1][i] *= fmaxf(ga1[i], 1e-30f) * __builtin_amdgcn_rcpf(fmaxf(gb1[i], 1e-30f)); } }
                    else { f32x4 v0, v1;
#pragma unroll
                        for (int i = 0; i < 4; ++i) { v0[i] = acc[ai][bj][m][0][i] * fmaxf(ga0[i], 1e-30f); v1[i] = acc[ai][bj][m][1][i] * fmaxf(ga1[i], 1e-30f); }
                        *(u32x4*)(MG + row * 1024 + col) = pack8(v0, v1); } } }
    }
};
}

namespace att {
using pg8::bf16_t;
typedef short bf16x8 __attribute__((ext_vector_type(8)));
typedef short s16x4 __attribute__((ext_vector_type(4)));
typedef float f32x16 __attribute__((ext_vector_type(16)));
typedef unsigned u32x4 __attribute__((ext_vector_type(4)));
typedef unsigned u32x2 __attribute__((ext_vector_type(2)));
typedef float f32x4 __attribute__((ext_vector_type(4)));
#define ATT_LAS __attribute__((address_space(3)))
struct Args {
    const bf16_t* Q; int qp;
    const bf16_t* KA; int kap;
    const bf16_t* KB; int kbp;
    const bf16_t* V; int vp;
    bf16_t* O; int op;
    const float* RC; const float* RSN;
    const float* F2; float kmax;
};
__device__ __forceinline__ unsigned cvtpk(float lo, float hi) { unsigned r; asm volatile("v_cvt_pk_bf16_f32 %0, %1, %2" : "=v"(r) : "v"(lo), "v"(hi)); return r; }
__device__ __forceinline__ s16x4 vtr(const ATT_LAS unsigned char* p) { return __builtin_bit_cast(s16x4, __builtin_amdgcn_ds_read_tr16_b64_v4i16((ATT_LAS s16x4*)p)); }

template <int DKC, int DVB, bool CAUSAL, bool ROPE, int RG, bool PRUNE>
__device__ __forceinline__ void attn_unit(const Args a, long qrow0, long krow0, int q0, int NT, ATT_LAS unsigned char* lds) {
    int tid_ = threadIdx.x; asm volatile("" : "+v"(tid_));
    const int tid = tid_, lane = tid & 63, r32 = lane & 31, hi = lane >> 5;
    const int wid = __builtin_amdgcn_readfirstlane(tid >> 6);
    constexpr int KSLOT = DKC * 2048, VSLOT = DVB * 4096, NKC = PRUNE ? 8 : 2 * DKC, KL = (NKC + 7) / 8, VL = (DVB * 4 + 7) / 8;
    ATT_LAS unsigned char* Kb = lds; ATT_LAS unsigned char* Vb = lds + 2 * KSLOT;
    const int wrow = wid * 32 * RG;
    bf16x8 qr[RG][DKC];
#pragma unroll
    for (int g = 0; g < RG; ++g) {
        const bf16_t* qrow = a.Q + (size_t)(qrow0 + wrow + g * 32 + r32) * a.qp + hi * 8;
#pragma unroll
        for (int c = 0; c < (PRUNE ? 4 : DKC); ++c) qr[g][c] = *(const bf16x8*)(qrow + c * 16);
        if constexpr (PRUNE) {
            const float f2 = a.F2[q0 + wrow + g * 32 + r32];
            const unsigned h1 = cvtpk(f2, 0.f) & 0xffffu; const float r1 = f2 - __uint_as_float(h1 << 16);
            const unsigned h2 = cvtpk(r1, 0.f) & 0xffffu; const float r2 = r1 - __uint_as_float(h2 << 16); const unsigned h3 = cvtpk(r2, 0.f) & 0xffffu;
            u32x4 w = (u32x4){0x3f803f80u, 0x3f80u | (h1 << 16), h2 | (h3 << 16), 0u};
            if (hi) w = (u32x4){0u, 0u, 0u, 0u};
            qr[g][4] = __builtin_bit_cast(bf16x8, w);
        }
        if constexpr (ROPE) {
            const size_t trow = (size_t)(qrow0 + wrow + g * 32 + r32) * 16 + 8 * hi;
            const f32x4 c0 = *(const f32x4*)(a.RC + trow), c1 = *(const f32x4*)(a.RC + trow + 4), s0 = *(const f32x4*)(a.RSN + trow), s1 = *(const f32x4*)(a.RSN + trow + 4);
            bf16x8 x1 = qr[g][4], x2 = qr[g][5];
#pragma unroll
            for (int j = 0; j < 8; ++j) { const float cc = j < 4 ? c0[j & 3] : c1[j & 3], ss = j < 4 ? s0[j & 3] : s1[j & 3];
                const float a1 = __uint_as_float((unsigned)(unsigned short)x1[j] << 16), a2 = __uint_as_float((unsigned)(unsigned short)x2[j] << 16);
                const float r1 = a1 * cc - a2 * ss, r2 = a2 * cc + a1 * ss;
                x1[j] = (short)(cvtpk(r1, 0.f) & 0xffffu); x2[j] = (short)(cvtpk(r2, 0.f) & 0xffffu); }
            qr[g][4] = x1; qr[g][5] = x2;
        }
    }
#define ATT_DMA(t, buf) do { const size_t kr_ = (size_t)(krow0 + 64 * (t)); \
    _Pragma("unroll") for (int j = 0; j < KL; ++j) { const int c8 = wid + 8 * j; if (c8 < NKC) { \
        const bf16_t* src = (c8 < 8) ? (a.KA + (kr_ + lane) * a.kap + c8 * 8) : (a.KB + (kr_ + lane) * a.kbp + (c8 - 8) * 8); \
        __builtin_amdgcn_global_load_lds((const unsigned*)src, (ATT_LAS unsigned*)(Kb + (buf) * KSLOT + c8 * 1024), 16, 0, 0); } } \
    _Pragma("unroll") for (int j = 0; j < VL; ++j) { const int pc = wid + 8 * j; if (pc < DVB * 4) { \
        __builtin_amdgcn_global_load_lds((const unsigned*)(a.V + (kr_ + 16 * (pc & 3) + (lane >> 2)) * a.vp + 32 * (pc >> 2) + (lane & 3) * 8), (ATT_LAS unsigned*)(Vb + (buf) * VSLOT + pc * 1024), 16, 0, 0); } } } while (0)
    float ub[RG]; bool gdone[RG]; bool wdone = false;
    ATT_LAS unsigned* cnt = (ATT_LAS unsigned*)(lds + 2 * KSLOT + 2 * VSLOT);
    if constexpr (PRUNE) {
#pragma unroll
        for (int g = 0; g < RG; ++g) { float nq = 0.f;
#pragma unroll
            for (int c = 0; c < 4; ++c)
#pragma unroll
                for (int j = 0; j < 8; ++j) { const float v = __uint_as_float((unsigned)(unsigned short)qr[g][c][j] << 16); nq += v * v; }
            nq += __shfl_xor(nq, 32);
            ub[g] = sqrtf(nq) * a.kmax + 2.f + a.F2[q0 + wrow + g * 32 + r32]; gdone[g] = false; }
        if (tid == 0) cnt[0] = 0u;
    }
    float fst = 0.f;
#define ATT_KBIAS(buf) do { const unsigned h1 = cvtpk(fst, 0.f) & 0xffffu; const float r1 = fst - __uint_as_float(h1 << 16); \
        const unsigned h2 = cvtpk(r1, 0.f) & 0xffffu; const float r2 = r1 - __uint_as_float(h2 << 16); const unsigned h3 = cvtpk(r2, 0.f) & 0xffffu; \
        *(ATT_LAS u32x4*)(Kb + (buf) * KSLOT + 8 * 1024 + lane * 16) = (u32x4){(h1 ^ 0x8000u) | ((h2 ^ 0x8000u) << 16), (h3 ^ 0x8000u) | 0x3f800000u, 0x3f803f80u, 0u}; } while (0)
    if constexpr (PRUNE) {
        if (wid == 0) { fst = a.F2[64 * (NT - 1) + lane]; ATT_KBIAS(0); }
        if (wid == 1) { *(ATT_LAS u32x4*)(Kb + 9 * 1024 + lane * 16) = (u32x4){0u, 0u, 0u, 0u}; *(ATT_LAS u32x4*)(Kb + KSLOT + 9 * 1024 + lane * 16) = (u32x4){0u, 0u, 0u, 0u}; }
    }
    ATT_DMA(PRUNE ? NT - 1 : 0, 0);
    asm volatile("s_waitcnt vmcnt(0)" ::: "memory");
    __syncthreads();
    f32x16 o[RG][DVB];
    float mrun[RG], lrun[RG];
#pragma unroll
    for (int g = 0; g < RG; ++g) { mrun[g] = -1e30f; lrun[g] = 0.f;
#pragma unroll
        for (int d = 0; d < DVB; ++d)
#pragma unroll
            for (int r = 0; r < 16; ++r) o[g][d][r] = 0.f; }
    const int koff = hi * 1024 + r32 * 16;
    const int voff = ((lane >> 4) & 1) * 32 + (lane & 3) * 8 + (4 * hi + ((lane & 15) >> 2)) * 64;
    const int qw0 = q0 + wrow;
    for (int it = 0; it < NT; ++it) {
        const int t = PRUNE ? NT - 1 - it : it, buf = it & 1;
        if constexpr (PRUNE) { if (tid == 0) cnt[(it + 1) % 3] = 0u; }
        if (it + 1 < NT) { ATT_DMA(PRUNE ? t - 1 : t + 1, buf ^ 1); if constexpr (PRUNE) { if (wid == 0) fst = a.F2[64 * (t - 1) + lane]; } }
        const bool active = (!CAUSAL || (64 * t <= qw0 + 32 * RG - 1)) && !(PRUNE && wdone);
        if (active) {
            f32x16 s0[RG], s1[RG];
#pragma unroll
            for (int g = 0; g < RG; ++g)
#pragma unroll
                for (int r = 0; r < 16; ++r) { s0[g][r] = 0.f; s1[g][r] = 0.f; }
            const ATT_LAS unsigned char* kp = Kb + buf * KSLOT + koff;
#pragma unroll
            for (int c = 0; c < DKC; ++c) {
                const bf16x8 k0 = *(const ATT_LAS bf16x8*)(kp + c * 2048), k1 = *(const ATT_LAS bf16x8*)(kp + c * 2048 + 512);
#pragma unroll
                for (int g = 0; g < RG; ++g) {
                    s0[g] = __builtin_amdgcn_mfma_f32_32x32x16_bf16(k0, qr[g][c], s0[g], 0, 0, 0);
                    s1[g] = __builtin_amdgcn_mfma_f32_32x32x16_bf16(k1, qr[g][c], s1[g], 0, 0, 0);
                }
            }
            u32x4 pw[RG][4];
#pragma unroll
            for (int g = 0; g < RG; ++g) {
                if (CAUSAL && (64 * t + 63 > qw0 + 32 * g)) {
                    const int kb = 64 * t + 4 * hi, qpos = qw0 + 32 * g + r32;
#pragma unroll
                    for (int r = 0; r < 16; ++r) { const int kv = kb + (r & 3) + 8 * (r >> 2); if (kv > qpos) s0[g][r] = -INFINITY; if (kv + 32 > qpos) s1[g][r] = -INFINITY; }
                }
                float rm = __builtin_fmaxf(s0[g][0], s1[g][0]);
#pragma unroll
                for (int r = 1; r < 16; ++r) rm = __builtin_fmaxf(__builtin_fmaxf(rm, s0[g][r]), s1[g][r]);
                rm = __builtin_fmaxf(rm, __shfl_xor(rm, 32));
                const float mn = __builtin_fmaxf(mrun[g], rm);
                if (__builtin_amdgcn_ballot_w64(mn > mrun[g]) != 0ull) {
                    const float alpha = __builtin_amdgcn_exp2f(mrun[g] - mn);
                    lrun[g] *= alpha;
#pragma unroll
                    for (int d = 0; d < DVB; ++d)
#pragma unroll
                        for (int r = 0; r < 16; ++r) o[g][d][r] *= alpha;
                    mrun[g] = mn;
                }
                float sum = 0.f;
#pragma unroll
                for (int r = 0; r < 16; ++r) { s0[g][r] = __builtin_amdgcn_exp2f(s0[g][r] - mn); s1[g][r] = __builtin_amdgcn_exp2f(s1[g][r] - mn); sum += s0[g][r] + s1[g][r]; }
                lrun[g] += sum;
                if constexpr (PRUNE) { if (t > 0) { const float f2e = a.F2[64 * t - 1];
                    if (__builtin_amdgcn_ballot_w64((ub[g] - f2e - mrun[g]) < -40.f) == ~0ull) gdone[g] = true; } }
#pragma unroll
                for (int i = 0; i < 4; ++i) { pw[g][0][i] = cvtpk(s0[g][2 * i], s0[g][2 * i + 1]); pw[g][1][i] = cvtpk(s0[g][8 + 2 * i], s0[g][9 + 2 * i]);
                    pw[g][2][i] = cvtpk(s1[g][2 * i], s1[g][2 * i + 1]); pw[g][3][i] = cvtpk(s1[g][8 + 2 * i], s1[g][9 + 2 * i]); }
            }
            const ATT_LAS unsigned char* vpp = Vb + buf * VSLOT + voff;
#pragma unroll
            for (int d = 0; d < DVB; ++d)
#pragma unroll
                for (int ks = 0; ks < 4; ++ks) {
                    const s16x4 lo = vtr(vpp + d * 4096 + ks * 1024), hh = vtr(vpp + d * 4096 + ks * 1024 + 512);
                    const bf16x8 vf = (bf16x8){lo[0], lo[1], lo[2], lo[3], hh[0], hh[1], hh[2], hh[3]};
#pragma unroll
                    for (int g = 0; g < RG; ++g) o[g][d] = __builtin_amdgcn_mfma_f32_32x32x16_bf16(vf, __builtin_bit_cast(bf16x8, pw[g][ks]), o[g][d], 0, 0, 0);
                }
        }
        if constexpr (PRUNE) { if (wid == 0 && it + 1 < NT) ATT_KBIAS(buf ^ 1);
            bool all = true;
#pragma unroll
            for (int g = 0; g < RG; ++g) all = all && gdone[g];
            wdone = wdone || all;
            if (wdone && lane == 0) __hip_atomic_fetch_add(cnt + (it % 3), 1u, __ATOMIC_RELAXED, __HIP_MEMORY_SCOPE_WORKGROUP); }
        asm volatile("s_waitcnt vmcnt(0) lgkmcnt(0)" ::: "memory");
        __syncthreads();
        if constexpr (PRUNE) { if (((volatile ATT_LAS unsigned*)cnt)[it % 3] == 8u) break; }
    }
    if constexpr (PRUNE) __syncthreads();
#pragma unroll
    for (int g = 0; g < RG; ++g) {
        const float lt = lrun[g] + __shfl_xor(lrun[g], 32);
        const float inv = 1.f / lt;
        bf16_t* orow = a.O + (size_t)(qrow0 + wrow + g * 32 + r32) * a.op + 4 * hi;
#pragma unroll
        for (int d = 0; d < DVB; ++d)
#pragma unroll
            for (int gg = 0; gg < 4; ++gg) { u32x2 w; w.x = cvtpk(o[g][d][4 * gg] * inv, o[g][d][4 * gg + 1] * inv); w.y = cvtpk(o[g][d][4 * gg + 2] * inv, o[g][d][4 * gg + 3] * inv);
                *(u32x2*)(orow + 32 * d + 8 * gg) = w; }
    }
#undef ATT_DMA
#undef ATT_KBIAS
}
}

using pg8::bf16_t; using pg8::f32x4; using pg8::u32x4;
#define LAS __attribute__((address_space(3)))
constexpr int NB = 4, S = 8192, T = NB * S, D = 1024, FF = 2816, NPROJ = 5888, NWAVES = 8;
constexpr float ALPHA = 1.189207115002721f;
constexpr size_t MiB = 1u << 20;
constexpr size_t WS_RS = 2 * MiB;
constexpr size_t WS_RC = 3 * MiB;
constexpr size_t WS_RSN = 5 * MiB;
constexpr size_t WS_SIDE = 7 * MiB;
constexpr size_t WS_MEMB = 12 * MiB;
constexpr size_t WS_MEMKV = 14 * MiB;
constexpr size_t WS_WIN = 16 * MiB;
constexpr size_t WS_WUQ = 28 * MiB;
constexpr size_t WS_WUKV = 29 * MiB;
constexpr size_t WS_WMKV = 30 * MiB;
constexpr size_t WS_KR = 32 * MiB;
constexpr size_t WS_XB = 34 * MiB;
constexpr size_t WS_QM = 34 * MiB;
constexpr size_t WS_WBR = 82 * MiB;
constexpr size_t WS_WOUT = 87 * MiB;
constexpr size_t WS_H = 98 * MiB;
constexpr size_t WS_G = 98 * MiB;
constexpr size_t WS_SLOT0 = 290 * MiB;
constexpr size_t WS_FQ = 338 * MiB;
constexpr size_t WS_MQ = 434 * MiB;
constexpr size_t WS_FK = 370 * MiB;
constexpr size_t WS_FV = 402 * MiB;
constexpr size_t WS_KN = 370 * MiB;
constexpr size_t WS_VM = 402 * MiB;
constexpr size_t WS_MG = 370 * MiB;
constexpr size_t WS_WA = 480 * MiB;
constexpr size_t WS_WD = 491 * MiB;
constexpr size_t WS_END = 512 * MiB;
constexpr size_t ATILE = (size_t)256 * 512 * 2;
static_assert(WS_MQ + (size_t)T * 512 * 2 <= WS_WA && WS_WD + (size_t)1024 * 2816 * 2 <= WS_END && (WS_FQ - WS_SLOT0) % ATILE == 0 && (WS_MQ - WS_SLOT0) % ATILE == 0 && WS_MG + (size_t)T * 1024 * 2 <= WS_MQ, "ws map");
constexpr int LDS_BYTES = 147456;

__device__ __forceinline__ unsigned f2bf(float f) { unsigned u = __builtin_bit_cast(unsigned, f); return (u + 0x7fffu + ((u >> 16) & 1u)) >> 16; }
__device__ __forceinline__ unsigned pk2(float lo, float hi) { return f2bf(lo) | (f2bf(hi) << 16); }
__device__ __forceinline__ float bf2f(unsigned b) { return __uint_as_float(b << 16); }
__device__ __forceinline__ float wave_sum(float v) {
#pragma unroll
    for (int o = 1; o < 64; o <<= 1) v += __shfl_xor(v, o);
    return v;
}
#define LDS_WAIT() asm volatile("s_waitcnt lgkmcnt(0)" ::: "memory")

__device__ __forceinline__ int map_ffn(int c) { return c < FF ? ((c >> 7) << 8) + (c & 127) : (((c - FF) >> 7) << 8) + 128 + ((c - FF) & 127); }
__device__ __forceinline__ int map_win(int c) {
    if (c < 384) return 5120 + c;
    if (c < 640) return 5504 + (c - 384);
    if (c < 672) return 5760 + (c - 640);
    if (c < 1184) return 3072 + (c - 672);
    if (c < 1696) return 3584 + (c - 1184);
    if (c < 2208) return 4096 + (c - 1696);
    if (c < 2216) return 5792 + (c - 2208);
    if (c < 2728) return 4608 + (c - 2216);
    return c - 2728;
}
template <int MODE>
__device__ __forceinline__ void tr_mat(const float* __restrict__ W, int K, int N, const float* __restrict__ ks, bf16_t* WT, int ldt, int kmul, LAS float* scr, int gw, int NGW, int lane) {
    const int nblk = (N + 31) / 32, items = (K / 64) * nblk;
    for (int it = gw; it < items; it += NGW) {
        const int kb = it / nblk, nb = it % nblk, k0 = 64 * kb, n0 = 32 * nb;
        const int r8 = lane >> 3, c4 = (lane & 7) * 4; const bool ok = n0 + c4 < N;
        f32x4 v[8];
#pragma unroll
        for (int i = 0; i < 8; ++i) v[i] = ok ? __builtin_nontemporal_load((const f32x4*)(W + (size_t)(k0 + 8 * i + r8) * N + n0 + c4)) : (f32x4){0.f, 0.f, 0.f, 0.f};
#pragma unroll
        for (int i = 0; i < 8; ++i) { const int kk = 8 * i + r8; if (ks) v[i] = v[i] * ks[k0 + kk];
            scr[kk * 33 + c4] = v[i][0]; scr[kk * 33 + c4 + 1] = v[i][1]; scr[kk * 33 + c4 + 2] = v[i][2]; scr[kk * 33 + c4 + 3] = v[i][3]; }
        LDS_WAIT(); asm volatile("" ::: "memory");
        const int c = lane & 7, dc = kb * kmul + 8 * c;
#pragma unroll
        for (int j = 0; j < 4; ++j) { const int n = (lane >> 3) + 8 * j, sc = n0 + n;
            if (sc < N) { const LAS float* s = scr + (8 * c) * 33 + n;
                u32x4 o; o.x = pk2(s[0 * 33], s[1 * 33]); o.y = pk2(s[2 * 33], s[3 * 33]); o.z = pk2(s[4 * 33], s[5 * 33]); o.w = pk2(s[6 * 33], s[7 * 33]);
                const int dr = MODE == 1 ? map_ffn(sc) : (MODE == 2 ? map_win(sc) : sc);
                *(u32x4*)(WT + (size_t)dr * ldt + dc) = o; } }
        LDS_WAIT(); asm volatile("" ::: "memory");
    }
}
__device__ __forceinline__ void cvt_copy(const float* __restrict__ src, bf16_t* dst, size_t n, size_t gt, size_t NTH) {
    size_t i = gt * 8;
    for (; i + 3 * NTH * 8 < n; i += 4 * NTH * 8) {
        f32x4 a[4], b[4];
#pragma unroll
        for (int u = 0; u < 4; ++u) { a[u] = __builtin_nontemporal_load((const f32x4*)(src + i + u * NTH * 8)); b[u] = __builtin_nontemporal_load((const f32x4*)(src + i + u * NTH * 8 + 4)); }
#pragma unroll
        for (int u = 0; u < 4; ++u) { u32x4 o; o.x = pk2(a[u][0], a[u][1]); o.y = pk2(a[u][2], a[u][3]); o.z = pk2(b[u][0], b[u][1]); o.w = pk2(b[u][2], b[u][3]); *(u32x4*)(dst + i + u * NTH * 8) = o; }
    }
    for (; i < n; i += NTH * 8) { const f32x4 a = *(const f32x4*)(src + i), b = *(const f32x4*)(src + i + 4);
        u32x4 o; o.x = pk2(a[0], a[1]); o.y = pk2(a[2], a[3]); o.z = pk2(b[0], b[1]); o.w = pk2(b[2], b[3]); *(u32x4*)(dst + i) = o; }
}
__device__ __forceinline__ void ln_row(const float* xrow, const float* __restrict__ g, const float* __restrict__ b, float* outf, bf16_t* outb, int lane) {
    f32x4 v[4]; float s = 0.f;
#pragma unroll
    for (int j = 0; j < 4; ++j) { v[j] = *(const f32x4*)(xrow + 4 * lane + 256 * j); s += (v[j][0] + v[j][1]) + (v[j][2] + v[j][3]); }
    const float mean = wave_sum(s) * (1.f / D); float s2 = 0.f;
#pragma unroll
    for (int j = 0; j < 4; ++j) { v[j] = v[j] - mean; s2 += (v[j][0] * v[j][0] + v[j][1] * v[j][1]) + (v[j][2] * v[j][2] + v[j][3] * v[j][3]); }
    const float rstd = 1.f / sqrtf(wave_sum(s2) * (1.f / D) + 1e-5f);
#pragma unroll
    for (int j = 0; j < 4; ++j) { const f32x4 gg = *(const f32x4*)(g + 4 * lane + 256 * j), bb = *(const f32x4*)(b + 4 * lane + 256 * j);
        const f32x4 y = v[j] * rstd * gg + bb;
        if (outf) *(f32x4*)(outf + 4 * lane + 256 * j) = y;
        if (outb) { unsigned long long w = (unsigned long long)pk2(y[0], y[1]) | ((unsigned long long)pk2(y[2], y[3]) << 32); *(unsigned long long*)(outb + 4 * lane + 256 * j) = w; } }
}

#define XB_TMO      128
#define XB_XCNT(j)  (256  + 64 * (j))
#define XB_XSUB(j)  (1280 + 64 * (j))
#define XB_XGEN(j)  (2304 + 64 * (j))
#define XB_TOP      3328
#define XB_TOPGEN   3392
#define XCD_BAR_WORDS 3456
#define XB_SPIN_CAP (1u << 18)

__device__ __forceinline__ unsigned xb_ld(unsigned* p)              { return __hip_atomic_load(p, __ATOMIC_RELAXED, __HIP_MEMORY_SCOPE_AGENT); }
__device__ __forceinline__ unsigned xb_add(unsigned* p, unsigned v) { return __hip_atomic_fetch_add(p, v, __ATOMIC_RELAXED, __HIP_MEMORY_SCOPE_AGENT); }
__device__ __forceinline__ unsigned xb_xcc_id() { return (unsigned)__builtin_amdgcn_s_getreg((3 << 11) | 20) & 0xFu; }
#define XB_SPIN(cond, bar) do { unsigned _sp = 0; while (cond) { __builtin_amdgcn_s_sleep(1); \
    if ((++_sp & 255u) == 0u) { if (xb_ld(&(bar)[XB_TMO])) break; if (_sp > XB_SPIN_CAP) { atomicAdd(&(bar)[XB_TMO], 1u); break; } } } } while (0)

struct XcdBarrier {
    unsigned* bar; unsigned x;
    volatile LAS unsigned* st;
};

__device__ __forceinline__ XcdBarrier xcd_barrier_post(unsigned* bar, volatile LAS unsigned* st) {
    XcdBarrier b; b.bar = bar; b.x = xb_xcc_id(); b.st = st;
    if (threadIdx.x == 0) (void)xb_add(&bar[XB_XCNT(b.x)], 1u);
    return b;
}
__device__ __forceinline__ void xcd_barrier_complete(unsigned* bar, unsigned x, unsigned& nloc, unsigned& nx) {
    const unsigned G = gridDim.x * gridDim.y * gridDim.z;
    unsigned sum, cnt, mine, sp = 0u;
    for (;;) {
        sum = 0u; cnt = 0u; mine = 0u;
#pragma unroll
        for (unsigned j = 0; j < 16; ++j) { const unsigned c = xb_ld(&bar[XB_XCNT(j)]); sum += c; cnt += (c > 0u) ? 1u : 0u; mine = (j == x) ? c : mine; }
        if (sum == G) break;
        __builtin_amdgcn_s_sleep(1);
        if ((++sp & 255u) == 0u) { if (xb_ld(&bar[XB_TMO])) break; if (sp > XB_SPIN_CAP) { atomicAdd(&bar[XB_TMO], 1u); break; } }
    }
    nloc = mine > 0u ? mine : 1u; nx = cnt > 0u ? cnt : 1u;
}

__device__ __forceinline__ void xcd_barrier(const XcdBarrier& b) {
    asm volatile("s_waitcnt vmcnt(0)" ::: "memory");
    __syncthreads();
    if (threadIdx.x == 0) {
        unsigned* bar = b.bar;
        __builtin_amdgcn_s_waitcnt(0);
        unsigned nloc = b.st[0], nx = b.st[1];
        if (nloc == 0u) { xcd_barrier_complete(bar, b.x, nloc, nx); b.st[0] = nloc; b.st[1] = nx; }
        const unsigned old = xb_add(&bar[XB_XSUB(b.x)], 1u);
        const unsigned gen = old / nloc;
        if (old + 1u == (gen + 1u) * nloc) {
            __builtin_amdgcn_fence(__ATOMIC_RELEASE, "agent");
            asm volatile("s_waitcnt vmcnt(0)" ::: "memory");
            const unsigned og = xb_add(&bar[XB_TOP], 1u);
            const unsigned tg = og / nx;
            if (og + 1u == (tg + 1u) * nx) xb_add(&bar[XB_TOPGEN], 1u);
            else XB_SPIN(xb_ld(&bar[XB_TOPGEN]) == tg, bar);
            __builtin_amdgcn_fence(__ATOMIC_ACQUIRE, "agent");
            xb_add(&bar[XB_XGEN(b.x)], 1u);
            asm volatile("s_waitcnt vmcnt(0)" ::: "memory");
        } else {
            XB_SPIN(xb_ld(&bar[XB_XGEN(b.x)]) == gen, bar);
            __builtin_amdgcn_fence(__ATOMIC_ACQUIRE, "agent");
            asm volatile("s_waitcnt vmcnt(0)" ::: "memory");
        }
    }
    __syncthreads();
}

#ifndef PH_MASK
#define PH_MASK 0xFFFF
#endif
struct Params { const float* in[25]; float* out; unsigned char* ws; };

__global__ void __launch_bounds__(NWAVES * 64) mega_fwd(Params p) {
    extern __shared__ __attribute__((aligned(16))) unsigned char lds_raw[];
    cg::grid_group grid = cg::this_grid();
    LAS unsigned char* lds = (LAS unsigned char*)lds_raw;
    const int wave = __builtin_amdgcn_readfirstlane((int)threadIdx.x >> 6);
#define PHASE_IDS() int tid_o = threadIdx.x; asm volatile("" : "+v"(tid_o)); const int tid = tid_o, lane = tid & 63; const size_t gt = (size_t)bx * (NWAVES * 64) + tid; (void)lane; (void)gt
    const int G = gridDim.x, bx = blockIdx.x;
    const int gw = bx * NWAVES + wave, NGW = G * NWAVES;
    const size_t NTH = (size_t)G * (NWAVES * 64);
    unsigned char* ws = p.ws;
    const float* x = p.in[0]; const float* mem = p.in[1]; const int* positions = (const int*)p.in[2];
    float* R = p.out;
    float* KMAX = (float*)(ws + WS_RS); float* F2T = (float*)(ws + 1 * MiB); float* RC = (float*)(ws + WS_RC); float* RSN = (float*)(ws + WS_RSN); float* SIDE = (float*)(ws + WS_SIDE);
    bf16_t* MEMB = (bf16_t*)(ws + WS_MEMB); bf16_t* MEMKV = (bf16_t*)(ws + WS_MEMKV);
    bf16_t* WIN = (bf16_t*)(ws + WS_WIN); bf16_t* WUQ = (bf16_t*)(ws + WS_WUQ); bf16_t* WUKV = (bf16_t*)(ws + WS_WUKV); bf16_t* WMKV = (bf16_t*)(ws + WS_WMKV);
    bf16_t* KR = (bf16_t*)(ws + WS_KR); bf16_t* XB = (bf16_t*)(ws + WS_XB); bf16_t* QM = (bf16_t*)(ws + WS_QM); bf16_t* WBR = (bf16_t*)(ws + WS_WBR); bf16_t* WOUT = (bf16_t*)(ws + WS_WOUT);
    bf16_t* HB = (bf16_t*)(ws + WS_H); bf16_t* GB = (bf16_t*)(ws + WS_G); bf16_t* SLOT0 = (bf16_t*)(ws + WS_SLOT0); bf16_t* CQ = SLOT0; bf16_t* CKV = SLOT0 + (size_t)T * 384; bf16_t* FQ = (bf16_t*)(ws + WS_FQ); bf16_t* MQ = (bf16_t*)(ws + WS_MQ);
    bf16_t* FK = (bf16_t*)(ws + WS_FK); bf16_t* FV = (bf16_t*)(ws + WS_FV); bf16_t* KN = (bf16_t*)(ws + WS_KN); bf16_t* VM = (bf16_t*)(ws + WS_VM); bf16_t* MG = (bf16_t*)(ws + WS_MG);
    bf16_t* WA = (bf16_t*)(ws + WS_WA); bf16_t* WD = (bf16_t*)(ws + WS_WD);
    LAS float* scr = (LAS float*)(lds + wave * 16384);
    volatile LAS unsigned* MISC = (volatile LAS unsigned*)(lds + 131072 + 256);
    unsigned* barw = (unsigned*)ws;
    { PHASE_IDS();
      if (tid < 2) MISC[tid] = 0u;
      if (bx == 0) for (int i = tid; i < XCD_BAR_WORDS; i += NWAVES * 64) barw[i] = 0u; }

#if (PH_MASK >> 0) & 1
    { PHASE_IDS();
    tr_mat<1>(p.in[5], D, 2 * FF, nullptr, WA, D, 64, scr, gw, NGW, lane);
    tr_mat<0>(p.in[6], FF, D, nullptr, WD, FF, 64, scr, gw, NGW, lane);
    tr_mat<2>(p.in[7], D, 5800, nullptr, WIN, D, 64, scr, gw, NGW, lane);
    tr_mat<0>(p.in[10], 384, 768, p.in[9], WUQ, 384, 64, scr, gw, NGW, lane);
    tr_mat<0>(p.in[12], 256, 1024, p.in[11], WUKV, 256, 64, scr, gw, NGW, lane);
    tr_mat<0>(p.in[14], D, 1024, nullptr, WMKV, D, 64, scr, gw, NGW, lane);
    for (size_t i = gt * 8; i < (size_t)88 * D; i += NTH * 8) *(u32x4*)(WIN + (size_t)5800 * D + i) = (u32x4){0u, 0u, 0u, 0u};
    if (gt < 32) KMAX[gt] = 0.f;
    cvt_copy(x, XB, (size_t)T * D, gt, NTH);
    cvt_copy(mem, MEMB, (size_t)NB * 256 * D, gt, NTH);
    for (size_t i = gt; i < (size_t)T * 16; i += NTH) {
        const int row = (int)(i >> 4), f = (int)(i & 15);
        const float invf = (float)exp2(-(double)f * (13.287712379549449 / 16.0));
        const float ang = (float)positions[row] * invf;
        const double rev = (double)ang * 0.15915494309189535; const float fr = (float)(rev - __builtin_rint(rev));
        RC[i] = __builtin_amdgcn_cosf(fr); RSN[i] = __builtin_amdgcn_sinf(fr);
    }
    }
#endif
    grid.sync();
    const XcdBarrier xb = xcd_barrier_post(barw, MISC);

#if (PH_MASK >> 1) & 1
    { PHASE_IDS();
    { pg8::Gemm g{XB, WA, T, 2 * FF, D}; pg8::StaticOrder so; so.init(T, 2 * FF, G, bx);
      pg8::EpiSwiglu E{HB, FF}; pg8::gemm_phase<pg8::EpiSwiglu, pg8::StaticOrder, true>(lds, g, so, E); }
    }
#endif
    xcd_barrier(xb);
#if (PH_MASK >> 2) & 1
    { PHASE_IDS();
    { pg8::Gemm g{HB, WD, T, D, FF}; pg8::StaticOrder so; so.init(T, D, G, bx);
      pg8::EpiRes E{x, R, ALPHA, 0.5f}; pg8::gemm_phase<pg8::EpiRes, pg8::StaticOrder, true>(lds, g, so, E); }
    }
#endif
    xcd_barrier(xb);
#if (PH_MASK >> 3) & 1
    { PHASE_IDS();
    for (int m = gw; m < T; m += NGW) ln_row(R + (size_t)m * D, p.in[3], p.in[4], R + (size_t)m * D, XB + (size_t)m * D, lane);
    }
#endif
    xcd_barrier(xb);
#if (PH_MASK >> 4) & 1
    { PHASE_IDS();
    { pg8::Gemm g{XB, WIN, T, NPROJ, D}; pg8::StaticOrder so; so.init(T, NPROJ, G, bx);
      pg8::EpiProj E{GB, FQ, FK, FV, MQ, CQ, CKV, SIDE, p.in[8]}; pg8::gemm_phase<pg8::EpiProj, pg8::StaticOrder, true>(lds, g, so, E); }
    { pg8::Gemm g{MEMB, WMKV, NB * 256, 1024, D}; pg8::StaticOrder so; so.init(NB * 256, 1024, G, (bx + 128) % G);
      pg8::EpiPlain E{MEMKV, 1024, 1.f}; pg8::gemm_phase<pg8::EpiPlain, pg8::StaticOrder, true>(lds, g, so, E); }
    }
#endif
    xcd_barrier(xb);
#if (PH_MASK >> 5) & 1
    { PHASE_IDS();
    if (bx < 32) {
        const int b = bx >> 3, h = bx & 7; LAS double* sh = (LAS double*)lds;
        const float bfh = p.in[13][h]; float lf[16]; double loc = 0.0;
#pragma unroll
        for (int j = 0; j < 16; ++j) { const float xx = SIDE[((size_t)b * S + 16 * tid + j) * 40 + 32 + h] + bfh; lf[j] = fminf(xx, 0.f) - log1pf(__expf(-fabsf(xx))); loc += (double)lf[j]; }
        double incl = loc;
#pragma unroll
        for (int o = 1; o < 64; o <<= 1) { const double v = __shfl_up(incl, o); if (lane >= o) incl += v; }
        if (lane == 63) sh[wave] = incl;
        __syncthreads();
        double run = incl - loc;
        for (int w = 0; w < wave; ++w) run += sh[w];
#pragma unroll
        for (int j = 0; j < 16; ++j) { run += (double)lf[j];
            const float f2 = (float)(run * 1.4426950408889634);
            F2T[(size_t)bx * S + 16 * tid + j] = f2; }
        __syncthreads();
    }
    float kmrun = 0.f; int curb = gw >> 13;
    for (int m = gw; m < T; m += NGW) {
        { const int bb = m >> 13;
          if (bb != curb) { if ((lane & 7) == 0) atomicMax((unsigned*)KMAX + curb * 8 + (lane >> 3), __float_as_uint(kmrun)); kmrun = 0.f; curb = bb; }
          f32x4 k0, k1; pg8::unpack8(*(const u32x4*)(FK + (size_t)m * 512 + lane * 8), k0, k1); float ks = 0.f;
#pragma unroll
          for (int i = 0; i < 4; ++i) ks += k0[i] * k0[i] + k1[i] * k1[i];
          ks += __shfl_xor(ks, 1); ks += __shfl_xor(ks, 2); ks += __shfl_xor(ks, 4);
          kmrun = fmaxf(kmrun, ks); }
        f32x4 a0, a1, c0, c1; float sq = 0.f, sq2 = 0.f;
        if (lane < 48) { pg8::unpack8(*(const u32x4*)(CQ + (size_t)m * 384 + lane * 8), a0, a1);
#pragma unroll
            for (int i = 0; i < 4; ++i) sq += a0[i] * a0[i] + a1[i] * a1[i]; }
        if (lane < 32) { pg8::unpack8(*(const u32x4*)(CKV + (size_t)m * 256 + lane * 8), c0, c1);
#pragma unroll
            for (int i = 0; i < 4; ++i) sq2 += c0[i] * c0[i] + c1[i] * c1[i]; }
        const float rq = 1.f / sqrtf(wave_sum(sq) * (1.f / 384.f) + 1e-6f), rkv = 1.f / sqrtf(wave_sum(sq2) * (1.f / 256.f) + 1e-6f);
        if (lane < 48) *(u32x4*)(CQ + (size_t)m * 384 + lane * 8) = pg8::pack8(a0 * rq, a1 * rq);
        if (lane < 32) *(u32x4*)(CKV + (size_t)m * 256 + lane * 8) = pg8::pack8(c0 * rkv, c1 * rkv);
        if (lane < 16) { const float x1 = SIDE[(size_t)m * 40 + lane], x2 = SIDE[(size_t)m * 40 + 16 + lane], c = RC[(size_t)m * 16 + lane], s = RSN[(size_t)m * 16 + lane];
            KR[(size_t)m * 32 + lane] = (bf16_t)f2bf(x1 * c - x2 * s); KR[(size_t)m * 32 + 16 + lane] = (bf16_t)f2bf(x2 * c + x1 * s); }
    }
    if ((lane & 7) == 0) atomicMax((unsigned*)KMAX + curb * 8 + (lane >> 3), __float_as_uint(kmrun));
    tr_mat<0>(p.in[15], 512, D, nullptr, WBR, 512, 64, scr, gw, NGW, lane);
    tr_mat<0>(p.in[16], 512, D, nullptr, WBR + (size_t)1024 * 512, 512, 64, scr, gw, NGW, lane);
    tr_mat<0>(p.in[17], 512, D, nullptr, WBR + (size_t)2048 * 512, 512, 64, scr, gw, NGW, lane);
    tr_mat<0>(p.in[18], D, D, nullptr, WOUT, D, 64, scr, gw, NGW, lane);
    __syncthreads();
    for (int u = bx; u < NB * 4 * 32; u += G) {
        const int b = u >> 7, hm = (u >> 5) & 3, qb = u & 31;
        att::Args a{MQ + hm * 128, 512, MEMKV + hm * 128, 1024, MEMKV + hm * 128 + 64, 1024, MEMKV + 512 + hm * 128, 1024, MQ + hm * 128, 512, nullptr, nullptr, nullptr, 0.f};
        att::attn_unit<8, 4, false, false, 1, false>(a, (long)b * S + qb * 256, (long)b * 256, 0, 4, lds);
    }
    }
#endif
    xcd_barrier(xb);
#if (PH_MASK >> 6) & 1
    { PHASE_IDS();
    for (int u = bx; u < 512; u += G) {
        const int v = u & 255, i = u >> 8, vcu = (v & 7) * 32 + (v >> 3), bh = vcu >> 3, s = vcu & 7;
        const int qb = (i == 0) ? s : 15 - s; const int b = bh >> 3, h = bh & 7;
        att::Args a{FQ + h * 64, 512, FK + h * 64, 512, nullptr, 0, FV + h * 64, 512, FQ + h * 64, 512, nullptr, nullptr, F2T + (size_t)bh * S, sqrtf(KMAX[bh]) * 1.001f};
        att::attn_unit<5, 2, true, false, 2, true>(a, (long)b * S + qb * 512, (long)b * S, qb * 512, 8 * (qb + 1), lds);
    }
    }
#endif
    xcd_barrier(xb);
#if (PH_MASK >> 7) & 1
    { PHASE_IDS();
    { pg8::Gemm g{CQ, WUQ, T, 768, 384}; pg8::StaticOrder so; so.init(T, 768, G, bx);
      pg8::EpiPlain E{QM, 768, 0.10206207261596577f * pg8::LOG2E}; pg8::gemm_phase<pg8::EpiPlain, pg8::StaticOrder, true>(lds, g, so, E); }
    { pg8::Gemm g{CKV, WUKV, T, 1024, 256}; pg8::StaticOrder so; so.init(T, 1024, G, bx);
      pg8::EpiKvup E{KN, VM}; pg8::gemm_phase<pg8::EpiKvup, pg8::StaticOrder, true>(lds, g, so, E); }
    }
#endif
    xcd_barrier(xb);
#if (PH_MASK >> 8) & 1
    { PHASE_IDS();
    for (int u = bx; u < 512; u += G) {
        const int v = u & 255, i = u >> 8, vcu = (v & 7) * 32 + (v >> 3), bh = vcu >> 3, s = vcu & 7;
        const int qb = (i == 0) ? s : 15 - s; const int b = bh >> 3, h = bh & 7;
        att::Args a{QM + h * 96, 768, KN + h * 64, 512, KR, 32, VM + h * 64, 512, SLOT0 + h * 64, 512, RC, RSN, nullptr, 0.f};
        att::attn_unit<6, 2, true, true, 2, false>(a, (long)b * S + qb * 512, (long)b * S, qb * 512, 8 * (qb + 1), lds);
    }
    }
#endif
    xcd_barrier(xb);
#if (PH_MASK >> 9) & 1
    { PHASE_IDS();
    { pg8::Gemm g{SLOT0, WBR, T, D, 512}; pg8::SegOrder so; so.init(T, D, G, bx, (int)((WS_FQ - WS_SLOT0) / ATILE), (int)((WS_MQ - WS_SLOT0) / ATILE));
      pg8::EpiBranch E{GB, MG}; pg8::gemm_phase<pg8::EpiBranch, pg8::SegOrder, true>(lds, g, so, E); }
    }
#endif
    xcd_barrier(xb);
#if (PH_MASK >> 10) & 1
    { PHASE_IDS();
    { pg8::Gemm g{MG, WOUT, T, D, D}; pg8::StaticOrder so; so.init(T, D, G, bx);
      pg8::EpiRes E{R, R, ALPHA, 1.f}; pg8::gemm_phase<pg8::EpiRes, pg8::StaticOrder, true>(lds, g, so, E); }
    }
#endif
    xcd_barrier(xb);
#if (PH_MASK >> 11) & 1
    { PHASE_IDS();
    for (int m = gw; m < T; m += NGW) ln_row(R + (size_t)m * D, p.in[19], p.in[20], R + (size_t)m * D, XB + (size_t)m * D, lane);
    tr_mat<1>(p.in[21], D, 2 * FF, nullptr, WA, D, 64, scr, gw, NGW, lane);
    tr_mat<0>(p.in[22], FF, D, nullptr, WD, FF, 64, scr, gw, NGW, lane);
    }
#endif
    xcd_barrier(xb);
#if (PH_MASK >> 12) & 1
    { PHASE_IDS();
    { pg8::Gemm g{XB, WA, T, 2 * FF, D}; pg8::StaticOrder so; so.init(T, 2 * FF, G, bx);
      pg8::EpiSwiglu E{HB, FF}; pg8::gemm_phase<pg8::EpiSwiglu, pg8::StaticOrder, true>(lds, g, so, E); }
    }
#endif
    xcd_barrier(xb);
#if (PH_MASK >> 13) & 1
    { PHASE_IDS();
    { pg8::Gemm g{HB, WD, T, D, FF}; pg8::StaticOrder so; so.init(T, D, G, bx);
      pg8::EpiRes E{R, R, ALPHA, 0.5f}; pg8::gemm_phase<pg8::EpiRes, pg8::StaticOrder, true>(lds, g, so, E); }
    }
#endif
    xcd_barrier(xb);
#if (PH_MASK >> 14) & 1
    { PHASE_IDS();
    for (int m = gw; m < T; m += NGW) ln_row(R + (size_t)m * D, p.in[23], p.in[24], R + (size_t)m * D, nullptr, lane);
    }
#endif
}

extern "C" void kernel_launch(void* const* d_in, const int* in_sizes, int n_in, void* d_out, int out_size, void* d_ws, size_t ws_size, hipStream_t stream) {
    static int grid = 0;
    if (grid == 0) {
        if (n_in != 25 || out_size != T * D || ws_size < WS_END) { fprintf(stderr, "kernel_launch: unexpected shapes (n_in %d out %d ws %zu)\n", n_in, out_size, ws_size); grid = -1; return; }
        int dev = 0, cus = 0, per = 0;
        (void)hipGetDevice(&dev); (void)hipDeviceGetAttribute(&cus, hipDeviceAttributeMultiprocessorCount, dev);
        (void)hipFuncSetAttribute((const void*)mega_fwd, hipFuncAttributeMaxDynamicSharedMemorySize, LDS_BYTES);
        (void)hipOccupancyMaxActiveBlocksPerMultiprocessor(&per, (const void*)mega_fwd, NWAVES * 64, LDS_BYTES);
        if (per < 1) per = 1;
        grid = cus * per;
        fprintf(stderr, "kernel_launch: grid %d (cus %d x %d), ws %zu\n", grid, cus, per, ws_size);
    }
    if (grid < 0) return;
    Params p{};
    for (int i = 0; i < 25; ++i) p.in[i] = (const float*)d_in[i];
    p.out = (float*)d_out; p.ws = (unsigned char*)d_ws;
    void* args[] = {&p};
    const hipError_t e = hipLaunchCooperativeKernel((const void*)mega_fwd, dim3(grid), dim3(NWAVES * 64), args, LDS_BYTES, stream);
    if (e != hipSuccess) fprintf(stderr, "kernel_launch: cooperative launch failed: %s (grid %d)\n", hipGetErrorString(e), grid);
}
```

```cpp
#include <hip/hip_runtime.h>
#include <hip/hip_cooperative_groups.h>
#include <cstdio>
#include <cstdint>
#include <cmath>
namespace cg = cooperative_groups;
namespace pg8 {
#define PG8_LAS __attribute__((address_space(3)))
typedef unsigned short bf16_t;
typedef short bf16x8 __attribute__((ext_vector_type(8)));
typedef float f32x4 __attribute__((ext_vector_type(4)));
typedef unsigned u32x4 __attribute__((ext_vector_type(4)));
constexpr int BM = 256, BK = 64, HALF = 128, HTB = HALF * BK * 2  , STAGE_BYTES = 8 * HTB, NXCD = 8, WGM = 8;

__host__ __device__ __forceinline__ int lds_byte(int r, int c) { const int st = (r >> 4) * 2 + (c >> 5), rr = r & 15, cc = c & 31, ob = rr * 64 + cc * 2; return st * 1024 + (ob ^ (((ob >> 9) & 1) << 5)); }
__host__ __device__ __forceinline__ void stage_rc(int b, int& R, int& C) { const int st = b / 1024, sb = b % 1024, swz = sb ^ (((sb >> 9) & 1) << 5); R = (st >> 1) * 16 + swz / 64; C = (st & 1) * 32 + (swz % 64) / 2; }
__host__ __device__ __forceinline__ int perm32(int rho) { const int n = rho >> 4, i = rho & 15; return 8 * (i >> 2) + 4 * n + (i & 3); }

struct Unit { int pm, pn, am, bn, seg; };
struct Gemm { const bf16_t* A; const bf16_t* Bt; int M, N, K; };

struct StaticOrder {
    int nM, nN, nwg, G, c;
    __host__ __device__ void init(int M, int N, int G_, int c_) { nM = M / BM; nN = N / BM; nwg = nM * nN; G = G_; c = c_; }
    __host__ __device__ bool next(int i, Unit& u) const {
        const long L = (long)i * G + c; if (L >= nwg) return false;
        int wgid = (int)L; { const int q = nwg / NXCD, r = nwg % NXCD, xcd = wgid % NXCD, off = wgid / NXCD; wgid = (xcd < r ? xcd * (q + 1) : r * (q + 1) + (xcd - r) * q) + off; }
        const int nig = WGM * nN, gid = wgid / nig, fm = gid * WGM, gsz = (nM - fm) < WGM ? (nM - fm) : WGM;
        u.pm = fm + ((wgid % nig) % gsz); u.pn = (wgid % nig) / gsz; u.am = u.pm; u.bn = u.pn; u.seg = 0; return true;
    }
};

__device__ __forceinline__ unsigned cvt_pk_bf16(float lo, float hi) { unsigned r; asm volatile("v_cvt_pk_bf16_f32 %0, %1, %2" : "=v"(r) : "v"(lo), "v"(hi)); return r; }
typedef float f32x2 __attribute__((ext_vector_type(2)));
template <class Epi, class Sched, bool ALIGN_EPI = false, bool SP2 = true>
__device__ __forceinline__ void gemm_phase(PG8_LAS unsigned char* lds, const Gemm g, const Sched& S, const Epi& E) {
    int tid_ = threadIdx.x; asm volatile("" : "+v"(tid_));
    const int tid = tid_, wid = __builtin_amdgcn_readfirstlane(tid >> 6), lane = tid & 63, wr = wid >> 2, wc = wid & 3, fr = lane & 15, fq = lane >> 4;
    const int K = g.K, nt = K / BK;
    unsigned voffA[2], voffB[2];
#pragma unroll
    for (int i = 0; i < 2; ++i) { int R, C; stage_rc(tid * 16 + i * 8192, R, C); const int Rb = Epi::PERM ? ((R & ~31) + perm32(R & 31)) : R;
        voffA[i] = (unsigned)(R * K + C) * 2u; voffB[i] = (unsigned)(Rb * K + C) * 2u; }
    const size_t kstep = (size_t)(BK * 2);
    const size_t hstep = (size_t)HALF * K * 2;
    const size_t tstep = 2 * hstep;
    const unsigned ldsw = (unsigned)wid * 1024u;
    const int aoff = lds_byte(wr * 64 + fr, fq * 8), boff = lds_byte(wc * 32 + fr, fq * 8);
#define PG8_SA(b, h) (((b) * 2 + (h)) * HTB)
#define PG8_SB(b, h) ((4 + (b) * 2 + (h)) * HTB)
#define PG8_STAGE(bufoff, gbase, voff) do { _Pragma("unroll") for (int _i = 0; _i < 2; ++_i) \
        __builtin_amdgcn_global_load_lds((const unsigned*)((const char*)(gbase) + (voff)[_i]), (PG8_LAS unsigned*)(lds + (bufoff) + ldsw + _i * 8192), 16, 0, 0); } while (0)
#define PG8_LDA(dst, b, h) do { _Pragma("unroll") for (int m = 0; m < 4; ++m) _Pragma("unroll") for (int k = 0; k < 2; ++k) dst[m][k] = *(const PG8_LAS bf16x8*)(lds + PG8_SA(b, h) + aoff + m * 2048 + k * 1024); } while (0)
#define PG8_LDB(dst, b, h) do { _Pragma("unroll") for (int n = 0; n < 2; ++n) _Pragma("unroll") for (int k = 0; k < 2; ++k) dst[n][k] = *(const PG8_LAS bf16x8*)(lds + PG8_SB(b, h) + boff + n * 2048 + k * 1024); } while (0)
#define PG8_MMA(ai, bj, At, Bt) do { __builtin_amdgcn_s_setprio(1); _Pragma("unroll") for (int m = 0; m < 4; ++m) _Pragma("unroll") for (int n = 0; n < 2; ++n) _Pragma("unroll") for (int k = 0; k < 2; ++k) \
        acc[ai][bj][m][n] = __builtin_amdgcn_mfma_f32_16x16x32_bf16(Bt[n][k], At[m][k], acc[ai][bj][m][n], 0, 0, 0); __builtin_amdgcn_s_setprio(0); } while (0)
#define PG8_WAIT_V(n) asm volatile("s_waitcnt vmcnt(" #n ")" ::: "memory")
#define PG8_WAIT_L(n) asm volatile("s_waitcnt lgkmcnt(" #n ")" ::: "memory")
#define PG8_BAR __builtin_amdgcn_s_barrier()
#define PG8_SCHED __builtin_amdgcn_sched_barrier(0)
    Unit cur, nxt; int ui = 0;
    if (!S.next(0, cur)) return;
    f32x4 acc[2][2][4][2];
#pragma unroll
    for (int a = 0; a < 2; ++a)
#pragma unroll
        for (int b = 0; b < 2; ++b)
#pragma unroll
            for (int m = 0; m < 4; ++m)
#pragma unroll
                for (int n = 0; n < 2; ++n) acc[a][b][m][n] = (f32x4){0.f, 0.f, 0.f, 0.f};
    bf16x8 At[4][2], B0[2][2], B1[2][2];
    const char* cA = (const char*)g.A + (size_t)cur.am * tstep; const char* cB = (const char*)g.Bt + (size_t)cur.bn * tstep;
    if constexpr (SP2) {
        PG8_STAGE(PG8_SB(0, 0), cB, voffB); PG8_STAGE(PG8_SB(0, 1), cB + hstep, voffB); PG8_STAGE(PG8_SA(0, 0), cA, voffA); PG8_STAGE(PG8_SA(0, 1), cA + hstep, voffA);
        if (wr == 1) PG8_BAR;
        PG8_WAIT_V(2); PG8_BAR;
        PG8_STAGE(PG8_SB(1, 0), cB + kstep, voffB); PG8_STAGE(PG8_SA(1, 0), cA + kstep, voffA); PG8_STAGE(PG8_SB(1, 1), cB + hstep + kstep, voffB);
        PG8_WAIT_V(6); PG8_BAR;
    } else {
        PG8_STAGE(PG8_SB(0, 0), cB, voffB); PG8_STAGE(PG8_SA(0, 0), cA, voffA); PG8_STAGE(PG8_SB(0, 1), cB + hstep, voffB); PG8_STAGE(PG8_SA(0, 1), cA + hstep, voffA);
        if (wr == 1) PG8_BAR;
        PG8_WAIT_V(4); PG8_BAR;
        PG8_STAGE(PG8_SB(1, 0), cB + kstep, voffB); PG8_STAGE(PG8_SA(1, 0), cA + kstep, voffA); PG8_STAGE(PG8_SB(1, 1), cB + hstep + kstep, voffB);
        PG8_WAIT_V(6); PG8_BAR;
    }
    for (;;) {
        const bool has_next = S.next(ui + 1, nxt);
        const char* nA = has_next ? (const char*)g.A + (size_t)nxt.am * tstep : cA; const char* nB = has_next ? (const char*)g.Bt + (size_t)nxt.bn * tstep : cB;
#pragma nounroll
        for (int t = 0; t < nt; t += 2) {
            const bool last = (t == nt - 2);
            const char* a1 = cA + (size_t)(t + 1) * kstep;
            const char* a2 = last ? nA : cA + (size_t)(t + 2) * kstep; const char* b2 = last ? nB : cB + (size_t)(t + 2) * kstep;
            const char* a3 = a2 + kstep; const char* b3 = b2 + kstep;
            if constexpr (SP2) {
            PG8_LDB(B0, 0, 0); PG8_LDB(B1, 0, 1); PG8_SCHED; PG8_LDA(At, 0, 0); PG8_STAGE(PG8_SA(1, 1), a1 + hstep, voffA);
            PG8_WAIT_V(8); PG8_WAIT_L(0); PG8_BAR; PG8_MMA(0, 0, At, B0); PG8_MMA(0, 1, At, B1); PG8_BAR; PG8_SCHED;
            PG8_LDA(At, 0, 1); PG8_STAGE(PG8_SB(0, 0), b2, voffB); PG8_STAGE(PG8_SB(0, 1), b2 + hstep, voffB); PG8_STAGE(PG8_SA(0, 0), a2, voffA);
            PG8_WAIT_V(8); PG8_WAIT_L(0); PG8_BAR; PG8_MMA(1, 0, At, B0); PG8_MMA(1, 1, At, B1); PG8_BAR; PG8_SCHED;
            PG8_LDB(B0, 1, 0); PG8_LDB(B1, 1, 1); PG8_SCHED; PG8_LDA(At, 1, 0); PG8_STAGE(PG8_SA(0, 1), a2 + hstep, voffA);
            PG8_WAIT_V(8); PG8_WAIT_L(0); PG8_BAR; PG8_MMA(0, 0, At, B0); PG8_MMA(0, 1, At, B1); PG8_BAR; PG8_SCHED;
            PG8_LDA(At, 1, 1); PG8_STAGE(PG8_SB(1, 0), b3, voffB); PG8_STAGE(PG8_SB(1, 1), b3 + hstep, voffB); PG8_STAGE(PG8_SA(1, 0), a3, voffA);
            PG8_WAIT_V(8); PG8_WAIT_L(0); PG8_BAR; PG8_MMA(1, 0, At, B0); PG8_MMA(1, 1, At, B1); PG8_BAR; PG8_SCHED;
            } else {
            PG8_LDB(B0, 0, 0); PG8_SCHED; PG8_LDA(At, 0, 0); PG8_STAGE(PG8_SA(1, 1), a1 + hstep, voffA);
            PG8_WAIT_L(8); PG8_BAR; PG8_WAIT_L(0); PG8_MMA(0, 0, At, B0); PG8_BAR; PG8_SCHED;
            PG8_LDB(B1, 0, 1); PG8_STAGE(PG8_SB(0, 0), b2, voffB);
            PG8_BAR; PG8_WAIT_L(0); PG8_MMA(0, 1, At, B1); PG8_BAR;
            PG8_LDA(At, 0, 1); PG8_STAGE(PG8_SA(0, 0), a2, voffA);
            PG8_BAR; PG8_WAIT_L(0); PG8_MMA(1, 0, At, B0); PG8_BAR; PG8_SCHED;
            PG8_STAGE(PG8_SB(0, 1), b2 + hstep, voffB);
            PG8_WAIT_V(6); PG8_BAR; PG8_MMA(1, 1, At, B1); PG8_BAR;
            PG8_LDB(B0, 1, 0); PG8_SCHED; PG8_LDA(At, 1, 0); PG8_STAGE(PG8_SA(0, 1), a2 + hstep, voffA);
            PG8_WAIT_L(8); PG8_BAR; PG8_WAIT_L(0); PG8_MMA(0, 0, At, B0); PG8_BAR; PG8_SCHED;
            PG8_LDB(B1, 1, 1); PG8_STAGE(PG8_SB(1, 0), b3, voffB);
            PG8_BAR; PG8_WAIT_L(0); PG8_MMA(0, 1, At, B1); PG8_BAR;
            PG8_LDA(At, 1, 1); PG8_STAGE(PG8_SA(1, 0), a3, voffA);
            PG8_BAR; PG8_WAIT_L(0); PG8_MMA(1, 0, At, B0); PG8_BAR; PG8_SCHED;
            PG8_STAGE(PG8_SB(1, 1), b3 + hstep, voffB);
            PG8_WAIT_V(6); PG8_BAR; PG8_MMA(1, 1, At, B1); PG8_BAR;
            }
        }
        if constexpr (ALIGN_EPI) { if (wr == 0) PG8_BAR; }
        E(acc, cur, wr, wc, fr, fq);
        if (!has_next) break;
        if (!Epi::keep(cur)) {
#pragma unroll
        for (int a = 0; a < 2; ++a)
#pragma unroll
            for (int b = 0; b < 2; ++b)
#pragma unroll
                for (int m = 0; m < 4; ++m)
#pragma unroll
                    for (int n = 0; n < 2; ++n) acc[a][b][m][n] = (f32x4){0.f, 0.f, 0.f, 0.f};
        }
        cur = nxt; cA = nA; cB = nB; ++ui;
        if constexpr (ALIGN_EPI) { if (wr == 1) PG8_BAR; }
    }
    PG8_WAIT_V(0);
    if constexpr (!ALIGN_EPI) { if (wr == 0) PG8_BAR; }
    PG8_BAR;
#undef PG8_SA
#undef PG8_SB
#undef PG8_STAGE
#undef PG8_LDA
#undef PG8_LDB
#undef PG8_MMA
#undef PG8_WAIT_V
#undef PG8_WAIT_L
#undef PG8_BAR
#undef PG8_SCHED
}

struct SegOrder {
    StaticOrder b; int a1, a2, bN;
    __device__ void init(int M, int N, int G_, int c_, int a1_, int a2_) { b.init(M, N, G_, c_); a1 = a1_; a2 = a2_; bN = N / BM; }
    __device__ bool next(int i, Unit& u) const { if (!b.next(i / 3, u)) return false; const int s = i % 3; u.seg = s; u.am = u.pm + (s == 0 ? 0 : (s == 1 ? a1 : a2)); u.bn = u.pn + s * bN; return true; }
};

constexpr float LOG2E = 1.4426950408889634f;
__device__ __forceinline__ float sigm(float x) { return __builtin_amdgcn_rcpf(1.f + __expf(-x)); }
__device__ __forceinline__ u32x4 pack8(const f32x4 v0, const f32x4 v1) { u32x4 w; w.x = cvt_pk_bf16(v0[0], v0[1]); w.y = cvt_pk_bf16(v0[2], v0[3]); w.z = cvt_pk_bf16(v1[0], v1[1]); w.w = cvt_pk_bf16(v1[2], v1[3]); return w; }
__device__ __forceinline__ void unpack8(const u32x4 w, f32x4& v0, f32x4& v1) {
    v0[0] = __uint_as_float(w.x << 16); v0[1] = __uint_as_float(w.x & 0xffff0000u); v0[2] = __uint_as_float(w.y << 16); v0[3] = __uint_as_float(w.y & 0xffff0000u);
    v1[0] = __uint_as_float(w.z << 16); v1[1] = __uint_as_float(w.z & 0xffff0000u); v1[2] = __uint_as_float(w.w << 16); v1[3] = __uint_as_float(w.w & 0xffff0000u); }

struct EpiPlain {
    static constexpr bool PERM = true; static __device__ __forceinline__ bool keep(const Unit&) { return false; }
    bf16_t* O; int ldc; float sc;
    __device__ __forceinline__ void operator()(f32x4 (&acc)[2][2][4][2], const Unit& u, int wr, int wc, int fr, int fq) const {
        const int row0 = u.pm * BM + wr * 64 + fr, col0 = u.pn * BM + wc * 32 + 8 * fq;
#pragma unroll
        for (int ai = 0; ai < 2; ++ai)
#pragma unroll
            for (int m = 0; m < 4; ++m) { bf16_t* rowp = O + (size_t)(row0 + ai * HALF + m * 16) * ldc + col0;
#pragma unroll
                for (int bj = 0; bj < 2; ++bj) *(u32x4*)(rowp + bj * HALF) = pack8(acc[ai][bj][m][0] * sc, acc[ai][bj][m][1] * sc); }
    }
};
struct EpiSwiglu {
    static constexpr bool PERM = true; static __device__ __forceinline__ bool keep(const Unit&) { return false; }
    bf16_t* H; int ldh;
    __device__ __forceinline__ void operator()(f32x4 (&acc)[2][2][4][2], const Unit& u, int wr, int wc, int fr, int fq) const {
        const int row0 = u.pm * BM + wr * 64 + fr, col0 = u.pn * HALF + wc * 32 + 8 * fq;
#pragma unroll
        for (int ai = 0; ai < 2; ++ai)
#pragma unroll
            for (int m = 0; m < 4; ++m) {
                f32x4 v0, v1;
#pragma unroll
                for (int i = 0; i < 4; ++i) { const float a0 = acc[ai][0][m][0][i], a1 = acc[ai][0][m][1][i];
                    v0[i] = a0 * sigm(a0) * acc[ai][1][m][0][i]; v1[i] = a1 * sigm(a1) * acc[ai][1][m][1][i]; }
                *(u32x4*)(H + (size_t)(row0 + ai * HALF + m * 16) * ldh + col0) = pack8(v0, v1); }
    }
};
struct EpiRes {
    static constexpr bool PERM = false; static __device__ __forceinline__ bool keep(const Unit&) { return false; }
    const float* res; float* out; float alpha, beta;
    __device__ __forceinline__ void operator()(f32x4 (&acc)[2][2][4][2], const Unit& u, int wr, int wc, int fr, int fq) const {
        const int row0 = u.pm * BM + wr * 64 + fr, col0 = u.pn * BM + wc * 32 + 4 * fq;
#pragma unroll
        for (int ai = 0; ai < 2; ++ai)
#pragma unroll
            for (int m = 0; m < 4; ++m) { const size_t off = (size_t)(row0 + ai * HALF + m * 16) * 1024 + col0;
#pragma unroll
                for (int bj = 0; bj < 2; ++bj)
#pragma unroll
                    for (int n = 0; n < 2; ++n) { const f32x4 r = *(const f32x4*)(res + off + bj * HALF + n * 16); *(f32x4*)(out + off + bj * HALF + n * 16) = r * alpha + acc[ai][bj][m][n] * beta; } }
    }
};
struct EpiProj {
    static constexpr bool PERM = true; static __device__ __forceinline__ bool keep(const Unit&) { return false; }
    bf16_t *G, *FQ, *FK, *FV, *MQ, *CQ, *CKV; float* SIDE; const float* bgate;
    __device__ __forceinline__ void operator()(f32x4 (&acc)[2][2][4][2], const Unit& u, int wr, int wc, int fr, int fq) const {
        const int row0 = u.pm * BM + wr * 64 + fr, pn = u.pn;
#pragma unroll
        for (int bj = 0; bj < 2; ++bj) {
            const int col = pn * BM + bj * HALF + wc * 32 + 8 * fq;
            bf16_t* base; int ld, dcol; float sc = 1.f; bool gate = false;
            if (pn < 12) { base = G; ld = 3072; dcol = col; gate = true; }
            else if (pn < 14) { base = FQ; ld = 512; dcol = col - 3072; sc = 0.125f * LOG2E; }
            else if (pn < 16) { base = FK; ld = 512; dcol = col - 3584; }
            else if (pn < 18) { base = FV; ld = 512; dcol = col - 4096; }
            else if (pn < 20) { base = MQ; ld = 512; dcol = col - 4608; sc = 0.08838834764831845f * LOG2E; }
            else { const int bc = col - 5120;
                if (bc < 384) { base = CQ; ld = 384; dcol = bc; } else if (bc < 640) { base = CKV; ld = 256; dcol = bc - 384; } else { base = nullptr; ld = 0; dcol = bc; } }
            f32x4 b0 = (f32x4){0.f, 0.f, 0.f, 0.f}, b1 = b0;
            if (gate) { b0 = *(const f32x4*)(bgate + col); b1 = *(const f32x4*)(bgate + col + 4); }
            const bool side = (pn == 22) && (bj == 1) && (wc == 0 || (wc == 1 && fq == 0));
#pragma unroll
            for (int ai = 0; ai < 2; ++ai)
#pragma unroll
                for (int m = 0; m < 4; ++m) { const size_t row = (size_t)(row0 + ai * HALF + m * 16);
                    f32x4 v0 = acc[ai][bj][m][0], v1 = acc[ai][bj][m][1];
                    if (gate) {
#pragma unroll
                        for (int i = 0; i < 4; ++i) { v0[i] = sigm(v0[i] + b0[i]); v1[i] = sigm(v1[i] + b1[i]); } }
                    else { v0 = v0 * sc; v1 = v1 * sc; }
                    if (base) *(u32x4*)(base + row * ld + dcol) = pack8(v0, v1);
                    if (side) { float* sp = SIDE + row * 40 + (dcol - 640); *(f32x4*)sp = v0; *(f32x4*)(sp + 4) = v1; } }
        }
    }
};
struct EpiKvup {
    static constexpr bool PERM = true; static __device__ __forceinline__ bool keep(const Unit&) { return false; }
    bf16_t* KN; bf16_t* VM;
    __device__ __forceinline__ void operator()(f32x4 (&acc)[2][2][4][2], const Unit& u, int wr, int wc, int fr, int fq) const {
        const int row0 = u.pm * BM + wr * 64 + fr; bf16_t* base = ((wc < 2) ? KN : VM) + (2 * u.pn) * 64 + (wc & 1) * 32 + 8 * fq;
#pragma unroll
        for (int ai = 0; ai < 2; ++ai)
#pragma unroll
            for (int m = 0; m < 4; ++m) { bf16_t* rowp = base + (size_t)(row0 + ai * HALF + m * 16) * 512;
#pragma unroll
                for (int bj = 0; bj < 2; ++bj) *(u32x4*)(rowp + bj * 64) = pack8(acc[ai][bj][m][0], acc[ai][bj][m][1]); }
    }
};
struct EpiBranch {
    static constexpr bool PERM = true; static __device__ __forceinline__ bool keep(const Unit& u) { return u.seg < 2; }
    const bf16_t* G; bf16_t* MG;
    __device__ __forceinline__ void operator()(f32x4 (&acc)[2][2][4][2], const Unit& u, int wr, int wc, int fr, int fq) const {
        const int row0 = u.pm * BM + wr * 64 + fr, col0 = u.pn * BM + wc * 32 + 8 * fq, seg = u.seg;
#pragma unroll
        for (int ai = 0; ai < 2; ++ai)
#pragma unroll
            for (int m = 0; m < 4; ++m) { const size_t row = (size_t)(row0 + ai * HALF + m * 16);
#pragma unroll
                for (int bj = 0; bj < 2; ++bj) { const int col = col0 + bj * HALF;
                    f32x4 ga0, ga1; unpack8(*(const u32x4*)(G + row * 3072 + seg * 1024 + col), ga0, ga1);
                    if (seg < 2) { f32x4 gb0, gb1; unpack8(*(const u32x4*)(G + row * 3072 + (seg + 1) * 1024 + col), gb0, gb1);
#pragma unroll
                        for (int i = 0; i < 4; ++i) { acc[ai][bj][m][0][i] *= fmaxf(ga0[i], 1e-30f) * __builtin_amdgcn_rcpf(fmaxf(gb0[i], 1e-30f)); acc[ai][bj][m][1][i] *= fmaxf(ga1[i], 1e-30f) * __builtin_amdgcn_rcpf(fmaxf(gb1[i], 1e-30f)); } }
                    else { f32x4 v0, v1;
#pragma unroll
                        for (int i = 0; i < 4; ++i) { v0[i] = acc[ai][bj][m][0][i] * fmaxf(ga0[i], 1e-30f); v1[i] = acc[ai][bj][m][1][i] * fmaxf(ga1[i], 1e-30f); }
                        *(u32x4*)(MG + row * 1024 + col) = pack8(v0, v1); } } }
    }
};
}

namespace att {
using pg8::bf16_t;
typedef short bf16x8 __attribute__((ext_vector_type(8)));
typedef short s16x4 __attribute__((ext_vector_type(4)));
typedef float f32x16 __attribute__((ext_vector_type(16)));
typedef unsigned u32x4 __attribute__((ext_vector_type(4)));
typedef unsigned u32x2 __attribute__((ext_vector_type(2)));
typedef float f32x4 __attribute__((ext_vector_type(4)));
#define ATT_LAS __attribute__((address_space(3)))
struct Args {
    const bf16_t* Q; int qp;
    const bf16_t* KA; int kap;
    const bf16_t* KB; int kbp;
    const bf16_t* V; int vp;
    bf16_t* O; int op;
    const float* RC; const float* RSN;
    const float* F2; float kmax;
};
__device__ __forceinline__ unsigned cvtpk(float lo, float hi) { unsigned r; asm volatile("v_cvt_pk_bf16_f32 %0, %1, %2" : "=v"(r) : "v"(lo), "v"(hi)); return r; }
__device__ __forceinline__ s16x4 vtr(const ATT_LAS unsigned char* p) { return __builtin_bit_cast(s16x4, __builtin_amdgcn_ds_read_tr16_b64_v4i16((ATT_LAS s16x4*)p)); }

template <int DKC, int DVB, bool CAUSAL, bool ROPE, int RG, bool PRUNE>
__device__ __forceinline__ void attn_unit(const Args a, long qrow0, long krow0, int q0, int NT, ATT_LAS unsigned char* lds) {
    int tid_ = threadIdx.x; asm volatile("" : "+v"(tid_));
    const int tid = tid_, lane = tid & 63, r32 = lane & 31, hi = lane >> 5;
    const int wid = __builtin_amdgcn_readfirstlane(tid >> 6);
    constexpr int KSLOT = DKC * 2048, VSLOT = DVB * 4096, NKC = PRUNE ? 8 : 2 * DKC, KL = (NKC + 7) / 8, VL = (DVB * 4 + 7) / 8;
    ATT_LAS unsigned char* Kb = lds; ATT_LAS unsigned char* Vb = lds + 2 * KSLOT;
    const int wrow = wid * 32 * RG;
    bf16x8 qr[RG][DKC];
#pragma unroll
    for (int g = 0; g < RG; ++g) {
        const bf16_t* qrow = a.Q + (size_t)(qrow0 + wrow + g * 32 + r32) * a.qp + hi * 8;
#pragma unroll
        for (int c = 0; c < (PRUNE ? 4 : DKC); ++c) qr[g][c] = *(const bf16x8*)(qrow + c * 16);
        if constexpr (PRUNE) {
            const float f2 = a.F2[q0 + wrow + g * 32 + r32];
            const unsigned h1 = cvtpk(f2, 0.f) & 0xffffu; const float r1 = f2 - __uint_as_float(h1 << 16);
            const unsigned h2 = cvtpk(r1, 0.f) & 0xffffu; const float r2 = r1 - __uint_as_float(h2 << 16); const unsigned h3 = cvtpk(r2, 0.f) & 0xffffu;
            u32x4 w = (u32x4){0x3f803f80u, 0x3f80u | (h1 << 16), h2 | (h3 << 16), 0u};
            if (hi) w = (u32x4){0u, 0u, 0u, 0u};
            qr[g][4] = __builtin_bit_cast(bf16x8, w);
        }
        if constexpr (ROPE) {
            const size_t trow = (size_t)(qrow0 + wrow + g * 32 + r32) * 16 + 8 * hi;
            const f32x4 c0 = *(const f32x4*)(a.RC + trow), c1 = *(const f32x4*)(a.RC + trow + 4), s0 = *(const f32x4*)(a.RSN + trow), s1 = *(const f32x4*)(a.RSN + trow + 4);
            bf16x8 x1 = qr[g][4], x2 = qr[g][5];
#pragma unroll
            for (int j = 0; j < 8; ++j) { const float cc = j < 4 ? c0[j & 3] : c1[j & 3], ss = j < 4 ? s0[j & 3] : s1[j & 3];
                const float a1 = __uint_as_float((unsigned)(unsigned short)x1[j] << 16), a2 = __uint_as_float((unsigned)(unsigned short)x2[j] << 16);
                const float r1 = a1 * cc - a2 * ss, r2 = a2 * cc + a1 * ss;
                x1[j] = (short)(cvtpk(r1, 0.f) & 0xffffu); x2[j] = (short)(cvtpk(r2, 0.f) & 0xffffu); }
            qr[g][4] = x1; qr[g][5] = x2;
        }
    }
#define ATT_DMA(t, buf) do { const size_t kr_ = (size_t)(krow0 + 64 * (t)); \
    _Pragma("unroll") for (int j = 0; j < KL; ++j) { const int c8 = wid + 8 * j; if (c8 < NKC) { \
        const bf16_t* src = (c8 < 8) ? (a.KA + (kr_ + lane) * a.kap + c8 * 8) : (a.KB + (kr_ + lane) * a.kbp + (c8 - 8) * 8); \
        __builtin_amdgcn_global_load_lds((const unsigned*)src, (ATT_LAS unsigned*)(Kb + (buf) * KSLOT + c8 * 1024), 16, 0, 0); } } \
    _Pragma("unroll") for (int j = 0; j < VL; ++j) { const int pc = wid + 8 * j; if (pc < DVB * 4) { \
        __builtin_amdgcn_global_load_lds((const unsigned*)(a.V + (kr_ + 16 * (pc & 3) + (lane >> 2)) * a.vp + 32 * (pc >> 2) + (lane & 3) * 8), (ATT_LAS unsigned*)(Vb + (buf) * VSLOT + pc * 1024), 16, 0, 0); } } } while (0)
    float ub[RG]; bool gdone[RG]; bool wdone = false;
    ATT_LAS unsigned* cnt = (ATT_LAS unsigned*)(lds + 2 * KSLOT + 2 * VSLOT);
    if constexpr (PRUNE) {
#pragma unroll
        for (int g = 0; g < RG; ++g) { float nq = 0.f;
#pragma unroll
            for (int c = 0; c < 4; ++c)
#pragma unroll
                for (int j = 0; j < 8; ++j) { const float v = __uint_as_float((unsigned)(unsigned short)qr[g][c][j] << 16); nq += v * v; }
            nq += __shfl_xor(nq, 32);
            ub[g] = sqrtf(nq) * a.kmax + 2.f + a.F2[q0 + wrow + g * 32 + r32]; gdone[g] = false; }
        if (tid == 0) cnt[0] = 0u;
    }
    float fst = 0.f;
#define ATT_KBIAS(buf) do { const unsigned h1 = cvtpk(fst, 0.f) & 0xffffu; const float r1 = fst - __uint_as_float(h1 << 16); \
        const unsigned h2 = cvtpk(r1, 0.f) & 0xffffu; const float r2 = r1 - __uint_as_float(h2 << 16); const unsigned h3 = cvtpk(r2, 0.f) & 0xffffu; \
        *(ATT_LAS u32x4*)(Kb + (buf) * KSLOT + 8 * 1024 + lane * 16) = (u32x4){(h1 ^ 0x8000u) | ((h2 ^ 0x8000u) << 16), (h3 ^ 0x8000u) | 0x3f800000u, 0x3f803f80u, 0u}; } while (0)
    if constexpr (PRUNE) {
        if (wid == 0) { fst = a.F2[64 * (NT - 1) + lane]; ATT_KBIAS(0); }
        if (wid == 1) { *(ATT_LAS u32x4*)(Kb + 9 * 1024 + lane * 16) = (u32x4){0u, 0u, 0u, 0u}; *(ATT_LAS u32x4*)(Kb + KSLOT + 9 * 1024 + lane * 16) = (u32x4){0u, 0u, 0u, 0u}; }
    }
    ATT_DMA(PRUNE ? NT - 1 : 0, 0);
    asm volatile("s_waitcnt vmcnt(0)" ::: "memory");
    __syncthreads();
    f32x16 o[RG][DVB];
    float mrun[RG], lrun[RG];
#pragma unroll
    for (int g = 0; g < RG; ++g) { mrun[g] = -1e30f; lrun[g] = 0.f;
#pragma unroll
        for (int d = 0; d < DVB; ++d)
#pragma unroll
            for (int r = 0; r < 16; ++r) o[g][d][r] = 0.f; }
    const int koff = hi * 1024 + r32 * 16;
    const int voff = ((lane >> 4) & 1) * 32 + (lane & 3) * 8 + (4 * hi + ((lane & 15) >> 2)) * 64;
    const int qw0 = q0 + wrow;
    for (int it = 0; it < NT; ++it) {
        const int t = PRUNE ? NT - 1 - it : it, buf = it & 1;
        if constexpr (PRUNE) { if (tid == 0) cnt[(it + 1) % 3] = 0u; }
        float f2e = 0.f; if constexpr (PRUNE) { if (t > 0) f2e = a.F2[64 * t - 1]; }
        if (it + 1 < NT) { ATT_DMA(PRUNE ? t - 1 : t + 1, buf ^ 1); if constexpr (PRUNE) { if (wid == 0) fst = a.F2[64 * (t - 1) + lane]; } }
        const bool active = (!CAUSAL || (64 * t <= qw0 + 32 * RG - 1)) && !(PRUNE && wdone);
        if (active) {
            f32x16 s0[RG], s1[RG];
#pragma unroll
            for (int g = 0; g < RG; ++g)
#pragma unroll
                for (int r = 0; r < 16; ++r) { s0[g][r] = 0.f; s1[g][r] = 0.f; }
            const ATT_LAS unsigned char* kp = Kb + buf * KSLOT + koff;
#pragma unroll
            for (int c = 0; c < DKC; ++c) {
                const bf16x8 k0 = *(const ATT_LAS bf16x8*)(kp + c * 2048), k1 = *(const ATT_LAS bf16x8*)(kp + c * 2048 + 512);
#pragma unroll
                for (int g = 0; g < RG; ++g) {
                    s0[g] = __builtin_amdgcn_mfma_f32_32x32x16_bf16(k0, qr[g][c], s0[g], 0, 0, 0);
                    s1[g] = __builtin_amdgcn_mfma_f32_32x32x16_bf16(k1, qr[g][c], s1[g], 0, 0, 0);
                }
            }
            u32x4 pw[RG][4];
#pragma unroll
            for (int g = 0; g < RG; ++g) {
                if (CAUSAL && (64 * t + 63 > qw0 + 32 * g)) {
                    const int kb = 64 * t + 4 * hi, qpos = qw0 + 32 * g + r32;
#pragma unroll
                    for (int r = 0; r < 16; ++r) { const int kv = kb + (r & 3) + 8 * (r >> 2); if (kv > qpos) s0[g][r] = -INFINITY; if (kv + 32 > qpos) s1[g][r] = -INFINITY; }
                }
                float rm = __builtin_fmaxf(s0[g][0], s1[g][0]), rm2 = __builtin_fmaxf(s0[g][1], s1[g][1]);
#pragma unroll
                for (int r = 2; r < 16; r += 2) { rm = __builtin_fmaxf(__builtin_fmaxf(rm, s0[g][r]), s1[g][r]); rm2 = __builtin_fmaxf(__builtin_fmaxf(rm2, s0[g][r + 1]), s1[g][r + 1]); }
                rm = __builtin_fmaxf(rm, rm2);
                { const auto rr = __builtin_amdgcn_permlane32_swap(__float_as_uint(rm), __float_as_uint(rm), false, false); rm = __builtin_fmaxf(__uint_as_float(rr[0]), __uint_as_float(rr[1])); }
                const float mn = __builtin_fmaxf(mrun[g], rm);
                if (__builtin_amdgcn_ballot_w64(mn > mrun[g]) != 0ull) {
                    const float alpha = __builtin_amdgcn_exp2f(mrun[g] - mn);
                    lrun[g] *= alpha;
#pragma unroll
                    for (int d = 0; d < DVB; ++d)
#pragma unroll
                        for (int r = 0; r < 16; ++r) o[g][d][r] *= alpha;
                    mrun[g] = mn;
                }
                float sm[4] = {0.f, 0.f, 0.f, 0.f};
#pragma unroll
                for (int r = 0; r < 16; ++r) { s0[g][r] = __builtin_amdgcn_exp2f(s0[g][r] - mn); s1[g][r] = __builtin_amdgcn_exp2f(s1[g][r] - mn); sm[r & 1] += s0[g][r]; sm[2 + (r & 1)] += s1[g][r]; }
                lrun[g] += (sm[0] + sm[1]) + (sm[2] + sm[3]);
                if constexpr (PRUNE) { if (t > 0) {
                    if (__builtin_amdgcn_ballot_w64((ub[g] - f2e - mrun[g]) < -40.f) == ~0ull) gdone[g] = true; } }
#pragma unroll
                for (int i = 0; i < 4; ++i) { pw[g][0][i] = cvtpk(s0[g][2 * i], s0[g][2 * i + 1]); pw[g][1][i] = cvtpk(s0[g][8 + 2 * i], s0[g][9 + 2 * i]);
                    pw[g][2][i] = cvtpk(s1[g][2 * i], s1[g][2 * i + 1]); pw[g][3][i] = cvtpk(s1[g][8 + 2 * i], s1[g][9 + 2 * i]); }
            }
            const ATT_LAS unsigned char* vpp = Vb + buf * VSLOT + voff;
#pragma unroll
            for (int d = 0; d < DVB; ++d)
#pragma unroll
                for (int ks = 0; ks < 4; ++ks) {
                    const s16x4 lo = vtr(vpp + d * 4096 + ks * 1024), hh = vtr(vpp + d * 4096 + ks * 1024 + 512);
                    const bf16x8 vf = (bf16x8){lo[0], lo[1], lo[2], lo[3], hh[0], hh[1], hh[2], hh[3]};
#pragma unroll
                    for (int g = 0; g < RG; ++g) o[g][d] = __builtin_amdgcn_mfma_f32_32x32x16_bf16(vf, __builtin_bit_cast(bf16x8, pw[g][ks]), o[g][d], 0, 0, 0);
                }
        }
        if constexpr (PRUNE) { if (wid == 0 && it + 1 < NT) ATT_KBIAS(buf ^ 1);
            bool all = true;
#pragma unroll
            for (int g = 0; g < RG; ++g) all = all && gdone[g];
            wdone = wdone || all;
            if (wdone && lane == 0) __hip_atomic_fetch_add(cnt + (it % 3), 1u, __ATOMIC_RELAXED, __HIP_MEMORY_SCOPE_WORKGROUP); }
        asm volatile("s_waitcnt vmcnt(0) lgkmcnt(0)" ::: "memory");
        __syncthreads();
        if constexpr (PRUNE) { if (((volatile ATT_LAS unsigned*)cnt)[it % 3] == 8u) break; }
    }
    if constexpr (PRUNE) __syncthreads();
#pragma unroll
    for (int g = 0; g < RG; ++g) {
        const float lt = lrun[g] + __shfl_xor(lrun[g], 32);
        const float inv = 1.f / lt;
        bf16_t* orow = a.O + (size_t)(qrow0 + wrow + g * 32 + r32) * a.op + 4 * hi;
#pragma unroll
        for (int d = 0; d < DVB; ++d)
#pragma unroll
            for (int gg = 0; gg < 4; ++gg) { u32x2 w; w.x = cvtpk(o[g][d][4 * gg] * inv, o[g][d][4 * gg + 1] * inv); w.y = cvtpk(o[g][d][4 * gg + 2] * inv, o[g][d][4 * gg + 3] * inv);
                *(u32x2*)(orow + 32 * d + 8 * gg) = w; }
    }
#undef ATT_DMA
#undef ATT_KBIAS
}
}

using pg8::bf16_t; using pg8::f32x4; using pg8::u32x4;
#define LAS __attribute__((address_space(3)))
constexpr int NB = 4, S = 8192, T = NB * S, D = 1024, FF = 2816, NPROJ = 5888, NWAVES = 8;
constexpr float ALPHA = 1.189207115002721f;
constexpr size_t MiB = 1u << 20;
constexpr size_t WS_RS = 2 * MiB;
constexpr size_t WS_RC = 3 * MiB;
constexpr size_t WS_RSN = 5 * MiB;
constexpr size_t WS_SIDE = 7 * MiB;
constexpr size_t WS_MEMB = 12 * MiB;
constexpr size_t WS_MEMKV = 14 * MiB;
constexpr size_t WS_WIN = 16 * MiB;
constexpr size_t WS_WUQ = 28 * MiB;
constexpr size_t WS_WUKV = 29 * MiB;
constexpr size_t WS_WMKV = 30 * MiB;
constexpr size_t WS_KR = 32 * MiB;
constexpr size_t WS_XB = 34 * MiB;
constexpr size_t WS_QM = 34 * MiB;
constexpr size_t WS_WBR = 82 * MiB;
constexpr size_t WS_WOUT = 87 * MiB;
constexpr size_t WS_H = 98 * MiB;
constexpr size_t WS_G = 98 * MiB;
constexpr size_t WS_SLOT0 = 290 * MiB;
constexpr size_t WS_FQ = 338 * MiB;
constexpr size_t WS_MQ = 434 * MiB;
constexpr size_t WS_FK = 370 * MiB;
constexpr size_t WS_FV = 402 * MiB;
constexpr size_t WS_KN = 370 * MiB;
constexpr size_t WS_VM = 402 * MiB;
constexpr size_t WS_MG = 370 * MiB;
constexpr size_t WS_WA = 480 * MiB;
constexpr size_t WS_WD = 491 * MiB;
constexpr size_t WS_END = 512 * MiB;
constexpr size_t ATILE = (size_t)256 * 512 * 2;
static_assert(WS_MQ + (size_t)T * 512 * 2 <= WS_WA && WS_WD + (size_t)1024 * 2816 * 2 <= WS_END && (WS_FQ - WS_SLOT0) % ATILE == 0 && (WS_MQ - WS_SLOT0) % ATILE == 0 && WS_MG + (size_t)T * 1024 * 2 <= WS_MQ, "ws map");
constexpr int LDS_BYTES = 147456;

__device__ __forceinline__ unsigned f2bf(float f) { unsigned u = __builtin_bit_cast(unsigned, f); return (u + 0x7fffu + ((u >> 16) & 1u)) >> 16; }
__device__ __forceinline__ unsigned pk2(float lo, float hi) { return f2bf(lo) | (f2bf(hi) << 16); }
__device__ __forceinline__ float bf2f(unsigned b) { return __uint_as_float(b << 16); }
__device__ __forceinline__ float wave_sum(float v) {
#pragma unroll
    for (int o = 1; o < 64; o <<= 1) v += __shfl_xor(v, o);
    return v;
}
#define LDS_WAIT() asm volatile("s_waitcnt lgkmcnt(0)" ::: "memory")

__device__ __forceinline__ int map_ffn(int c) { return c < FF ? ((c >> 7) << 8) + (c & 127) : (((c - FF) >> 7) << 8) + 128 + ((c - FF) & 127); }
__device__ __forceinline__ int map_win(int c) {
    if (c < 384) return 5120 + c;
    if (c < 640) return 5504 + (c - 384);
    if (c < 672) return 5760 + (c - 640);
    if (c < 1184) return 3072 + (c - 672);
    if (c < 1696) return 3584 + (c - 1184);
    if (c < 2208) return 4096 + (c - 1696);
    if (c < 2216) return 5792 + (c - 2208);
    if (c < 2728) return 4608 + (c - 2216);
    return c - 2728;
}
template <int MODE>
__device__ __forceinline__ void tr_mat(const float* __restrict__ W, int K, int N, const float* __restrict__ ks, bf16_t* WT, int ldt, int kmul, LAS float* scr, int gw, int NGW, int lane) {
    const int nblk = (N + 31) / 32, items = (K / 64) * nblk;
    for (int it = gw; it < items; it += NGW) {
        const int kb = it / nblk, nb = it % nblk, k0 = 64 * kb, n0 = 32 * nb;
        const int r8 = lane >> 3, c4 = (lane & 7) * 4; const bool ok = n0 + c4 < N;
        f32x4 v[8];
#pragma unroll
        for (int i = 0; i < 8; ++i) v[i] = ok ? __builtin_nontemporal_load((const f32x4*)(W + (size_t)(k0 + 8 * i + r8) * N + n0 + c4)) : (f32x4){0.f, 0.f, 0.f, 0.f};
#pragma unroll
        for (int i = 0; i < 8; ++i) { const int kk = 8 * i + r8; if (ks) v[i] = v[i] * ks[k0 + kk];
            scr[kk * 33 + c4] = v[i][0]; scr[kk * 33 + c4 + 1] = v[i][1]; scr[kk * 33 + c4 + 2] = v[i][2]; scr[kk * 33 + c4 + 3] = v[i][3]; }
        LDS_WAIT(); asm volatile("" ::: "memory");
        const int c = lane & 7, dc = kb * kmul + 8 * c;
#pragma unroll
        for (int j = 0; j < 4; ++j) { const int n = (lane >> 3) + 8 * j, sc = n0 + n;
            if (sc < N) { const LAS float* s = scr + (8 * c) * 33 + n;
                u32x4 o; o.x = pk2(s[0 * 33], s[1 * 33]); o.y = pk2(s[2 * 33], s[3 * 33]); o.z = pk2(s[4 * 33], s[5 * 33]); o.w = pk2(s[6 * 33], s[7 * 33]);
                const int dr = MODE == 1 ? map_ffn(sc) : (MODE == 2 ? map_win(sc) : sc);
                *(u32x4*)(WT + (size_t)dr * ldt + dc) = o; } }
        LDS_WAIT(); asm volatile("" ::: "memory");
    }
}
__device__ __forceinline__ void cvt_copy(const float* __restrict__ src, bf16_t* dst, size_t n, size_t gt, size_t NTH) {
    size_t i = gt * 8;
    for (; i + 3 * NTH * 8 < n; i += 4 * NTH * 8) {
        f32x4 a[4], b[4];
#pragma unroll
        for (int u = 0; u < 4; ++u) { a[u] = __builtin_nontemporal_load((const f32x4*)(src + i + u * NTH * 8)); b[u] = __builtin_nontemporal_load((const f32x4*)(src + i + u * NTH * 8 + 4)); }
#pragma unroll
        for (int u = 0; u < 4; ++u) { u32x4 o; o.x = pk2(a[u][0], a[u][1]); o.y = pk2(a[u][2], a[u][3]); o.z = pk2(b[u][0], b[u][1]); o.w = pk2(b[u][2], b[u][3]); *(u32x4*)(dst + i + u * NTH * 8) = o; }
    }
    for (; i < n; i += NTH * 8) { const f32x4 a = *(const f32x4*)(src + i), b = *(const f32x4*)(src + i + 4);
        u32x4 o; o.x = pk2(a[0], a[1]); o.y = pk2(a[2], a[3]); o.z = pk2(b[0], b[1]); o.w = pk2(b[2], b[3]); *(u32x4*)(dst + i) = o; }
}
__device__ __forceinline__ void ln_row(const float* xrow, const float* __restrict__ g, const float* __restrict__ b, float* outf, bf16_t* outb, int lane) {
    f32x4 v[4]; float s = 0.f;
#pragma unroll
    for (int j = 0; j < 4; ++j) { v[j] = *(const f32x4*)(xrow + 4 * lane + 256 * j); s += (v[j][0] + v[j][1]) + (v[j][2] + v[j][3]); }
    const float mean = wave_sum(s) * (1.f / D); float s2 = 0.f;
#pragma unroll
    for (int j = 0; j < 4; ++j) { v[j] = v[j] - mean; s2 += (v[j][0] * v[j][0] + v[j][1] * v[j][1]) + (v[j][2] * v[j][2] + v[j][3] * v[j][3]); }
    const float rstd = 1.f / sqrtf(wave_sum(s2) * (1.f / D) + 1e-5f);
#pragma unroll
    for (int j = 0; j < 4; ++j) { const f32x4 gg = *(const f32x4*)(g + 4 * lane + 256 * j), bb = *(const f32x4*)(b + 4 * lane + 256 * j);
        const f32x4 y = v[j] * rstd * gg + bb;
        if (outf) *(f32x4*)(outf + 4 * lane + 256 * j) = y;
        if (outb) { unsigned long long w = (unsigned long long)pk2(y[0], y[1]) | ((unsigned long long)pk2(y[2], y[3]) << 32); *(unsigned long long*)(outb + 4 * lane + 256 * j) = w; } }
}

#define XB_TMO      128
#define XB_XCNT(j)  (256  + 64 * (j))
#define XB_XSUB(j)  (1280 + 64 * (j))
#define XB_XGEN(j)  (2304 + 64 * (j))
#define XB_TOP      3328
#define XB_TOPGEN   3392
#define XCD_BAR_WORDS 3456
#define XB_SPIN_CAP (1u << 18)

__device__ __forceinline__ unsigned xb_ld(unsigned* p)              { return __hip_atomic_load(p, __ATOMIC_RELAXED, __HIP_MEMORY_SCOPE_AGENT); }
__device__ __forceinline__ unsigned xb_add(unsigned* p, unsigned v) { return __hip_atomic_fetch_add(p, v, __ATOMIC_RELAXED, __HIP_MEMORY_SCOPE_AGENT); }
__device__ __forceinline__ unsigned xb_xcc_id() { return (unsigned)__builtin_amdgcn_s_getreg((3 << 11) | 20) & 0xFu; }
#define XB_SPIN(cond, bar) do { unsigned _sp = 0; while (cond) { __builtin_amdgcn_s_sleep(1); \
    if ((++_sp & 255u) == 0u) { if (xb_ld(&(bar)[XB_TMO])) break; if (_sp > XB_SPIN_CAP) { atomicAdd(&(bar)[XB_TMO], 1u); break; } } } } while (0)

struct XcdBarrier {
    unsigned* bar; unsigned x;
    volatile LAS unsigned* st;
};

__device__ __forceinline__ XcdBarrier xcd_barrier_post(unsigned* bar, volatile LAS unsigned* st) {
    XcdBarrier b; b.bar = bar; b.x = xb_xcc_id(); b.st = st;
    if (threadIdx.x == 0) (void)xb_add(&bar[XB_XCNT(b.x)], 1u);
    return b;
}
__device__ __forceinline__ void xcd_barrier_complete(unsigned* bar, unsigned x, unsigned& nloc, unsigned& nx) {
    const unsigned G = gridDim.x * gridDim.y * gridDim.z;
    unsigned sum, cnt, mine, sp = 0u;
    for (;;) {
        sum = 0u; cnt = 0u; mine = 0u;
#pragma unroll
        for (unsigned j = 0; j < 16; ++j) { const unsigned c = xb_ld(&bar[XB_XCNT(j)]); sum += c; cnt += (c > 0u) ? 1u : 0u; mine = (j == x) ? c : mine; }
        if (sum == G) break;
        __builtin_amdgcn_s_sleep(1);
        if ((++sp & 255u) == 0u) { if (xb_ld(&bar[XB_TMO])) break; if (sp > XB_SPIN_CAP) { atomicAdd(&bar[XB_TMO], 1u); break; } }
    }
    nloc = mine > 0u ? mine : 1u; nx = cnt > 0u ? cnt : 1u;
}

__device__ __forceinline__ void xcd_barrier(const XcdBarrier& b) {
    asm volatile("s_waitcnt vmcnt(0)" ::: "memory");
    __syncthreads();
    if (threadIdx.x == 0) {
        unsigned* bar = b.bar;
        __builtin_amdgcn_s_waitcnt(0);
        unsigned nloc = b.st[0], nx = b.st[1];
        if (nloc == 0u) { xcd_barrier_complete(bar, b.x, nloc, nx); b.st[0] = nloc; b.st[1] = nx; }
        const unsigned old = xb_add(&bar[XB_XSUB(b.x)], 1u);
        const unsigned gen = old / nloc;
        if (old + 1u == (gen + 1u) * nloc) {
            __builtin_amdgcn_fence(__ATOMIC_RELEASE, "agent");
            asm volatile("s_waitcnt vmcnt(0)" ::: "memory");
            const unsigned og = xb_add(&bar[XB_TOP], 1u);
            const unsigned tg = og / nx;
            if (og + 1u == (tg + 1u) * nx) xb_add(&bar[XB_TOPGEN], 1u);
            else XB_SPIN(xb_ld(&bar[XB_TOPGEN]) == tg, bar);
            __builtin_amdgcn_fence(__ATOMIC_ACQUIRE, "agent");
            xb_add(&bar[XB_XGEN(b.x)], 1u);
            asm volatile("s_waitcnt vmcnt(0)" ::: "memory");
        } else {
            XB_SPIN(xb_ld(&bar[XB_XGEN(b.x)]) == gen, bar);
            __builtin_amdgcn_fence(__ATOMIC_ACQUIRE, "agent");
            asm volatile("s_waitcnt vmcnt(0)" ::: "memory");
        }
    }
    __syncthreads();
}

__device__ __forceinline__ void ln_rows2(float* R, int m0, int m1, const float* __restrict__ g, const float* __restrict__ b, bf16_t* XBo, bool wf, int lane) {
    f32x4 v[2][4]; float s[2] = {0.f, 0.f};
#pragma unroll
    for (int r = 0; r < 2; ++r) { const float* xrow = R + (size_t)(r ? m1 : m0) * D;
#pragma unroll
        for (int j = 0; j < 4; ++j) { v[r][j] = *(const f32x4*)(xrow + 4 * lane + 256 * j); s[r] += (v[r][j][0] + v[r][j][1]) + (v[r][j][2] + v[r][j][3]); } }
    float mean[2], rstd[2];
#pragma unroll
    for (int r = 0; r < 2; ++r) { mean[r] = wave_sum(s[r]) * (1.f / D); float s2 = 0.f;
#pragma unroll
        for (int j = 0; j < 4; ++j) { v[r][j] = v[r][j] - mean[r]; s2 += (v[r][j][0] * v[r][j][0] + v[r][j][1] * v[r][j][1]) + (v[r][j][2] * v[r][j][2] + v[r][j][3] * v[r][j][3]); }
        rstd[r] = 1.f / sqrtf(wave_sum(s2) * (1.f / D) + 1e-5f); }
#pragma unroll
    for (int j = 0; j < 4; ++j) { const f32x4 gg = *(const f32x4*)(g + 4 * lane + 256 * j), bb = *(const f32x4*)(b + 4 * lane + 256 * j);
#pragma unroll
        for (int r = 0; r < 2; ++r) { const size_t off = (size_t)(r ? m1 : m0) * D + 4 * lane + 256 * j; const f32x4 y = v[r][j] * rstd[r] * gg + bb;
            if (wf) *(f32x4*)(R + off) = y;
            if (XBo) { unsigned long long w = (unsigned long long)pk2(y[0], y[1]) | ((unsigned long long)pk2(y[2], y[3]) << 32); *(unsigned long long*)(XBo + off) = w; } } }
}

#ifndef PH_MASK
#define PH_MASK 0xFFFF
#endif
struct Params { const float* in[25]; float* out; unsigned char* ws; };

__global__ void __launch_bounds__(NWAVES * 64) mega_fwd(Params p) {
    extern __shared__ __attribute__((aligned(16))) unsigned char lds_raw[];
    cg::grid_group grid = cg::this_grid();
    LAS unsigned char* lds = (LAS unsigned char*)lds_raw;
    const int wave = __builtin_amdgcn_readfirstlane((int)threadIdx.x >> 6);
#define PHASE_IDS() int tid_o = threadIdx.x; asm volatile("" : "+v"(tid_o)); const int tid = tid_o, lane = tid & 63; const size_t gt = (size_t)bx * (NWAVES * 64) + tid; (void)lane; (void)gt
    const int G = gridDim.x, bx = blockIdx.x;
    const int gw = bx * NWAVES + wave, NGW = G * NWAVES;
    const size_t NTH = (size_t)G * (NWAVES * 64);
    unsigned char* ws = p.ws;
    const float* x = p.in[0]; const float* mem = p.in[1]; const int* positions = (const int*)p.in[2];
    float* R = p.out;
    float* KMAX = (float*)(ws + WS_RS); float* F2T = (float*)(ws + 1 * MiB); float* RC = (float*)(ws + WS_RC); float* RSN = (float*)(ws + WS_RSN); float* SIDE = (float*)(ws + WS_SIDE);
    bf16_t* MEMB = (bf16_t*)(ws + WS_MEMB); bf16_t* MEMKV = (bf16_t*)(ws + WS_MEMKV);
    bf16_t* WIN = (bf16_t*)(ws + WS_WIN); bf16_t* WUQ = (bf16_t*)(ws + WS_WUQ); bf16_t* WUKV = (bf16_t*)(ws + WS_WUKV); bf16_t* WMKV = (bf16_t*)(ws + WS_WMKV);
    bf16_t* KR = (bf16_t*)(ws + WS_KR); bf16_t* XB = (bf16_t*)(ws + WS_XB); bf16_t* QM = (bf16_t*)(ws + WS_QM); bf16_t* WBR = (bf16_t*)(ws + WS_WBR); bf16_t* WOUT = (bf16_t*)(ws + WS_WOUT);
    bf16_t* HB = (bf16_t*)(ws + WS_H); bf16_t* GB = (bf16_t*)(ws + WS_G); bf16_t* SLOT0 = (bf16_t*)(ws + WS_SLOT0); bf16_t* CQ = SLOT0; bf16_t* CKV = SLOT0 + (size_t)T * 384; bf16_t* FQ = (bf16_t*)(ws + WS_FQ); bf16_t* MQ = (bf16_t*)(ws + WS_MQ);
    bf16_t* FK = (bf16_t*)(ws + WS_FK); bf16_t* FV = (bf16_t*)(ws + WS_FV); bf16_t* KN = (bf16_t*)(ws + WS_KN); bf16_t* VM = (bf16_t*)(ws + WS_VM); bf16_t* MG = (bf16_t*)(ws + WS_MG);
    bf16_t* WA = (bf16_t*)(ws + WS_WA); bf16_t* WD = (bf16_t*)(ws + WS_WD);
    LAS float* scr = (LAS float*)(lds + wave * 16384);
    volatile LAS unsigned* MISC = (volatile LAS unsigned*)(lds + 131072 + 256);
    unsigned* barw = (unsigned*)ws;
    { PHASE_IDS();
      if (tid < 2) MISC[tid] = 0u;
      if (bx == 0) for (int i = tid; i < XCD_BAR_WORDS; i += NWAVES * 64) barw[i] = 0u; }

#if (PH_MASK >> 0) & 1
    { PHASE_IDS();
    tr_mat<1>(p.in[5], D, 2 * FF, nullptr, WA, D, 64, scr, gw, NGW, lane);
    tr_mat<0>(p.in[6], FF, D, nullptr, WD, FF, 64, scr, gw, NGW, lane);
    tr_mat<2>(p.in[7], D, 5800, nullptr, WIN, D, 64, scr, gw, NGW, lane);
    tr_mat<0>(p.in[10], 384, 768, p.in[9], WUQ, 384, 64, scr, gw, NGW, lane);
    tr_mat<0>(p.in[12], 256, 1024, p.in[11], WUKV, 256, 64, scr, gw, NGW, lane);
    tr_mat<0>(p.in[14], D, 1024, nullptr, WMKV, D, 64, scr, gw, NGW, lane);
    for (size_t i = gt * 8; i < (size_t)88 * D; i += NTH * 8) *(u32x4*)(WIN + (size_t)5800 * D + i) = (u32x4){0u, 0u, 0u, 0u};
    if (gt < 32) KMAX[gt] = 0.f;
    cvt_copy(x, XB, (size_t)T * D, gt, NTH);
    cvt_copy(mem, MEMB, (size_t)NB * 256 * D, gt, NTH);
    for (size_t i = gt; i < (size_t)T * 16; i += NTH) {
        const int row = (int)(i >> 4), f = (int)(i & 15);
        const float invf = (float)exp2(-(double)f * (13.287712379549449 / 16.0));
        const float ang = (float)positions[row] * invf;
        const double rev = (double)ang * 0.15915494309189535; const float fr = (float)(rev - __builtin_rint(rev));
        RC[i] = __builtin_amdgcn_cosf(fr); RSN[i] = __builtin_amdgcn_sinf(fr);
    }
    }
#endif
    grid.sync();
    const XcdBarrier xb = xcd_barrier_post(barw, MISC);

#if (PH_MASK >> 1) & 1
    { PHASE_IDS();
    { pg8::Gemm g{XB, WA, T, 2 * FF, D}; pg8::StaticOrder so; so.init(T, 2 * FF, G, bx);
      pg8::EpiSwiglu E{HB, FF}; pg8::gemm_phase<pg8::EpiSwiglu, pg8::StaticOrder, true>(lds, g, so, E); }
    }
#endif
    xcd_barrier(xb);
#if (PH_MASK >> 2) & 1
    { PHASE_IDS();
    { pg8::Gemm g{HB, WD, T, D, FF}; pg8::StaticOrder so; so.init(T, D, G, bx);
      pg8::EpiRes E{x, R, ALPHA, 0.5f}; pg8::gemm_phase<pg8::EpiRes, pg8::StaticOrder, true>(lds, g, so, E); }
    }
#endif
    xcd_barrier(xb);
#if (PH_MASK >> 3) & 1
    { PHASE_IDS();
    for (int m = gw; m < T; m += 2 * NGW) { if (m + NGW < T) ln_rows2(R, m, m + NGW, p.in[3], p.in[4], XB, true, lane); else ln_row(R + (size_t)m * D, p.in[3], p.in[4], R + (size_t)m * D, XB + (size_t)m * D, lane); }
    }
#endif
    xcd_barrier(xb);
#if (PH_MASK >> 4) & 1
    { PHASE_IDS();
    { pg8::Gemm g{XB, WIN, T, NPROJ, D}; pg8::StaticOrder so; so.init(T, NPROJ, G, bx);
      pg8::EpiProj E{GB, FQ, FK, FV, MQ, CQ, CKV, SIDE, p.in[8]}; pg8::gemm_phase<pg8::EpiProj, pg8::StaticOrder, true>(lds, g, so, E); }
    { pg8::Gemm g{MEMB, WMKV, NB * 256, 1024, D}; pg8::StaticOrder so; so.init(NB * 256, 1024, G, (bx + 128) % G);
      pg8::EpiPlain E{MEMKV, 1024, 1.f}; pg8::gemm_phase<pg8::EpiPlain, pg8::StaticOrder, true>(lds, g, so, E); }
    }
#endif
    xcd_barrier(xb);
#if (PH_MASK >> 5) & 1
    { PHASE_IDS();
    if (bx < 32) {
        const int b = bx >> 3, h = bx & 7; LAS double* sh = (LAS double*)lds;
        const float bfh = p.in[13][h]; float lf[16]; double loc = 0.0;
#pragma unroll
        for (int j = 0; j < 16; ++j) { const float xx = SIDE[((size_t)b * S + 16 * tid + j) * 40 + 32 + h] + bfh; lf[j] = fminf(xx, 0.f) - log1pf(__expf(-fabsf(xx))); loc += (double)lf[j]; }
        double incl = loc;
#pragma unroll
        for (int o = 1; o < 64; o <<= 1) { const double v = __shfl_up(incl, o); if (lane >= o) incl += v; }
        if (lane == 63) sh[wave] = incl;
        __syncthreads();
        double run = incl - loc;
        for (int w = 0; w < wave; ++w) run += sh[w];
#pragma unroll
        for (int j = 0; j < 16; ++j) { run += (double)lf[j];
            const float f2 = (float)(run * 1.4426950408889634);
            F2T[(size_t)bx * S + 16 * tid + j] = f2; }
        __syncthreads();
    }
    float kmrun = 0.f; int curb = gw >> 13;
    for (int m0 = gw; m0 < T; m0 += 2 * NGW) {
        u32x4 kraw[2], qraw[2], vraw[2]; float x1[2], x2[2], cc[2], ss[2]; bool has[2];
#pragma unroll
        for (int r = 0; r < 2; ++r) { const int m = m0 + r * NGW; has[r] = m < T; const size_t mm = has[r] ? (size_t)m : (size_t)m0;
            kraw[r] = *(const u32x4*)(FK + mm * 512 + lane * 8);
            qraw[r] = (lane < 48) ? *(const u32x4*)(CQ + mm * 384 + lane * 8) : (u32x4){0u, 0u, 0u, 0u};
            vraw[r] = (lane < 32) ? *(const u32x4*)(CKV + mm * 256 + lane * 8) : (u32x4){0u, 0u, 0u, 0u};
            x1[r] = 0.f; x2[r] = 0.f; cc[r] = 0.f; ss[r] = 0.f;
            if (lane < 16) { x1[r] = SIDE[mm * 40 + lane]; x2[r] = SIDE[mm * 40 + 16 + lane]; cc[r] = RC[mm * 16 + lane]; ss[r] = RSN[mm * 16 + lane]; } }
#pragma unroll
        for (int r = 0; r < 2; ++r) { if (!has[r]) continue;
            const int m = m0 + r * NGW; const int bb = m >> 13;
            if (bb != curb) { if ((lane & 7) == 0) atomicMax((unsigned*)KMAX + curb * 8 + (lane >> 3), __float_as_uint(kmrun)); kmrun = 0.f; curb = bb; }
            f32x4 k0, k1; pg8::unpack8(kraw[r], k0, k1); float ks = 0.f;
#pragma unroll
            for (int i = 0; i < 4; ++i) ks += k0[i] * k0[i] + k1[i] * k1[i];
            ks += __shfl_xor(ks, 1); ks += __shfl_xor(ks, 2); ks += __shfl_xor(ks, 4);
            kmrun = fmaxf(kmrun, ks);
            f32x4 a0, a1, c0, c1; float sq = 0.f, sq2 = 0.f;
            pg8::unpack8(qraw[r], a0, a1); pg8::unpack8(vraw[r], c0, c1);
#pragma unroll
            for (int i = 0; i < 4; ++i) { sq += a0[i] * a0[i] + a1[i] * a1[i]; sq2 += c0[i] * c0[i] + c1[i] * c1[i]; }
            const float rq = 1.f / sqrtf(wave_sum(sq) * (1.f / 384.f) + 1e-6f), rkv = 1.f / sqrtf(wave_sum(sq2) * (1.f / 256.f) + 1e-6f);
            if (lane < 48) *(u32x4*)(CQ + (size_t)m * 384 + lane * 8) = pg8::pack8(a0 * rq, a1 * rq);
            if (lane < 32) *(u32x4*)(CKV + (size_t)m * 256 + lane * 8) = pg8::pack8(c0 * rkv, c1 * rkv);
            if (lane < 16) { KR[(size_t)m * 32 + lane] = (bf16_t)f2bf(x1[r] * cc[r] - x2[r] * ss[r]); KR[(size_t)m * 32 + 16 + lane] = (bf16_t)f2bf(x2[r] * cc[r] + x1[r] * ss[r]); } }
    }
    if ((lane & 7) == 0) atomicMax((unsigned*)KMAX + curb * 8 + (lane >> 3), __float_as_uint(kmrun));
    tr_mat<0>(p.in[15], 512, D, nullptr, WBR, 512, 64, scr, gw, NGW, lane);
    tr_mat<0>(p.in[16], 512, D, nullptr, WBR + (size_t)1024 * 512, 512, 64, scr, gw, NGW, lane);
    tr_mat<0>(p.in[17], 512, D, nullptr, WBR + (size_t)2048 * 512, 512, 64, scr, gw, NGW, lane);
    tr_mat<0>(p.in[18], D, D, nullptr, WOUT, D, 64, scr, gw, NGW, lane);
    __syncthreads();
    for (int u = bx; u < NB * 4 * 32; u += G) {
        const int b = u >> 7, hm = (u >> 5) & 3, qb = u & 31;
        att::Args a{MQ + hm * 128, 512, MEMKV + hm * 128, 1024, MEMKV + hm * 128 + 64, 1024, MEMKV + 512 + hm * 128, 1024, MQ + hm * 128, 512, nullptr, nullptr, nullptr, 0.f};
        att::attn_unit<8, 4, false, false, 1, false>(a, (long)b * S + qb * 256, (long)b * 256, 0, 4, lds);
    }
    }
#endif
    xcd_barrier(xb);
#if (PH_MASK >> 6) & 1
    { PHASE_IDS();
    for (int u = bx; u < 512; u += G) {
        const int v = u & 255, i = u >> 8, vcu = (v & 7) * 32 + (v >> 3), bh = vcu >> 3, s = vcu & 7;
        const int qb = (i == 0) ? s : 15 - s; const int b = bh >> 3, h = bh & 7;
        att::Args a{FQ + h * 64, 512, FK + h * 64, 512, nullptr, 0, FV + h * 64, 512, FQ + h * 64, 512, nullptr, nullptr, F2T + (size_t)bh * S, sqrtf(KMAX[bh]) * 1.001f};
        att::attn_unit<5, 2, true, false, 2, true>(a, (long)b * S + qb * 512, (long)b * S, qb * 512, 8 * (qb + 1), lds);
    }
    }
#endif
    xcd_barrier(xb);
#if (PH_MASK >> 7) & 1
    { PHASE_IDS();
    { pg8::Gemm g{CQ, WUQ, T, 768, 384}; pg8::StaticOrder so; so.init(T, 768, G, bx);
      pg8::EpiPlain E{QM, 768, 0.10206207261596577f * pg8::LOG2E}; pg8::gemm_phase<pg8::EpiPlain, pg8::StaticOrder, true>(lds, g, so, E); }
    { pg8::Gemm g{CKV, WUKV, T, 1024, 256}; pg8::StaticOrder so; so.init(T, 1024, G, bx);
      pg8::EpiKvup E{KN, VM}; pg8::gemm_phase<pg8::EpiKvup, pg8::StaticOrder, true>(lds, g, so, E); }
    }
#endif
    xcd_barrier(xb);
#if (PH_MASK >> 8) & 1
    { PHASE_IDS();
    for (int u = bx; u < 512; u += G) {
        const int v = u & 255, i = u >> 8, vcu = (v & 7) * 32 + (v >> 3), bh = vcu >> 3, s = vcu & 7;
        const int qb = (i == 0) ? s : 15 - s; const int b = bh >> 3, h = bh & 7;
        att::Args a{QM + h * 96, 768, KN + h * 64, 512, KR, 32, VM + h * 64, 512, SLOT0 + h * 64, 512, RC, RSN, nullptr, 0.f};
        att::attn_unit<6, 2, true, true, 2, false>(a, (long)b * S + qb * 512, (long)b * S, qb * 512, 8 * (qb + 1), lds);
    }
    }
#endif
    xcd_barrier(xb);
#if (PH_MASK >> 9) & 1
    { PHASE_IDS();
    { pg8::Gemm g{SLOT0, WBR, T, D, 512}; pg8::SegOrder so; so.init(T, D, G, bx, (int)((WS_FQ - WS_SLOT0) / ATILE), (int)((WS_MQ - WS_SLOT0) / ATILE));
      pg8::EpiBranch E{GB, MG}; pg8::gemm_phase<pg8::EpiBranch, pg8::SegOrder, true>(lds, g, so, E); }
    }
#endif
    xcd_barrier(xb);
#if (PH_MASK >> 10) & 1
    { PHASE_IDS();
    { pg8::Gemm g{MG, WOUT, T, D, D}; pg8::StaticOrder so; so.init(T, D, G, bx);
      pg8::EpiRes E{R, R, ALPHA, 1.f}; pg8::gemm_phase<pg8::EpiRes, pg8::StaticOrder, true>(lds, g, so, E); }
    }
#endif
    xcd_barrier(xb);
#if (PH_MASK >> 11) & 1
    { PHASE_IDS();
    for (int m = gw; m < T; m += 2 * NGW) { if (m + NGW < T) ln_rows2(R, m, m + NGW, p.in[19], p.in[20], XB, true, lane); else ln_row(R + (size_t)m * D, p.in[19], p.in[20], R + (size_t)m * D, XB + (size_t)m * D, lane); }
    tr_mat<1>(p.in[21], D, 2 * FF, nullptr, WA, D, 64, scr, gw, NGW, lane);
    tr_mat<0>(p.in[22], FF, D, nullptr, WD, FF, 64, scr, gw, NGW, lane);
    }
#endif
    xcd_barrier(xb);
#if (PH_MASK >> 12) & 1
    { PHASE_IDS();
    { pg8::Gemm g{XB, WA, T, 2 * FF, D}; pg8::StaticOrder so; so.init(T, 2 * FF, G, bx);
      pg8::EpiSwiglu E{HB, FF}; pg8::gemm_phase<pg8::EpiSwiglu, pg8::StaticOrder, true>(lds, g, so, E); }
    }
#endif
    xcd_barrier(xb);
#if (PH_MASK >> 13) & 1
    { PHASE_IDS();
    { pg8::Gemm g{HB, WD, T, D, FF}; pg8::StaticOrder so; so.init(T, D, G, bx);
      pg8::EpiRes E{R, R, ALPHA, 0.5f}; pg8::gemm_phase<pg8::EpiRes, pg8::StaticOrder, true>(lds, g, so, E); }
    }
#endif
    xcd_barrier(xb);
#if (PH_MASK >> 14) & 1
    { PHASE_IDS();
    for (int m = gw; m < T; m += 2 * NGW) { if (m + NGW < T) ln_rows2(R, m, m + NGW, p.in[23], p.in[24], nullptr, true, lane); else ln_row(R + (size_t)m * D, p.in[23], p.in[24], R + (size_t)m * D, nullptr, lane); }
    }
#endif
}

extern "C" void kernel_launch(void* const* d_in, const int* in_sizes, int n_in, void* d_out, int out_size, void* d_ws, size_t ws_size, hipStream_t stream) {
    static int grid = 0;
    if (grid == 0) {
        if (n_in != 25 || out_size != T * D || ws_size < WS_END) { fprintf(stderr, "kernel_launch: unexpected shapes (n_in %d out %d ws %zu)\n", n_in, out_size, ws_size); grid = -1; return; }
        int dev = 0, cus = 0, per = 0;
        (void)hipGetDevice(&dev); (void)hipDeviceGetAttribute(&cus, hipDeviceAttributeMultiprocessorCount, dev);
        (void)hipFuncSetAttribute((const void*)mega_fwd, hipFuncAttributeMaxDynamicSharedMemorySize, LDS_BYTES);
        (void)hipOccupancyMaxActiveBlocksPerMultiprocessor(&per, (const void*)mega_fwd, NWAVES * 64, LDS_BYTES);
        if (per < 1) per = 1;
        grid = cus * per;
        fprintf(stderr, "kernel_launch: grid %d (cus %d x %d), ws %zu\n", grid, cus, per, ws_size);
    }
    if (grid < 0) return;
    Params p{};
    for (int i = 0; i < 25; ++i) p.in[i] = (const float*)d_in[i];
    p.out = (float*)d_out; p.ws = (unsigned char*)d_ws;
    void* args[] = {&p};
    const hipError_t e = hipLaunchCooperativeKernel((const void*)mega_fwd, dim3(grid), dim3(NWAVES * 64), args, LDS_BYTES, stream);
    if (e != hipSuccess) fprintf(stderr, "kernel_launch: cooperative launch failed: %s (grid %d)\n", hipGetErrorString(e), grid);
}
```

```cpp
#include <hip/hip_runtime.h>
#include <hip/hip_cooperative_groups.h>
#include <cstdio>
#include <cstdint>
#include <cmath>
namespace cg = cooperative_groups;
__device__ __forceinline__ float shx(float v, int o, int lane) { return __int_as_float(__builtin_amdgcn_ds_bpermute((lane ^ o) << 2, __float_as_int(v))); }
__device__ __forceinline__ double shup_d(double v, int o, int lane) { const int src = (lane - o) << 2; const long long b = __double_as_longlong(v);
    const int lo = __builtin_amdgcn_ds_bpermute(src, (int)b), hi = __builtin_amdgcn_ds_bpermute(src, (int)(b >> 32)); return __longlong_as_double(((long long)hi << 32) | (unsigned)lo); }
__device__ __forceinline__ int wg_tid(int wave) { int l; asm volatile("v_mbcnt_lo_u32_b32 %0, -1, 0\n\tv_mbcnt_hi_u32_b32 %0, -1, %0" : "=v"(l)); return wave * 64 + l; }
namespace pg8 {
#define PG8_LAS __attribute__((address_space(3)))
typedef unsigned short bf16_t;
typedef short bf16x8 __attribute__((ext_vector_type(8)));
typedef float f32x4 __attribute__((ext_vector_type(4)));
typedef unsigned u32x4 __attribute__((ext_vector_type(4)));
constexpr int BM = 256, BK = 64, HALF = 128, HTB = HALF * BK * 2  , STAGE_BYTES = 8 * HTB, NXCD = 8, WGM = 8;

__host__ __device__ __forceinline__ int lds_byte(int r, int c) { const int st = (r >> 4) * 2 + (c >> 5), rr = r & 15, cc = c & 31, ob = rr * 64 + cc * 2; return st * 1024 + (ob ^ (((ob >> 9) & 1) << 5)); }
__host__ __device__ __forceinline__ void stage_rc(int b, int& R, int& C) { const int st = b / 1024, sb = b % 1024, swz = sb ^ (((sb >> 9) & 1) << 5); R = (st >> 1) * 16 + swz / 64; C = (st & 1) * 32 + (swz % 64) / 2; }
__host__ __device__ __forceinline__ int perm32(int rho) { const int n = rho >> 4, i = rho & 15; return 8 * (i >> 2) + 4 * n + (i & 3); }

struct Unit { int pm, pn, am, bn, seg; };
struct Gemm { const bf16_t* A; const bf16_t* Bt; int M, N, K; };

struct StaticOrder {
    int nM, nN, nwg, G, c;
    __host__ __device__ void init(int M, int N, int G_, int c_) { nM = M / BM; nN = N / BM; nwg = nM * nN; G = G_; c = c_; }
    __host__ __device__ bool next(int i, Unit& u) const {
        const long L = (long)i * G + c; if (L >= nwg) return false;
        int wgid = (int)L; { const int q = nwg / NXCD, r = nwg % NXCD, xcd = wgid % NXCD, off = wgid / NXCD; wgid = (xcd < r ? xcd * (q + 1) : r * (q + 1) + (xcd - r) * q) + off; }
        const int nig = WGM * nN, gid = wgid / nig, fm = gid * WGM, gsz = (nM - fm) < WGM ? (nM - fm) : WGM;
        u.pm = fm + ((wgid % nig) % gsz); u.pn = (wgid % nig) / gsz; u.am = u.pm; u.bn = u.pn; u.seg = 0; return true;
    }
};

__device__ __forceinline__ unsigned cvt_pk_bf16(float lo, float hi) { unsigned r; asm volatile("v_cvt_pk_bf16_f32 %0, %1, %2" : "=v"(r) : "v"(lo), "v"(hi)); return r; }
typedef float f32x2 __attribute__((ext_vector_type(2)));
template <class Epi, class Sched, bool ALIGN_EPI = false, bool SP2 = true>
__device__ __forceinline__ void gemm_phase(PG8_LAS unsigned char* lds, const Gemm g, const Sched& S, const Epi& E, const int wave_in_wg) {
    int tid_ = wg_tid(wave_in_wg); asm volatile("" : "+v"(tid_));
    const int tid = tid_, wid = __builtin_amdgcn_readfirstlane(tid >> 6), lane = tid & 63, wr = wid >> 2, wc = wid & 3, fr = lane & 15, fq = lane >> 4;
    const int K = g.K, nt = K / BK;
    unsigned voffA[2], voffB[2];
#pragma unroll
    for (int i = 0; i < 2; ++i) { int R, C; stage_rc(tid * 16 + i * 8192, R, C); const int Rb = Epi::PERM ? ((R & ~31) + perm32(R & 31)) : R;
        voffA[i] = (unsigned)(R * K + C) * 2u; voffB[i] = (unsigned)(Rb * K + C) * 2u; }
    const size_t kstep = (size_t)(BK * 2);
    const size_t hstep = (size_t)HALF * K * 2;
    const size_t tstep = 2 * hstep;
    const unsigned ldsw = (unsigned)wid * 1024u;
    const int aoff = lds_byte(wr * 64 + fr, fq * 8), boff = lds_byte(wc * 32 + fr, fq * 8);
#define PG8_SA(b, h) (((b) * 2 + (h)) * HTB)
#define PG8_SB(b, h) ((4 + (b) * 2 + (h)) * HTB)
#define PG8_STAGE(bufoff, gbase, voff) do { _Pragma("unroll") for (int _i = 0; _i < 2; ++_i) \
        __builtin_amdgcn_global_load_lds((const unsigned*)((const char*)(gbase) + (voff)[_i]), (PG8_LAS unsigned*)(lds + (bufoff) + ldsw + _i * 8192), 16, 0, 0); } while (0)
#define PG8_LDA(dst, b, h) do { _Pragma("unroll") for (int m = 0; m < 4; ++m) _Pragma("unroll") for (int k = 0; k < 2; ++k) dst[m][k] = *(const PG8_LAS bf16x8*)(lds + PG8_SA(b, h) + aoff + m * 2048 + k * 1024); } while (0)
#define PG8_LDB(dst, b, h) do { _Pragma("unroll") for (int n = 0; n < 2; ++n) _Pragma("unroll") for (int k = 0; k < 2; ++k) dst[n][k] = *(const PG8_LAS bf16x8*)(lds + PG8_SB(b, h) + boff + n * 2048 + k * 1024); } while (0)
#define PG8_MMA(ai, bj, At, Bt) do { __builtin_amdgcn_s_setprio(1); _Pragma("unroll") for (int m = 0; m < 4; ++m) _Pragma("unroll") for (int n = 0; n < 2; ++n) _Pragma("unroll") for (int k = 0; k < 2; ++k) \
        acc[ai][bj][m][n] = __builtin_amdgcn_mfma_f32_16x16x32_bf16(Bt[n][k], At[m][k], acc[ai][bj][m][n], 0, 0, 0); __builtin_amdgcn_s_setprio(0); } while (0)
#define PG8_WAIT_V(n) asm volatile("s_waitcnt vmcnt(" #n ")" ::: "memory")
#define PG8_WAIT_L(n) asm volatile("s_waitcnt lgkmcnt(" #n ")" ::: "memory")
#define PG8_BAR __builtin_amdgcn_s_barrier()
#define PG8_SCHED __builtin_amdgcn_sched_barrier(0)
    Unit cur, nxt; int ui = 0;
    if (!S.next(0, cur)) return;
    f32x4 acc[2][2][4][2];
#pragma unroll
    for (int a = 0; a < 2; ++a)
#pragma unroll
        for (int b = 0; b < 2; ++b)
#pragma unroll
            for (int m = 0; m < 4; ++m)
#pragma unroll
                for (int n = 0; n < 2; ++n) acc[a][b][m][n] = (f32x4){0.f, 0.f, 0.f, 0.f};
    bf16x8 At[4][2], B0[2][2], B1[2][2];
    const char* cA = (const char*)g.A + (size_t)cur.am * tstep; const char* cB = (const char*)g.Bt + (size_t)cur.bn * tstep;
    if constexpr (SP2) {
        PG8_STAGE(PG8_SB(0, 0), cB, voffB); PG8_STAGE(PG8_SB(0, 1), cB + hstep, voffB); PG8_STAGE(PG8_SA(0, 0), cA, voffA); PG8_STAGE(PG8_SA(0, 1), cA + hstep, voffA);
        if (wr == 1) PG8_BAR;
        PG8_WAIT_V(2); PG8_BAR;
        PG8_STAGE(PG8_SB(1, 0), cB + kstep, voffB); PG8_STAGE(PG8_SA(1, 0), cA + kstep, voffA); PG8_STAGE(PG8_SB(1, 1), cB + hstep + kstep, voffB);
        PG8_WAIT_V(6); PG8_BAR;
    } else {
        PG8_STAGE(PG8_SB(0, 0), cB, voffB); PG8_STAGE(PG8_SA(0, 0), cA, voffA); PG8_STAGE(PG8_SB(0, 1), cB + hstep, voffB); PG8_STAGE(PG8_SA(0, 1), cA + hstep, voffA);
        if (wr == 1) PG8_BAR;
        PG8_WAIT_V(4); PG8_BAR;
        PG8_STAGE(PG8_SB(1, 0), cB + kstep, voffB); PG8_STAGE(PG8_SA(1, 0), cA + kstep, voffA); PG8_STAGE(PG8_SB(1, 1), cB + hstep + kstep, voffB);
        PG8_WAIT_V(6); PG8_BAR;
    }
    for (;;) {
        const bool has_next = S.next(ui + 1, nxt);
        const char* nA = has_next ? (const char*)g.A + (size_t)nxt.am * tstep : cA; const char* nB = has_next ? (const char*)g.Bt + (size_t)nxt.bn * tstep : cB;
#pragma nounroll
        for (int t = 0; t < nt; t += 2) {
            const bool last = (t == nt - 2);
            const char* a1 = cA + (size_t)(t + 1) * kstep;
            const char* a2 = last ? nA : cA + (size_t)(t + 2) * kstep; const char* b2 = last ? nB : cB + (size_t)(t + 2) * kstep;
            const char* a3 = a2 + kstep; const char* b3 = b2 + kstep;
            if constexpr (SP2) {
            PG8_LDB(B0, 0, 0); PG8_LDB(B1, 0, 1); PG8_SCHED; PG8_LDA(At, 0, 0); PG8_STAGE(PG8_SA(1, 1), a1 + hstep, voffA);
            PG8_WAIT_V(8); PG8_WAIT_L(0); PG8_BAR; PG8_MMA(0, 0, At, B0); PG8_MMA(0, 1, At, B1); PG8_BAR; PG8_SCHED;
            PG8_LDA(At, 0, 1); PG8_STAGE(PG8_SB(0, 0), b2, voffB); PG8_STAGE(PG8_SB(0, 1), b2 + hstep, voffB); PG8_STAGE(PG8_SA(0, 0), a2, voffA);
            PG8_WAIT_V(8); PG8_WAIT_L(0); PG8_BAR; PG8_MMA(1, 0, At, B0); PG8_MMA(1, 1, At, B1); PG8_BAR; PG8_SCHED;
            PG8_LDB(B0, 1, 0); PG8_LDB(B1, 1, 1); PG8_SCHED; PG8_LDA(At, 1, 0); PG8_STAGE(PG8_SA(0, 1), a2 + hstep, voffA);
            PG8_WAIT_V(8); PG8_WAIT_L(0); PG8_BAR; PG8_MMA(0, 0, At, B0); PG8_MMA(0, 1, At, B1); PG8_BAR; PG8_SCHED;
            PG8_LDA(At, 1, 1); PG8_STAGE(PG8_SB(1, 0), b3, voffB); PG8_STAGE(PG8_SB(1, 1), b3 + hstep, voffB); PG8_STAGE(PG8_SA(1, 0), a3, voffA);
            PG8_WAIT_V(8); PG8_WAIT_L(0); PG8_BAR; PG8_MMA(1, 0, At, B0); PG8_MMA(1, 1, At, B1); PG8_BAR; PG8_SCHED;
            } else {
            PG8_LDB(B0, 0, 0); PG8_SCHED; PG8_LDA(At, 0, 0); PG8_STAGE(PG8_SA(1, 1), a1 + hstep, voffA);
            PG8_WAIT_L(8); PG8_BAR; PG8_WAIT_L(0); PG8_MMA(0, 0, At, B0); PG8_BAR; PG8_SCHED;
            PG8_LDB(B1, 0, 1); PG8_STAGE(PG8_SB(0, 0), b2, voffB);
            PG8_BAR; PG8_WAIT_L(0); PG8_MMA(0, 1, At, B1); PG8_BAR;
            PG8_LDA(At, 0, 1); PG8_STAGE(PG8_SA(0, 0), a2, voffA);
            PG8_BAR; PG8_WAIT_L(0); PG8_MMA(1, 0, At, B0); PG8_BAR; PG8_SCHED;
            PG8_STAGE(PG8_SB(0, 1), b2 + hstep, voffB);
            PG8_WAIT_V(6); PG8_BAR; PG8_MMA(1, 1, At, B1); PG8_BAR;
            PG8_LDB(B0, 1, 0); PG8_SCHED; PG8_LDA(At, 1, 0); PG8_STAGE(PG8_SA(0, 1), a2 + hstep, voffA);
            PG8_WAIT_L(8); PG8_BAR; PG8_WAIT_L(0); PG8_MMA(0, 0, At, B0); PG8_BAR; PG8_SCHED;
            PG8_LDB(B1, 1, 1); PG8_STAGE(PG8_SB(1, 0), b3, voffB);
            PG8_BAR; PG8_WAIT_L(0); PG8_MMA(0, 1, At, B1); PG8_BAR;
            PG8_LDA(At, 1, 1); PG8_STAGE(PG8_SA(1, 0), a3, voffA);
            PG8_BAR; PG8_WAIT_L(0); PG8_MMA(1, 0, At, B0); PG8_BAR; PG8_SCHED;
            PG8_STAGE(PG8_SB(1, 1), b3 + hstep, voffB);
            PG8_WAIT_V(6); PG8_BAR; PG8_MMA(1, 1, At, B1); PG8_BAR;
            }
        }
        if constexpr (ALIGN_EPI) { if (wr == 0) PG8_BAR; }
        E(acc, cur, wr, wc, fr, fq);
        if (!has_next) break;
        if (!Epi::keep(cur)) {
#pragma unroll
        for (int a = 0; a < 2; ++a)
#pragma unroll
            for (int b = 0; b < 2; ++b)
#pragma unroll
                for (int m = 0; m < 4; ++m)
#pragma unroll
                    for (int n = 0; n < 2; ++n) acc[a][b][m][n] = (f32x4){0.f, 0.f, 0.f, 0.f};
        }
        cur = nxt; cA = nA; cB = nB; ++ui;
        if constexpr (ALIGN_EPI) { if (wr == 1) PG8_BAR; }
    }
    PG8_WAIT_V(0);
    if constexpr (!ALIGN_EPI) { if (wr == 0) PG8_BAR; }
    PG8_BAR;
#undef PG8_SA
#undef PG8_SB
#undef PG8_STAGE
#undef PG8_LDA
#undef PG8_LDB
#undef PG8_MMA
#undef PG8_WAIT_V
#undef PG8_WAIT_L
#undef PG8_BAR
#undef PG8_SCHED
}

struct SegOrder {
    StaticOrder b; int a1, a2, bN;
    __device__ void init(int M, int N, int G_, int c_, int a1_, int a2_) { b.init(M, N, G_, c_); a1 = a1_; a2 = a2_; bN = N / BM; }
    __device__ bool next(int i, Unit& u) const { if (!b.next(i / 3, u)) return false; const int s = i % 3; u.seg = s; u.am = u.pm + (s == 0 ? 0 : (s == 1 ? a1 : a2)); u.bn = u.pn + s * bN; return true; }
};

constexpr float LOG2E = 1.4426950408889634f;
__device__ __forceinline__ float sigm(float x) { return __builtin_amdgcn_rcpf(1.f + __expf(-x)); }
__device__ __forceinline__ u32x4 pack8(const f32x4 v0, const f32x4 v1) { u32x4 w; w.x = cvt_pk_bf16(v0[0], v0[1]); w.y = cvt_pk_bf16(v0[2], v0[3]); w.z = cvt_pk_bf16(v1[0], v1[1]); w.w = cvt_pk_bf16(v1[2], v1[3]); return w; }
__device__ __forceinline__ void unpack8(const u32x4 w, f32x4& v0, f32x4& v1) {
    v0[0] = __uint_as_float(w.x << 16); v0[1] = __uint_as_float(w.x & 0xffff0000u); v0[2] = __uint_as_float(w.y << 16); v0[3] = __uint_as_float(w.y & 0xffff0000u);
    v1[0] = __uint_as_float(w.z << 16); v1[1] = __uint_as_float(w.z & 0xffff0000u); v1[2] = __uint_as_float(w.w << 16); v1[3] = __uint_as_float(w.w & 0xffff0000u); }

struct EpiPlain {
    static constexpr bool PERM = true; static __device__ __forceinline__ bool keep(const Unit&) { return false; }
    bf16_t* O; int ldc; float sc;
    __device__ __forceinline__ void operator()(f32x4 (&acc)[2][2][4][2], const Unit& u, int wr, int wc, int fr, int fq) const {
        const int row0 = u.pm * BM + wr * 64 + fr, col0 = u.pn * BM + wc * 32 + 8 * fq;
#pragma unroll
        for (int ai = 0; ai < 2; ++ai)
#pragma unroll
            for (int m = 0; m < 4; ++m) { bf16_t* rowp = O + (size_t)(row0 + ai * HALF + m * 16) * ldc + col0;
#pragma unroll
                for (int bj = 0; bj < 2; ++bj) *(u32x4*)(rowp + bj * HALF) = pack8(acc[ai][bj][m][0] * sc, acc[ai][bj][m][1] * sc); }
    }
};
struct EpiSwiglu {
    static constexpr bool PERM = true; static __device__ __forceinline__ bool keep(const Unit&) { return false; }
    bf16_t* H; int ldh;
    __device__ __forceinline__ void operator()(f32x4 (&acc)[2][2][4][2], const Unit& u, int wr, int wc, int fr, int fq) const {
        const int row0 = u.pm * BM + wr * 64 + fr, col0 = u.pn * HALF + wc * 32 + 8 * fq;
#pragma unroll
        for (int ai = 0; ai < 2; ++ai)
#pragma unroll
            for (int m = 0; m < 4; ++m) {
                f32x4 v0, v1;
#pragma unroll
                for (int i = 0; i < 4; ++i) { const float a0 = acc[ai][0][m][0][i], a1 = acc[ai][0][m][1][i];
                    v0[i] = a0 * sigm(a0) * acc[ai][1][m][0][i]; v1[i] = a1 * sigm(a1) * acc[ai][1][m][1][i]; }
                *(u32x4*)(H + (size_t)(row0 + ai * HALF + m * 16) * ldh + col0) = pack8(v0, v1); }
    }
};
struct EpiRes {
    static constexpr bool PERM = false; static __device__ __forceinline__ bool keep(const Unit&) { return false; }
    const float* res; float* out; float alpha, beta;
    __device__ __forceinline__ void operator()(f32x4 (&acc)[2][2][4][2], const Unit& u, int wr, int wc, int fr, int fq) const {
        const int row0 = u.pm * BM + wr * 64 + fr, col0 = u.pn * BM + wc * 32 + 4 * fq;
#pragma unroll
        for (int ai = 0; ai < 2; ++ai)
#pragma unroll
            for (int m = 0; m < 4; ++m) { const size_t off = (size_t)(row0 + ai * HALF + m * 16) * 1024 + col0;
#pragma unroll
                for (int bj = 0; bj < 2; ++bj)
#pragma unroll
                    for (int n = 0; n < 2; ++n) { const f32x4 r = *(const f32x4*)(res + off + bj * HALF + n * 16); *(f32x4*)(out + off + bj * HALF + n * 16) = r * alpha + acc[ai][bj][m][n] * beta; } }
    }
};
struct EpiProj {
    static constexpr bool PERM = true; static __device__ __forceinline__ bool keep(const Unit&) { return false; }
    bf16_t *G, *FQ, *FK, *FV, *MQ, *CQ, *CKV; float* SIDE; const float* bgate;
    __device__ __forceinline__ void operator()(f32x4 (&acc)[2][2][4][2], const Unit& u, int wr, int wc, int fr, int fq) const {
        const int row0 = u.pm * BM + wr * 64 + fr, pn = u.pn;
#pragma unroll
        for (int bj = 0; bj < 2; ++bj) {
            const int col = pn * BM + bj * HALF + wc * 32 + 8 * fq;
            bf16_t* base; int ld, dcol; float sc = 1.f; bool gate = false;
            if (pn < 12) { base = G; ld = 3072; dcol = col; gate = true; }
            else if (pn < 14) { base = FQ; ld = 512; dcol = col - 3072; sc = 0.125f * LOG2E; }
            else if (pn < 16) { base = FK; ld = 512; dcol = col - 3584; }
            else if (pn < 18) { base = FV; ld = 512; dcol = col - 4096; }
            else if (pn < 20) { base = MQ; ld = 512; dcol = col - 4608; sc = 0.08838834764831845f * LOG2E; }
            else { const int bc = col - 5120;
                if (bc < 384) { base = CQ; ld = 384; dcol = bc; } else if (bc < 640) { base = CKV; ld = 256; dcol = bc - 384; } else { base = nullptr; ld = 0; dcol = bc; } }
            f32x4 b0 = (f32x4){0.f, 0.f, 0.f, 0.f}, b1 = b0;
            if (gate) { b0 = *(const f32x4*)(bgate + col); b1 = *(const f32x4*)(bgate + col + 4); }
            const bool side = (pn == 22) && (bj == 1) && (wc == 0 || (wc == 1 && fq == 0));
#pragma unroll
            for (int ai = 0; ai < 2; ++ai)
#pragma unroll
                for (int m = 0; m < 4; ++m) { const size_t row = (size_t)(row0 + ai * HALF + m * 16);
                    f32x4 v0 = acc[ai][bj][m][0], v1 = acc[ai][bj][m][1];
                    if (gate) {
#pragma unroll
                        for (int i = 0; i < 4; ++i) { v0[i] = sigm(v0[i] + b0[i]); v1[i] = sigm(v1[i] + b1[i]); } }
                    else { v0 = v0 * sc; v1 = v1 * sc; }
                    if (base) *(u32x4*)(base + row * ld + dcol) = pack8(v0, v1);
                    if (side) { float* sp = SIDE + row * 40 + (dcol - 640); *(f32x4*)sp = v0; *(f32x4*)(sp + 4) = v1; } }
        }
    }
};
struct EpiKvup {
    static constexpr bool PERM = true; static __device__ __forceinline__ bool keep(const Unit&) { return false; }
    bf16_t* KN; bf16_t* VM; float* NK2;
    __device__ __forceinline__ void operator()(f32x4 (&acc)[2][2][4][2], const Unit& u, int wr, int wc, int fr, int fq) const {
        const int row0 = u.pm * BM + wr * 64 + fr; bf16_t* base = ((wc < 2) ? KN : VM) + (2 * u.pn) * 64 + (wc & 1) * 32 + 8 * fq;
#pragma unroll
        for (int ai = 0; ai < 2; ++ai)
#pragma unroll
            for (int m = 0; m < 4; ++m) { const size_t row = (size_t)(row0 + ai * HALF + m * 16); bf16_t* rowp = base + row * 512;
#pragma unroll
                for (int bj = 0; bj < 2; ++bj) { const f32x4 v0 = acc[ai][bj][m][0], v1 = acc[ai][bj][m][1];
                    *(u32x4*)(rowp + bj * 64) = pack8(v0, v1);
                    if (wc < 2) { float sq = (v0[0] * v0[0] + v0[1] * v0[1]) + (v0[2] * v0[2] + v0[3] * v0[3]) + (v1[0] * v1[0] + v1[1] * v1[1]) + (v1[2] * v1[2] + v1[3] * v1[3]);
                        sq += shx(sq, 16, fq * 16 + fr); sq += shx(sq, 32, fq * 16 + fr);
                        if (fq == 0) atomicAdd(NK2 + row * 8 + 2 * u.pn + bj, sq); } }
                asm volatile("" ::: "memory"); }
    }
};
struct EpiBranch {
    static constexpr bool PERM = true; static __device__ __forceinline__ bool keep(const Unit& u) { return u.seg < 2; }
    const bf16_t* G; bf16_t* MG;
    __device__ __forceinline__ void operator()(f32x4 (&acc)[2][2][4][2], const Unit& u, int wr, int wc, int fr, int fq) const {
        const int row0 = u.pm * BM + wr * 64 + fr, col0 = u.pn * BM + wc * 32 + 8 * fq, seg = u.seg;
#pragma unroll
        for (int ai = 0; ai < 2; ++ai)
#pragma unroll
            for (int m = 0; m < 4; ++m) { const size_t row = (size_t)(row0 + ai * HALF + m * 16);
#pragma unroll
                for (int bj = 0; bj < 2; ++bj) { const int col = col0 + bj * HALF;
                    f32x4 ga0, ga1; unpack8(*(const u32x4*)(G + row * 3072 + seg * 1024 + col), ga0, ga1);
                    if (seg < 2) { f32x4 gb0, gb1; unpack8(*(const u32x4*)(G + row * 3072 + (seg + 1) * 1024 + col), gb0, gb1);
#pragma unroll
                        for (int i = 0; i < 4; ++i) { acc[ai][bj][m][0][i] *= fmaxf(ga0[i], 1e-30f) * __builtin_amdgcn_rcpf(fmaxf(gb0[i], 1e-30f)); acc[ai][bj][m][1][i] *= fmaxf(ga1[i], 1e-30f) * __builtin_amdgcn_rcpf(fmaxf(gb1[i], 1e-30f)); } }
                    else { f32x4 v0, v1;
#pragma unroll
                        for (int i = 0; i < 4; ++i) { v0[i] = acc[ai][bj][m][0][i] * fmaxf(ga0[i], 1e-30f); v1[i] = acc[ai][bj][m][1][i] * fmaxf(ga1[i], 1e-30f); }
                        *(u32x4*)(MG + row * 1024 + col) = pack8(v0, v1); } } }
    }
};
}

namespace att {
using pg8::bf16_t;
typedef short bf16x8 __attribute__((ext_vector_type(8)));
typedef short s16x4 __attribute__((ext_vector_type(4)));
typedef float f32x16 __attribute__((ext_vector_type(16)));
typedef unsigned u32x4 __attribute__((ext_vector_type(4)));
typedef unsigned u32x2 __attribute__((ext_vector_type(2)));
typedef float f32x4 __attribute__((ext_vector_type(4)));
#define ATT_LAS __attribute__((address_space(3)))
struct Args {
    const bf16_t* Q; int qp;
    const bf16_t* KA; int kap;
    const bf16_t* KB; int kbp;
    const bf16_t* V; int vp;
    bf16_t* O; int op;
    const float* RC; const float* RSN;
    const float* F2; float kmax;
};
__device__ __forceinline__ unsigned cvtpk(float lo, float hi) { unsigned r; asm volatile("v_cvt_pk_bf16_f32 %0, %1, %2" : "=v"(r) : "v"(lo), "v"(hi)); return r; }
__device__ __forceinline__ s16x4 vtr(const ATT_LAS unsigned char* p) { return __builtin_bit_cast(s16x4, __builtin_amdgcn_ds_read_tr16_b64_v4i16((ATT_LAS s16x4*)p)); }

template <int DKC, int DVB, bool CAUSAL, bool ROPE, int RG, bool PRUNE, bool BOUNDED = false>
__device__ __forceinline__ void attn_unit(const Args a, long qrow0, long krow0, int q0, int NT, ATT_LAS unsigned char* lds, const int wave_in_wg) {
    int tid_ = wg_tid(wave_in_wg); asm volatile("" : "+v"(tid_));
    const int tid = tid_, lane = tid & 63, r32 = lane & 31, hi = lane >> 5;
    const int wid = wave_in_wg;
    constexpr int KSLOT = DKC * 2048, VSLOT = DVB * 4096, NKC = PRUNE ? 8 : 2 * DKC, KL = (NKC + 7) / 8, VL = (DVB * 4 + 7) / 8;
    ATT_LAS unsigned char* Kb = lds; ATT_LAS unsigned char* Vb = lds + 2 * KSLOT;
    const int wrow = wid * 32 * RG;
    bf16x8 qr[RG][DKC];
#pragma unroll
    for (int g = 0; g < RG; ++g) {
        const bf16_t* qrow = a.Q + (size_t)(qrow0 + wrow + g * 32 + r32) * a.qp + hi * 8;
#pragma unroll
        for (int c = 0; c < (PRUNE ? 4 : DKC); ++c) qr[g][c] = *(const bf16x8*)(qrow + c * 16);
        if constexpr (PRUNE) {
            const float f2 = a.F2[q0 + wrow + g * 32 + r32];
            const unsigned h1 = cvtpk(f2, 0.f) & 0xffffu; const float r1 = f2 - __uint_as_float(h1 << 16);
            const unsigned h2 = cvtpk(r1, 0.f) & 0xffffu; const float r2 = r1 - __uint_as_float(h2 << 16); const unsigned h3 = cvtpk(r2, 0.f) & 0xffffu;
            u32x4 w = (u32x4){0x3f803f80u, 0x3f80u | (h1 << 16), h2 | (h3 << 16), 0u};
            if (hi) w = (u32x4){0u, 0u, 0u, 0u};
            qr[g][4] = __builtin_bit_cast(bf16x8, w);
        }
        if constexpr (ROPE) {
            const size_t trow = (size_t)(qrow0 + wrow + g * 32 + r32) * 16 + 8 * hi;
            const f32x4 c0 = *(const f32x4*)(a.RC + trow), c1 = *(const f32x4*)(a.RC + trow + 4), s0 = *(const f32x4*)(a.RSN + trow), s1 = *(const f32x4*)(a.RSN + trow + 4);
            bf16x8 x1 = qr[g][4], x2 = qr[g][5];
#pragma unroll
            for (int j = 0; j < 8; ++j) { const float cc = j < 4 ? c0[j & 3] : c1[j & 3], ss = j < 4 ? s0[j & 3] : s1[j & 3];
                const float a1 = __uint_as_float((unsigned)(unsigned short)x1[j] << 16), a2 = __uint_as_float((unsigned)(unsigned short)x2[j] << 16);
                const float r1 = a1 * cc - a2 * ss, r2 = a2 * cc + a1 * ss;
                x1[j] = (short)(cvtpk(r1, 0.f) & 0xffffu); x2[j] = (short)(cvtpk(r2, 0.f) & 0xffffu); }
            qr[g][4] = x1; qr[g][5] = x2;
        }
    }
#define ATT_DMA(t, buf) do { const size_t kr_ = (size_t)(krow0 + 64 * (t)); \
    _Pragma("unroll") for (int j = 0; j < KL; ++j) { const int c8 = wid + 8 * j; if (c8 < NKC) { \
        const bf16_t* src = (c8 < 8) ? (a.KA + (kr_ + lane) * a.kap + c8 * 8) : (a.KB + (kr_ + lane) * a.kbp + (c8 - 8) * 8); \
        __builtin_amdgcn_global_load_lds((const unsigned*)src, (ATT_LAS unsigned*)(Kb + (buf) * KSLOT + c8 * 1024), 16, 0, 0); } } \
    _Pragma("unroll") for (int j = 0; j < VL; ++j) { const int pc = wid + 8 * j; if (pc < DVB * 4) { \
        __builtin_amdgcn_global_load_lds((const unsigned*)(a.V + (kr_ + 16 * (pc & 3) + (lane >> 2)) * a.vp + 32 * (pc >> 2) + (lane & 3) * 8), (ATT_LAS unsigned*)(Vb + (buf) * VSLOT + pc * 1024), 16, 0, 0); } } } while (0)
    float ub[RG]; bool gdone[RG]; bool wdone = false;
    ATT_LAS unsigned* cnt = (ATT_LAS unsigned*)(lds + 2 * KSLOT + 2 * VSLOT);
    if constexpr (PRUNE) {
#pragma unroll
        for (int g = 0; g < RG; ++g) { float nq = 0.f;
#pragma unroll
            for (int c = 0; c < 4; ++c)
#pragma unroll
                for (int j = 0; j < 8; ++j) { const float v = __uint_as_float((unsigned)(unsigned short)qr[g][c][j] << 16); nq += v * v; }
            nq += shx(nq, 32, lane);
            ub[g] = sqrtf(nq) * a.kmax + 2.f + a.F2[q0 + wrow + g * 32 + r32]; gdone[g] = false; }
        if (tid == 0) cnt[0] = 0u;
    }
    float fst = 0.f;
#define ATT_KBIAS(buf) do { const unsigned h1 = cvtpk(fst, 0.f) & 0xffffu; const float r1 = fst - __uint_as_float(h1 << 16); \
        const unsigned h2 = cvtpk(r1, 0.f) & 0xffffu; const float r2 = r1 - __uint_as_float(h2 << 16); const unsigned h3 = cvtpk(r2, 0.f) & 0xffffu; \
        *(ATT_LAS u32x4*)(Kb + (buf) * KSLOT + 8 * 1024 + lane * 16) = (u32x4){(h1 ^ 0x8000u) | ((h2 ^ 0x8000u) << 16), (h3 ^ 0x8000u) | 0x3f800000u, 0x3f803f80u, 0u}; } while (0)
    if constexpr (PRUNE) {
        if (wid == 0) { fst = a.F2[64 * (NT - 1) + lane]; ATT_KBIAS(0); }
        if (wid == 1) { *(ATT_LAS u32x4*)(Kb + 9 * 1024 + lane * 16) = (u32x4){0u, 0u, 0u, 0u}; *(ATT_LAS u32x4*)(Kb + KSLOT + 9 * 1024 + lane * 16) = (u32x4){0u, 0u, 0u, 0u}; }
    }
    ATT_DMA(PRUNE ? NT - 1 : 0, 0);
    asm volatile("s_waitcnt vmcnt(0)" ::: "memory");
    __syncthreads();
    f32x16 o[RG][DVB];
    float mrun[RG], lrun[RG];
#pragma unroll
    for (int g = 0; g < RG; ++g) { mrun[g] = -1e30f; lrun[g] = 0.f;
#pragma unroll
        for (int d = 0; d < DVB; ++d)
#pragma unroll
            for (int r = 0; r < 16; ++r) o[g][d][r] = 0.f; }
    const int koff = hi * 1024 + r32 * 16;
    const int voff = ((lane >> 4) & 1) * 32 + (lane & 3) * 8 + (4 * hi + ((lane & 15) >> 2)) * 64;
    const int qw0 = q0 + wrow;
    for (int it = 0; it < NT; ++it) {
        const int t = PRUNE ? NT - 1 - it : it, buf = it & 1;
        if constexpr (PRUNE) { if (tid == 0) cnt[(it + 1) % 3] = 0u; }
        float f2e = 0.f; if constexpr (PRUNE) { if (t > 0) f2e = a.F2[64 * t - 1]; }
        if (it + 1 < NT) { ATT_DMA(PRUNE ? t - 1 : t + 1, buf ^ 1); if constexpr (PRUNE) { if (wid == 0) fst = a.F2[64 * (t - 1) + lane]; } }
        const bool active = (!CAUSAL || (64 * t <= qw0 + 32 * RG - 1)) && !(PRUNE && wdone);
        if (active) {
            f32x16 s0[RG], s1[RG];
#pragma unroll
            for (int g = 0; g < RG; ++g)
#pragma unroll
                for (int r = 0; r < 16; ++r) { s0[g][r] = 0.f; s1[g][r] = 0.f; }
            const ATT_LAS unsigned char* kp = Kb + buf * KSLOT + koff;
#pragma unroll
            for (int c = 0; c < DKC; ++c) {
                const bf16x8 k0 = *(const ATT_LAS bf16x8*)(kp + c * 2048), k1 = *(const ATT_LAS bf16x8*)(kp + c * 2048 + 512);
#pragma unroll
                for (int g = 0; g < RG; ++g) {
                    s0[g] = __builtin_amdgcn_mfma_f32_32x32x16_bf16(k0, qr[g][c], s0[g], 0, 0, 0);
                    s1[g] = __builtin_amdgcn_mfma_f32_32x32x16_bf16(k1, qr[g][c], s1[g], 0, 0, 0);
                }
            }
            u32x4 pw[RG][4];
#pragma unroll
            for (int g = 0; g < RG; ++g) {
                if (CAUSAL && (64 * t + 63 > qw0 + 32 * g)) {
                    const int kb = 64 * t + 4 * hi, qpos = qw0 + 32 * g + r32;
#pragma unroll
                    for (int r = 0; r < 16; ++r) { const int kv = kb + (r & 3) + 8 * (r >> 2); if (kv > qpos) s0[g][r] = -INFINITY; if (kv + 32 > qpos) s1[g][r] = -INFINITY; }
                }
                float sm[4] = {0.f, 0.f, 0.f, 0.f};
                if constexpr (BOUNDED) {
#pragma unroll
                    for (int r = 0; r < 16; ++r) { s0[g][r] = __builtin_amdgcn_exp2f(s0[g][r]); s1[g][r] = __builtin_amdgcn_exp2f(s1[g][r]); sm[r & 1] += s0[g][r]; sm[2 + (r & 1)] += s1[g][r]; }
                } else {
                float rm = __builtin_fmaxf(s0[g][0], s1[g][0]), rm2 = __builtin_fmaxf(s0[g][1], s1[g][1]);
#pragma unroll
                for (int r = 2; r < 16; r += 2) { rm = __builtin_fmaxf(__builtin_fmaxf(rm, s0[g][r]), s1[g][r]); rm2 = __builtin_fmaxf(__builtin_fmaxf(rm2, s0[g][r + 1]), s1[g][r + 1]); }
                rm = __builtin_fmaxf(rm, rm2);
                { const auto rr = __builtin_amdgcn_permlane32_swap(__float_as_uint(rm), __float_as_uint(rm), false, false); rm = __builtin_fmaxf(__uint_as_float(rr[0]), __uint_as_float(rr[1])); }
                const float mn = __builtin_fmaxf(mrun[g], rm);
                if (__builtin_amdgcn_ballot_w64(mn > mrun[g]) != 0ull) {
                    const float alpha = __builtin_amdgcn_exp2f(mrun[g] - mn);
                    lrun[g] *= alpha;
#pragma unroll
                    for (int d = 0; d < DVB; ++d)
#pragma unroll
                        for (int r = 0; r < 16; ++r) o[g][d][r] *= alpha;
                    mrun[g] = mn;
                }
#pragma unroll
                for (int r = 0; r < 16; ++r) { s0[g][r] = __builtin_amdgcn_exp2f(s0[g][r] - mn); s1[g][r] = __builtin_amdgcn_exp2f(s1[g][r] - mn); sm[r & 1] += s0[g][r]; sm[2 + (r & 1)] += s1[g][r]; }
                }
                lrun[g] += (sm[0] + sm[1]) + (sm[2] + sm[3]);
                if constexpr (PRUNE) { if (t > 0) {
                    if (__builtin_amdgcn_ballot_w64((ub[g] - f2e - mrun[g]) < -40.f) == ~0ull) gdone[g] = true; } }
#pragma unroll
                for (int i = 0; i < 4; ++i) { pw[g][0][i] = cvtpk(s0[g][2 * i], s0[g][2 * i + 1]); pw[g][1][i] = cvtpk(s0[g][8 + 2 * i], s0[g][9 + 2 * i]);
                    pw[g][2][i] = cvtpk(s1[g][2 * i], s1[g][2 * i + 1]); pw[g][3][i] = cvtpk(s1[g][8 + 2 * i], s1[g][9 + 2 * i]); }
            }
            const ATT_LAS unsigned char* vpp = Vb + buf * VSLOT + voff;
#pragma unroll
            for (int d = 0; d < DVB; ++d)
#pragma unroll
                for (int ks = 0; ks < 4; ++ks) {
                    const s16x4 lo = vtr(vpp + d * 4096 + ks * 1024), hh = vtr(vpp + d * 4096 + ks * 1024 + 512);
                    const bf16x8 vf = (bf16x8){lo[0], lo[1], lo[2], lo[3], hh[0], hh[1], hh[2], hh[3]};
#pragma unroll
                    for (int g = 0; g < RG; ++g) o[g][d] = __builtin_amdgcn_mfma_f32_32x32x16_bf16(vf, __builtin_bit_cast(bf16x8, pw[g][ks]), o[g][d], 0, 0, 0);
                }
        }
        if constexpr (PRUNE) { if (wid == 0 && it + 1 < NT) ATT_KBIAS(buf ^ 1);
            bool all = true;
#pragma unroll
            for (int g = 0; g < RG; ++g) all = all && gdone[g];
            wdone = wdone || all;
            if (wdone && lane == 0) __hip_atomic_fetch_add(cnt + (it % 3), 1u, __ATOMIC_RELAXED, __HIP_MEMORY_SCOPE_WORKGROUP); }
        asm volatile("s_waitcnt vmcnt(0) lgkmcnt(0)" ::: "memory");
        __syncthreads();
        if constexpr (PRUNE) { if (((volatile ATT_LAS unsigned*)cnt)[it % 3] == 8u) break; }
    }
    if constexpr (PRUNE) __syncthreads();
#pragma unroll
    for (int g = 0; g < RG; ++g) {
        const float lt = lrun[g] + shx(lrun[g], 32, lane);
        const float inv = 1.f / lt;
        bf16_t* orow = a.O + (size_t)(qrow0 + wrow + g * 32 + r32) * a.op + 4 * hi;
#pragma unroll
        for (int d = 0; d < DVB; ++d)
#pragma unroll
            for (int gg = 0; gg < 4; ++gg) { u32x2 w; w.x = cvtpk(o[g][d][4 * gg] * inv, o[g][d][4 * gg + 1] * inv); w.y = cvtpk(o[g][d][4 * gg + 2] * inv, o[g][d][4 * gg + 3] * inv);
                *(u32x2*)(orow + 32 * d + 8 * gg) = w; }
    }
#undef ATT_DMA
#undef ATT_KBIAS
}
}

using pg8::bf16_t; using pg8::f32x4; using pg8::u32x4;
#define LAS __attribute__((address_space(3)))
constexpr int NB = 4, S = 8192, T = NB * S, D = 1024, FF = 2816, NPROJ = 5888, NWAVES = 8;
constexpr float ALPHA = 1.189207115002721f;
constexpr size_t MiB = 1u << 20;
constexpr size_t WS_RS = 2 * MiB;
constexpr size_t WS_RC = 3 * MiB;
constexpr size_t WS_RSN = 5 * MiB;
constexpr size_t WS_SIDE = 7 * MiB;
constexpr size_t WS_MEMB = 12 * MiB;
constexpr size_t WS_MEMKV = 14 * MiB;
constexpr size_t WS_WIN = 16 * MiB;
constexpr size_t WS_WUQ = 28 * MiB;
constexpr size_t WS_WUKV = 29 * MiB;
constexpr size_t WS_WMKV = 30 * MiB;
constexpr size_t WS_KR = 32 * MiB;
constexpr size_t WS_XB = 34 * MiB;
constexpr size_t WS_QM = 34 * MiB;
constexpr size_t WS_WBR = 82 * MiB;
constexpr size_t WS_WOUT = 87 * MiB;
constexpr size_t WS_H = 98 * MiB;
constexpr size_t WS_G = 98 * MiB;
constexpr size_t WS_SLOT0 = 290 * MiB;
constexpr size_t WS_FQ = 338 * MiB;
constexpr size_t WS_MQ = 434 * MiB;
constexpr size_t WS_FK = 370 * MiB;
constexpr size_t WS_FV = 402 * MiB;
constexpr size_t WS_KN = 370 * MiB;
constexpr size_t WS_VM = 402 * MiB;
constexpr size_t WS_MG = 370 * MiB;
constexpr size_t WS_WA = 480 * MiB;
constexpr size_t WS_WD = 491 * MiB;
constexpr size_t WS_END = 512 * MiB;
constexpr size_t ATILE = (size_t)256 * 512 * 2;
static_assert(WS_MQ + (size_t)T * 512 * 2 <= WS_WA && WS_WD + (size_t)1024 * 2816 * 2 <= WS_END && (WS_FQ - WS_SLOT0) % ATILE == 0 && (WS_MQ - WS_SLOT0) % ATILE == 0 && WS_MG + (size_t)T * 1024 * 2 <= WS_MQ, "ws map");
constexpr int LDS_BYTES = 147456;

__device__ __forceinline__ unsigned f2bf(float f) { unsigned u = __builtin_bit_cast(unsigned, f); return (u + 0x7fffu + ((u >> 16) & 1u)) >> 16; }
__device__ __forceinline__ unsigned pk2(float lo, float hi) { return f2bf(lo) | (f2bf(hi) << 16); }
__device__ __forceinline__ float bf2f(unsigned b) { return __uint_as_float(b << 16); }
__device__ __forceinline__ float wave_sum(float v, int lane) {
#pragma unroll
    for (int o = 1; o < 64; o <<= 1) v += shx(v, o, lane);
    return v;
}
#define LDS_WAIT() asm volatile("s_waitcnt lgkmcnt(0)" ::: "memory")

__device__ __forceinline__ int map_ffn(int c) { return c < FF ? ((c >> 7) << 8) + (c & 127) : (((c - FF) >> 7) << 8) + 128 + ((c - FF) & 127); }
__device__ __forceinline__ int map_win(int c) {
    if (c < 384) return 5120 + c;
    if (c < 640) return 5504 + (c - 384);
    if (c < 672) return 5760 + (c - 640);
    if (c < 1184) return 3072 + (c - 672);
    if (c < 1696) return 3584 + (c - 1184);
    if (c < 2208) return 4096 + (c - 1696);
    if (c < 2216) return 5792 + (c - 2208);
    if (c < 2728) return 4608 + (c - 2216);
    return c - 2728;
}
template <int MODE>
__device__ __forceinline__ void tr_mat(const float* __restrict__ W, int K, int N, const float* __restrict__ ks, bf16_t* WT, int ldt, int kmul, LAS float* scr, int gw, int NGW, int lane) {
    const int nblk = (N + 31) / 32, items = (K / 64) * nblk;
    for (int it = gw; it < items; it += NGW) {
        const int kb = it / nblk, nb = it % nblk, k0 = 64 * kb, n0 = 32 * nb;
        const int r8 = lane >> 3, c4 = (lane & 7) * 4; const bool ok = n0 + c4 < N;
        f32x4 v[8];
#pragma unroll
        for (int i = 0; i < 8; ++i) v[i] = ok ? __builtin_nontemporal_load((const f32x4*)(W + (size_t)(k0 + 8 * i + r8) * N + n0 + c4)) : (f32x4){0.f, 0.f, 0.f, 0.f};
#pragma unroll
        for (int i = 0; i < 8; ++i) { const int kk = 8 * i + r8; if (ks) v[i] = v[i] * ks[k0 + kk];
            scr[kk * 33 + c4] = v[i][0]; scr[kk * 33 + c4 + 1] = v[i][1]; scr[kk * 33 + c4 + 2] = v[i][2]; scr[kk * 33 + c4 + 3] = v[i][3]; }
        LDS_WAIT(); asm volatile("" ::: "memory");
        const int c = lane & 7, dc = kb * kmul + 8 * c;
#pragma unroll
        for (int j = 0; j < 4; ++j) { const int n = (lane >> 3) + 8 * j, sc = n0 + n;
            if (sc < N) { const LAS float* s = scr + (8 * c) * 33 + n;
                u32x4 o; o.x = pk2(s[0 * 33], s[1 * 33]); o.y = pk2(s[2 * 33], s[3 * 33]); o.z = pk2(s[4 * 33], s[5 * 33]); o.w = pk2(s[6 * 33], s[7 * 33]);
                const int dr = MODE == 1 ? map_ffn(sc) : (MODE == 2 ? map_win(sc) : sc);
                *(u32x4*)(WT + (size_t)dr * ldt + dc) = o; } }
        LDS_WAIT(); asm volatile("" ::: "memory");
    }
}
__device__ __forceinline__ void cvt_copy(const float* __restrict__ src, bf16_t* dst, size_t n, size_t gt, size_t NTH) {
    size_t i = gt * 8;
    for (; i + 3 * NTH * 8 < n; i += 4 * NTH * 8) {
        f32x4 a[4], b[4];
#pragma unroll
        for (int u = 0; u < 4; ++u) { a[u] = __builtin_nontemporal_load((const f32x4*)(src + i + u * NTH * 8)); b[u] = __builtin_nontemporal_load((const f32x4*)(src + i + u * NTH * 8 + 4)); }
#pragma unroll
        for (int u = 0; u < 4; ++u) { u32x4 o; o.x = pk2(a[u][0], a[u][1]); o.y = pk2(a[u][2], a[u][3]); o.z = pk2(b[u][0], b[u][1]); o.w = pk2(b[u][2], b[u][3]); *(u32x4*)(dst + i + u * NTH * 8) = o; }
    }
    for (; i < n; i += NTH * 8) { const f32x4 a = *(const f32x4*)(src + i), b = *(const f32x4*)(src + i + 4);
        u32x4 o; o.x = pk2(a[0], a[1]); o.y = pk2(a[2], a[3]); o.z = pk2(b[0], b[1]); o.w = pk2(b[2], b[3]); *(u32x4*)(dst + i) = o; }
}
__device__ __forceinline__ void ln_row(const float* xrow, const float* __restrict__ g, const float* __restrict__ b, float* outf, bf16_t* outb, int lane) {
    f32x4 v[4]; float s = 0.f;
#pragma unroll
    for (int j = 0; j < 4; ++j) { v[j] = *(const f32x4*)(xrow + 4 * lane + 256 * j); s += (v[j][0] + v[j][1]) + (v[j][2] + v[j][3]); }
    const float mean = wave_sum(s, lane) * (1.f / D); float s2 = 0.f;
#pragma unroll
    for (int j = 0; j < 4; ++j) { v[j] = v[j] - mean; s2 += (v[j][0] * v[j][0] + v[j][1] * v[j][1]) + (v[j][2] * v[j][2] + v[j][3] * v[j][3]); }
    const float rstd = 1.f / sqrtf(wave_sum(s2, lane) * (1.f / D) + 1e-5f);
#pragma unroll
    for (int j = 0; j < 4; ++j) { const f32x4 gg = *(const f32x4*)(g + 4 * lane + 256 * j), bb = *(const f32x4*)(b + 4 * lane + 256 * j);
        const f32x4 y = v[j] * rstd * gg + bb;
        if (outf) *(f32x4*)(outf + 4 * lane + 256 * j) = y;
        if (outb) { unsigned long long w = (unsigned long long)pk2(y[0], y[1]) | ((unsigned long long)pk2(y[2], y[3]) << 32); *(unsigned long long*)(outb + 4 * lane + 256 * j) = w; } }
}

#define XB_TMO      128
#define XB_XCNT(j)  (256  + 64 * (j))
#define XB_XSUB(j)  (1280 + 64 * (j))
#define XB_XGEN(j)  (2304 + 64 * (j))
#define XB_TOP      3328
#define XB_TOPGEN   3392
#define XCD_BAR_WORDS 3456
#define XB_SPIN_CAP (1u << 18)

__device__ __forceinline__ unsigned xb_ld(unsigned* p)              { return __hip_atomic_load(p, __ATOMIC_RELAXED, __HIP_MEMORY_SCOPE_AGENT); }
__device__ __forceinline__ unsigned xb_add(unsigned* p, unsigned v) { return __hip_atomic_fetch_add(p, v, __ATOMIC_RELAXED, __HIP_MEMORY_SCOPE_AGENT); }
__device__ __forceinline__ unsigned xb_xcc_id() { return (unsigned)__builtin_amdgcn_s_getreg((3 << 11) | 20) & 0xFu; }
#define XB_SPIN(cond, bar) do { unsigned _sp = 0; while (cond) { __builtin_amdgcn_s_sleep(1); \
    if ((++_sp & 255u) == 0u) { if (xb_ld(&(bar)[XB_TMO])) break; if (_sp > XB_SPIN_CAP) { atomicAdd(&(bar)[XB_TMO], 1u); break; } } } } while (0)

struct XcdBarrier {
    unsigned* bar; unsigned x;
    volatile LAS unsigned* st;
};

__device__ __forceinline__ XcdBarrier xcd_barrier_post(unsigned* bar, volatile LAS unsigned* st, int wave_in_wg) {
    XcdBarrier b; b.bar = bar; b.x = xb_xcc_id(); b.st = st;
    if (wg_tid(wave_in_wg) == 0) (void)xb_add(&bar[XB_XCNT(b.x)], 1u);
    return b;
}
__device__ __forceinline__ void xcd_barrier_complete(unsigned* bar, unsigned x, unsigned& nloc, unsigned& nx) {
    const unsigned G = gridDim.x * gridDim.y * gridDim.z;
    unsigned sum, cnt, mine, sp = 0u;
    for (;;) {
        sum = 0u; cnt = 0u; mine = 0u;
#pragma unroll
        for (unsigned j = 0; j < 16; ++j) { const unsigned c = xb_ld(&bar[XB_XCNT(j)]); sum += c; cnt += (c > 0u) ? 1u : 0u; mine = (j == x) ? c : mine; }
        if (sum == G) break;
        __builtin_amdgcn_s_sleep(1);
        if ((++sp & 255u) == 0u) { if (xb_ld(&bar[XB_TMO])) break; if (sp > XB_SPIN_CAP) { atomicAdd(&bar[XB_TMO], 1u); break; } }
    }
    nloc = mine > 0u ? mine : 1u; nx = cnt > 0u ? cnt : 1u;
}

__device__ __forceinline__ void xcd_barrier_w(const XcdBarrier& b, int wave_in_wg) {
    asm volatile("s_waitcnt vmcnt(0)" ::: "memory");
    __syncthreads();
    if (wg_tid(wave_in_wg) == 0) {
        unsigned* bar = b.bar;
        __builtin_amdgcn_s_waitcnt(0);
        unsigned nloc = b.st[0], nx = b.st[1];
        if (nloc == 0u) { xcd_barrier_complete(bar, b.x, nloc, nx); b.st[0] = nloc; b.st[1] = nx; }
        const unsigned old = xb_add(&bar[XB_XSUB(b.x)], 1u);
        const unsigned gen = old / nloc;
        if (old + 1u == (gen + 1u) * nloc) {
            __builtin_amdgcn_fence(__ATOMIC_RELEASE, "agent");
            asm volatile("s_waitcnt vmcnt(0)" ::: "memory");
            const unsigned og = xb_add(&bar[XB_TOP], 1u);
            const unsigned tg = og / nx;
            if (og + 1u == (tg + 1u) * nx) xb_add(&bar[XB_TOPGEN], 1u);
            else XB_SPIN(xb_ld(&bar[XB_TOPGEN]) == tg, bar);
            __builtin_amdgcn_fence(__ATOMIC_ACQUIRE, "agent");
            xb_add(&bar[XB_XGEN(b.x)], 1u);
            asm volatile("s_waitcnt vmcnt(0)" ::: "memory");
        } else {
            XB_SPIN(xb_ld(&bar[XB_XGEN(b.x)]) == gen, bar);
            __builtin_amdgcn_fence(__ATOMIC_ACQUIRE, "agent");
            asm volatile("s_waitcnt vmcnt(0)" ::: "memory");
        }
    }
    __syncthreads();
}

__device__ __forceinline__ void ln_rows2(float* R, int m0, int m1, const float* __restrict__ g, const float* __restrict__ b, bf16_t* XBo, bool wf, int lane) {
    f32x4 v[2][4]; float s[2] = {0.f, 0.f};
#pragma unroll
    for (int r = 0; r < 2; ++r) { const float* xrow = R + (size_t)(r ? m1 : m0) * D;
#pragma unroll
        for (int j = 0; j < 4; ++j) { v[r][j] = *(const f32x4*)(xrow + 4 * lane + 256 * j); s[r] += (v[r][j][0] + v[r][j][1]) + (v[r][j][2] + v[r][j][3]); } }
    float mean[2], rstd[2];
#pragma unroll
    for (int r = 0; r < 2; ++r) { mean[r] = wave_sum(s[r], lane) * (1.f / D); float s2 = 0.f;
#pragma unroll
        for (int j = 0; j < 4; ++j) { v[r][j] = v[r][j] - mean[r]; s2 += (v[r][j][0] * v[r][j][0] + v[r][j][1] * v[r][j][1]) + (v[r][j][2] * v[r][j][2] + v[r][j][3] * v[r][j][3]); }
        rstd[r] = 1.f / sqrtf(wave_sum(s2, lane) * (1.f / D) + 1e-5f); }
#pragma unroll
    for (int j = 0; j < 4; ++j) { const f32x4 gg = *(const f32x4*)(g + 4 * lane + 256 * j), bb = *(const f32x4*)(b + 4 * lane + 256 * j);
#pragma unroll
        for (int r = 0; r < 2; ++r) { const size_t off = (size_t)(r ? m1 : m0) * D + 4 * lane + 256 * j; const f32x4 y = v[r][j] * rstd[r] * gg + bb;
            if (wf) *(f32x4*)(R + off) = y;
            if (XBo) { unsigned long long w = (unsigned long long)pk2(y[0], y[1]) | ((unsigned long long)pk2(y[2], y[3]) << 32); *(unsigned long long*)(XBo + off) = w; } } }
}

#ifndef PH_MASK
#define PH_MASK 0xFFFF
#endif
struct Params { const float* in[25]; float* out; unsigned char* ws; };

#define xcd_barrier(b) xcd_barrier_w(b, wave)
__global__ void __launch_bounds__(NWAVES * 64) mega_fwd(Params p) {
    extern __shared__ __attribute__((aligned(16))) unsigned char lds_raw[];
    cg::grid_group grid = cg::this_grid();
    LAS unsigned char* lds = (LAS unsigned char*)lds_raw;
    const int wave = __builtin_amdgcn_readfirstlane((int)threadIdx.x >> 6);
#define PHASE_IDS() const float* const* pin = (const float* const*)__builtin_amdgcn_kernarg_segment_ptr(); asm volatile("" : "+s"(pin)); unsigned char* wsp = ws; asm volatile("" : "+s"(wsp)); int tid_o = wg_tid(wave); asm volatile("" : "+v"(tid_o)); const int tid = tid_o, lane = tid & 63; const size_t gt = (size_t)bx * (NWAVES * 64) + tid; (void)lane; (void)gt
    const int G = gridDim.x, bx = blockIdx.x;
    const int gw = bx * NWAVES + wave, NGW = G * NWAVES;
    const size_t NTH = (size_t)G * (NWAVES * 64);
    unsigned char* ws = p.ws;
#define KMAX ((float*)(wsp + WS_RS))
#define RC ((float*)(wsp + WS_RC))
#define RSN ((float*)(wsp + WS_RSN))
#define SIDE ((float*)(wsp + WS_SIDE))
#define F2T ((float*)(wsp + 1 * MiB))
#define KRN ((float*)(wsp + WS_RS + MiB / 2))
#define NK2 ((float*)(wsp + WS_SIDE))
#define MEMB ((bf16_t*)(wsp + WS_MEMB))
#define MEMKV ((bf16_t*)(wsp + WS_MEMKV))
#define WIN ((bf16_t*)(wsp + WS_WIN))
#define WUQ ((bf16_t*)(wsp + WS_WUQ))
#define WUKV ((bf16_t*)(wsp + WS_WUKV))
#define WMKV ((bf16_t*)(wsp + WS_WMKV))
#define KR ((bf16_t*)(wsp + WS_KR))
#define XB ((bf16_t*)(wsp + WS_XB))
#define QM ((bf16_t*)(wsp + WS_QM))
#define WBR ((bf16_t*)(wsp + WS_WBR))
#define WOUT ((bf16_t*)(wsp + WS_WOUT))
#define HB ((bf16_t*)(wsp + WS_H))
#define GB ((bf16_t*)(wsp + WS_G))
#define SLOT0 ((bf16_t*)(wsp + WS_SLOT0))
#define CQ ((bf16_t*)(wsp + WS_SLOT0))
#define CKV ((bf16_t*)(wsp + WS_SLOT0) + (size_t)T * 384)
#define FQ ((bf16_t*)(wsp + WS_FQ))
#define MQ ((bf16_t*)(wsp + WS_MQ))
#define FK ((bf16_t*)(wsp + WS_FK))
#define FV ((bf16_t*)(wsp + WS_FV))
#define KN ((bf16_t*)(wsp + WS_KN))
#define VM ((bf16_t*)(wsp + WS_VM))
#define MG ((bf16_t*)(wsp + WS_MG))
#define WA ((bf16_t*)(wsp + WS_WA))
#define WD ((bf16_t*)(wsp + WS_WD))
    float* R = p.out;
    LAS float* scr = (LAS float*)(lds + wave * 16384);
    volatile LAS unsigned* MISC = (volatile LAS unsigned*)(lds + 131072 + 256);
    unsigned* barw = (unsigned*)ws;
    { PHASE_IDS();
      if (tid < 2) MISC[tid] = 0u;
      if (bx == 0) for (int i = tid; i < XCD_BAR_WORDS; i += NWAVES * 64) barw[i] = 0u; }

#if (PH_MASK >> 0) & 1
    { PHASE_IDS();
    tr_mat<1>(pin[5], D, 2 * FF, nullptr, WA, D, 64, scr, gw, NGW, lane);
    tr_mat<0>(pin[6], FF, D, nullptr, WD, FF, 64, scr, gw, NGW, lane);
    tr_mat<2>(pin[7], D, 5800, nullptr, WIN, D, 64, scr, gw, NGW, lane);
    tr_mat<0>(pin[10], 384, 768, pin[9], WUQ, 384, 64, scr, gw, NGW, lane);
    tr_mat<0>(pin[12], 256, 1024, pin[11], WUKV, 256, 64, scr, gw, NGW, lane);
    tr_mat<0>(pin[14], D, 1024, nullptr, WMKV, D, 64, scr, gw, NGW, lane);
    for (size_t i = gt * 8; i < (size_t)88 * D; i += NTH * 8) *(u32x4*)(WIN + (size_t)5800 * D + i) = (u32x4){0u, 0u, 0u, 0u};
    if (gt < 32) KMAX[gt] = 0.f;
    cvt_copy(pin[0], XB, (size_t)T * D, gt, NTH);
    cvt_copy(pin[1], MEMB, (size_t)NB * 256 * D, gt, NTH);
    for (size_t i = gt; i < (size_t)T * 16; i += NTH) {
        const int row = (int)(i >> 4), f = (int)(i & 15);
        const float invf = (float)exp2(-(double)f * (13.287712379549449 / 16.0));
        const float ang = (float)((const int*)pin[2])[row] * invf;
        const double rev = (double)ang * 0.15915494309189535; const float fr = (float)(rev - __builtin_rint(rev));
        RC[i] = __builtin_amdgcn_cosf(fr); RSN[i] = __builtin_amdgcn_sinf(fr);
    }
    }
#endif
    grid.sync();
    const XcdBarrier xb = xcd_barrier_post(barw, MISC, wave);

#if (PH_MASK >> 1) & 1
    { PHASE_IDS();
    { pg8::Gemm g{XB, WA, T, 2 * FF, D}; pg8::StaticOrder so; so.init(T, 2 * FF, G, bx);
      pg8::EpiSwiglu E{HB, FF}; pg8::gemm_phase<pg8::EpiSwiglu, pg8::StaticOrder, true>(lds, g, so, E, wave); }
    }
#endif
    xcd_barrier(xb);
#if (PH_MASK >> 2) & 1
    { PHASE_IDS();
    { pg8::Gemm g{HB, WD, T, D, FF}; pg8::StaticOrder so; so.init(T, D, G, bx);
      pg8::EpiRes E{pin[0], R, ALPHA, 0.5f}; pg8::gemm_phase<pg8::EpiRes, pg8::StaticOrder, true>(lds, g, so, E, wave); }
    }
#endif
    xcd_barrier(xb);
#if (PH_MASK >> 3) & 1
    { PHASE_IDS();
    for (int m = gw; m < T; m += 2 * NGW) { if (m + NGW < T) ln_rows2(R, m, m + NGW, pin[3], pin[4], XB, true, lane); else ln_row(R + (size_t)m * D, pin[3], pin[4], R + (size_t)m * D, XB + (size_t)m * D, lane); }
    }
#endif
    xcd_barrier(xb);
#if (PH_MASK >> 4) & 1
    { PHASE_IDS();
    { pg8::Gemm g{XB, WIN, T, NPROJ, D}; pg8::StaticOrder so; so.init(T, NPROJ, G, bx);
      pg8::EpiProj E{GB, FQ, FK, FV, MQ, CQ, CKV, SIDE, pin[8]}; pg8::gemm_phase<pg8::EpiProj, pg8::StaticOrder, true>(lds, g, so, E, wave); }
    { pg8::Gemm g{MEMB, WMKV, NB * 256, 1024, D}; pg8::StaticOrder so; so.init(NB * 256, 1024, G, (bx + 128) % G);
      pg8::EpiPlain E{MEMKV, 1024, 1.f}; pg8::gemm_phase<pg8::EpiPlain, pg8::StaticOrder, true>(lds, g, so, E, wave); }
    }
#endif
    xcd_barrier(xb);
#if (PH_MASK >> 5) & 1
    { PHASE_IDS();
    if (bx < 32) {
        const int b = bx >> 3, h = bx & 7; LAS double* sh = (LAS double*)lds;
        const float bfh = pin[13][h]; float lf[16]; double loc = 0.0;
#pragma unroll
        for (int j = 0; j < 16; ++j) { const float xx = SIDE[((size_t)b * S + 16 * tid + j) * 40 + 32 + h] + bfh; lf[j] = fminf(xx, 0.f) - log1pf(__expf(-fabsf(xx))); loc += (double)lf[j]; }
        double incl = loc;
#pragma unroll
        for (int o = 1; o < 64; o <<= 1) { const double v = shup_d(incl, o, lane); if (lane >= o) incl += v; }
        if (lane == 63) sh[wave] = incl;
        __syncthreads();
        double run = incl - loc;
        for (int w = 0; w < wave; ++w) run += sh[w];
#pragma unroll
        for (int j = 0; j < 16; ++j) { run += (double)lf[j];
            const float f2 = (float)(run * 1.4426950408889634);
            F2T[(size_t)bx * S + 16 * tid + j] = f2; }
        __syncthreads();
    }
    float kmrun = 0.f; int curb = gw >> 13;
    for (int m0 = gw; m0 < T; m0 += 2 * NGW) {
        u32x4 kraw[2], qraw[2], vraw[2]; float x1[2], x2[2], cc[2], ss[2]; bool has[2];
#pragma unroll
        for (int r = 0; r < 2; ++r) { const int m = m0 + r * NGW; has[r] = m < T; const size_t mm = has[r] ? (size_t)m : (size_t)m0;
            kraw[r] = *(const u32x4*)(FK + mm * 512 + lane * 8);
            qraw[r] = (lane < 48) ? *(const u32x4*)(CQ + mm * 384 + lane * 8) : (u32x4){0u, 0u, 0u, 0u};
            vraw[r] = (lane < 32) ? *(const u32x4*)(CKV + mm * 256 + lane * 8) : (u32x4){0u, 0u, 0u, 0u};
            x1[r] = 0.f; x2[r] = 0.f; cc[r] = 0.f; ss[r] = 0.f;
            if (lane < 16) { x1[r] = SIDE[mm * 40 + lane]; x2[r] = SIDE[mm * 40 + 16 + lane]; cc[r] = RC[mm * 16 + lane]; ss[r] = RSN[mm * 16 + lane]; } }
#pragma unroll
        for (int r = 0; r < 2; ++r) { if (!has[r]) continue;
            const int m = m0 + r * NGW; const int bb = m >> 13;
            if (bb != curb) { if ((lane & 7) == 0) atomicMax((unsigned*)KMAX + curb * 8 + (lane >> 3), __float_as_uint(kmrun)); kmrun = 0.f; curb = bb; }
            f32x4 k0, k1; pg8::unpack8(kraw[r], k0, k1); float ks = 0.f;
#pragma unroll
            for (int i = 0; i < 4; ++i) ks += k0[i] * k0[i] + k1[i] * k1[i];
            ks += shx(ks, 1, lane); ks += shx(ks, 2, lane); ks += shx(ks, 4, lane);
            kmrun = fmaxf(kmrun, ks);
            f32x4 a0, a1, c0, c1; float sq = 0.f, sq2 = 0.f;
            pg8::unpack8(qraw[r], a0, a1); pg8::unpack8(vraw[r], c0, c1);
#pragma unroll
            for (int i = 0; i < 4; ++i) { sq += a0[i] * a0[i] + a1[i] * a1[i]; sq2 += c0[i] * c0[i] + c1[i] * c1[i]; }
            const float rq = 1.f / sqrtf(wave_sum(sq, lane) * (1.f / 384.f) + 1e-6f), rkv = 1.f / sqrtf(wave_sum(sq2, lane) * (1.f / 256.f) + 1e-6f);
            if (lane < 48) *(u32x4*)(CQ + (size_t)m * 384 + lane * 8) = pg8::pack8(a0 * rq, a1 * rq);
            if (lane < 32) *(u32x4*)(CKV + (size_t)m * 256 + lane * 8) = pg8::pack8(c0 * rkv, c1 * rkv);
            { const float y1 = x1[r] * cc[r] - x2[r] * ss[r], y2 = x2[r] * cc[r] + x1[r] * ss[r];
              if (lane < 16) { KR[(size_t)m * 32 + lane] = (bf16_t)f2bf(y1); KR[(size_t)m * 32 + 16 + lane] = (bf16_t)f2bf(y2); }
              float kq = y1 * y1 + y2 * y2; kq += shx(kq, 1, lane); kq += shx(kq, 2, lane); kq += shx(kq, 4, lane); kq += shx(kq, 8, lane);
              if (lane == 0) KRN[m] = kq; } }
    }
    if ((lane & 7) == 0) atomicMax((unsigned*)KMAX + curb * 8 + (lane >> 3), __float_as_uint(kmrun));
    tr_mat<0>(pin[15], 512, D, nullptr, WBR, 512, 64, scr, gw, NGW, lane);
    tr_mat<0>(pin[16], 512, D, nullptr, WBR + (size_t)1024 * 512, 512, 64, scr, gw, NGW, lane);
    tr_mat<0>(pin[17], 512, D, nullptr, WBR + (size_t)2048 * 512, 512, 64, scr, gw, NGW, lane);
    tr_mat<0>(pin[18], D, D, nullptr, WOUT, D, 64, scr, gw, NGW, lane);
    __syncthreads();
    for (int u = bx; u < NB * 4 * 32; u += G) {
        const int b = u >> 7, hm = (u >> 5) & 3, qb = u & 31;
        att::Args a{MQ + hm * 128, 512, MEMKV + hm * 128, 1024, MEMKV + hm * 128 + 64, 1024, MEMKV + 512 + hm * 128, 1024, MQ + hm * 128, 512, nullptr, nullptr, nullptr, 0.f};
        att::attn_unit<8, 4, false, false, 1, false>(a, (long)b * S + qb * 256, (long)b * 256, 0, 4, lds, wave);
    }
    }
#endif
    xcd_barrier(xb);
#if (PH_MASK >> 6) & 1
    { PHASE_IDS();
    for (size_t i = gt; i < (size_t)T * 8; i += NTH) NK2[i] = 0.f;
    for (int u = bx; u < 512; u += G) {
        const int v = u & 255, i = u >> 8, vcu = (v & 7) * 32 + (v >> 3), bh = vcu >> 3, s = vcu & 7;
        const int qb = (i == 0) ? s : 15 - s; const int b = bh >> 3, h = bh & 7;
        att::Args a{FQ + h * 64, 512, FK + h * 64, 512, nullptr, 0, FV + h * 64, 512, FQ + h * 64, 512, nullptr, nullptr, F2T + (size_t)bh * S, sqrtf(KMAX[bh]) * 1.001f};
        att::attn_unit<5, 2, true, false, 2, true>(a, (long)b * S + qb * 512, (long)b * S, qb * 512, 8 * (qb + 1), lds, wave);
    }
    }
#endif
    xcd_barrier(xb);
#if (PH_MASK >> 7) & 1
    { PHASE_IDS();
    { pg8::Gemm g{CQ, WUQ, T, 768, 384}; pg8::StaticOrder so; so.init(T, 768, G, bx);
      pg8::EpiPlain E{QM, 768, 0.10206207261596577f * pg8::LOG2E}; pg8::gemm_phase<pg8::EpiPlain, pg8::StaticOrder, true>(lds, g, so, E, wave); }
    { pg8::Gemm g{CKV, WUKV, T, 1024, 256}; pg8::StaticOrder so; so.init(T, 1024, G, bx);
      pg8::EpiKvup E{KN, VM, NK2}; pg8::gemm_phase<pg8::EpiKvup, pg8::StaticOrder, true>(lds, g, so, E, wave); }
    }
#endif
    xcd_barrier(xb);
#if (PH_MASK >> 8) & 1
    { PHASE_IDS();
    bool bounded;
    { const int v = bx & 255, vcu = (v & 7) * 32 + (v >> 3), bh = vcu >> 3, s = vcu & 7, b = bh >> 3, h = bh & 7;
      float km = 0.f, qm = 0.f;
      for (int s2 = tid; s2 < S; s2 += NWAVES * 64) km = fmaxf(km, NK2[((size_t)b * S + s2) * 8 + h] + KRN[(size_t)b * S + s2]);
      for (int r2 = tid; r2 < 1024; r2 += NWAVES * 64) { const int qb = (r2 < 512) ? s : 15 - s; float q2 = 0.f;
          const bf16_t* qrow = QM + ((size_t)b * S + qb * 512 + (r2 & 511)) * 768 + h * 96;
#pragma unroll
          for (int c = 0; c < 12; ++c) { f32x4 q0, q1; pg8::unpack8(*(const u32x4*)(qrow + 8 * c), q0, q1);
#pragma unroll
              for (int i2 = 0; i2 < 4; ++i2) q2 += q0[i2] * q0[i2] + q1[i2] * q1[i2]; }
          qm = fmaxf(qm, q2); }
#pragma unroll
      for (int o2 = 1; o2 < 64; o2 <<= 1) { km = fmaxf(km, shx(km, o2, lane)); qm = fmaxf(qm, shx(qm, o2, lane)); }
      LAS float* shk = (LAS float*)(lds + 131072 + 1024);
      if (lane == 0) { shk[wave] = km; shk[8 + wave] = qm; }
      __syncthreads();
      km = shk[0]; qm = shk[8];
#pragma unroll
      for (int w = 1; w < 8; ++w) { km = fmaxf(km, shk[w]); qm = fmaxf(qm, shk[8 + w]); }
      __syncthreads();
      bounded = (G == 256) && (sqrtf(km) * sqrtf(qm) * 1.05f < 64.f); }
    if (bounded) {
        for (int u = bx; u < 512; u += G) {
            const int v = u & 255, i = u >> 8, vcu = (v & 7) * 32 + (v >> 3), bh = vcu >> 3, s = vcu & 7;
            const int qb = (i == 0) ? s : 15 - s; const int b = bh >> 3, h = bh & 7;
            att::Args a{QM + h * 96, 768, KN + h * 64, 512, KR, 32, VM + h * 64, 512, SLOT0 + h * 64, 512, RC, RSN, nullptr, 0.f};
            att::attn_unit<6, 2, true, true, 2, false, true>(a, (long)b * S + qb * 512, (long)b * S, qb * 512, 8 * (qb + 1), lds, wave);
        }
    } else {
        for (int u = bx; u < 512; u += G) {
            const int v = u & 255, i = u >> 8, vcu = (v & 7) * 32 + (v >> 3), bh = vcu >> 3, s = vcu & 7;
            const int qb = (i == 0) ? s : 15 - s; const int b = bh >> 3, h = bh & 7;
            att::Args a{QM + h * 96, 768, KN + h * 64, 512, KR, 32, VM + h * 64, 512, SLOT0 + h * 64, 512, RC, RSN, nullptr, 0.f};
            att::attn_unit<6, 2, true, true, 2, false, false>(a, (long)b * S + qb * 512, (long)b * S, qb * 512, 8 * (qb + 1), lds, wave);
        }
    }
    }
#endif
    xcd_barrier(xb);
#if (PH_MASK >> 9) & 1
    { PHASE_IDS();
    { pg8::Gemm g{SLOT0, WBR, T, D, 512}; pg8::SegOrder so; so.init(T, D, G, bx, (int)((WS_FQ - WS_SLOT0) / ATILE), (int)((WS_MQ - WS_SLOT0) / ATILE));
      pg8::EpiBranch E{GB, MG}; pg8::gemm_phase<pg8::EpiBranch, pg8::SegOrder, true>(lds, g, so, E, wave); }
    }
#endif
    xcd_barrier(xb);
#if (PH_MASK >> 10) & 1
    { PHASE_IDS();
    { pg8::Gemm g{MG, WOUT, T, D, D}; pg8::StaticOrder so; so.init(T, D, G, bx);
      pg8::EpiRes E{R, R, ALPHA, 1.f}; pg8::gemm_phase<pg8::EpiRes, pg8::StaticOrder, true>(lds, g, so, E, wave); }
    }
#endif
    xcd_barrier(xb);
#if (PH_MASK >> 11) & 1
    { PHASE_IDS();
    for (int m = gw; m < T; m += 2 * NGW) { if (m + NGW < T) ln_rows2(R, m, m + NGW, pin[19], pin[20], XB, true, lane); else ln_row(R + (size_t)m * D, pin[19], pin[20], R + (size_t)m * D, XB + (size_t)m * D, lane); }
    tr_mat<1>(pin[21], D, 2 * FF, nullptr, WA, D, 64, scr, gw, NGW, lane);
    tr_mat<0>(pin[22], FF, D, nullptr, WD, FF, 64, scr, gw, NGW, lane);
    }
#endif
    xcd_barrier(xb);
#if (PH_MASK >> 12) & 1
    { PHASE_IDS();
    { pg8::Gemm g{XB, WA, T, 2 * FF, D}; pg8::StaticOrder so; so.init(T, 2 * FF, G, bx);
      pg8::EpiSwiglu E{HB, FF}; pg8::gemm_phase<pg8::EpiSwiglu, pg8::StaticOrder, true>(lds, g, so, E, wave); }
    }
#endif
    xcd_barrier(xb);
#if (PH_MASK >> 13) & 1
    { PHASE_IDS();
    { pg8::Gemm g{HB, WD, T, D, FF}; pg8::StaticOrder so; so.init(T, D, G, bx);
      pg8::EpiRes E{R, R, ALPHA, 0.5f}; pg8::gemm_phase<pg8::EpiRes, pg8::StaticOrder, true>(lds, g, so, E, wave); }
    }
#endif
    xcd_barrier(xb);
#if (PH_MASK >> 14) & 1
    { PHASE_IDS();
    for (int m = gw; m < T; m += 2 * NGW) { if (m + NGW < T) ln_rows2(R, m, m + NGW, pin[23], pin[24], nullptr, true, lane); else ln_row(R + (size_t)m * D, pin[23], pin[24], R + (size_t)m * D, nullptr, lane); }
    }
#endif
}

#undef KMAX
#undef RC
#undef RSN
#undef SIDE
#undef F2T
#undef KRN
#undef NK2
#undef MEMB
#undef MEMKV
#undef WIN
#undef WUQ
#undef WUKV
#undef WMKV
#undef KR
#undef XB
#undef QM
#undef WBR
#undef WOUT
#undef HB
#undef GB
#undef SLOT0
#undef CQ
#undef CKV
#undef FQ
#undef MQ
#undef FK
#undef FV
#undef KN
#undef VM
#undef MG
#undef WA
#undef WD
extern "C" void kernel_launch(void* const* d_in, const int* in_sizes, int n_in, void* d_out, int out_size, void* d_ws, size_t ws_size, hipStream_t stream) {
    static int grid = 0;
    if (grid == 0) {
        if (n_in != 25 || out_size != T * D || ws_size < WS_END) { fprintf(stderr, "kernel_launch: unexpected shapes (n_in %d out %d ws %zu)\n", n_in, out_size, ws_size); grid = -1; return; }
        int dev = 0, cus = 0, per = 0;
        (void)hipGetDevice(&dev); (void)hipDeviceGetAttribute(&cus, hipDeviceAttributeMultiprocessorCount, dev);
        (void)hipFuncSetAttribute((const void*)mega_fwd, hipFuncAttributeMaxDynamicSharedMemorySize, LDS_BYTES);
        (void)hipOccupancyMaxActiveBlocksPerMultiprocessor(&per, (const void*)mega_fwd, NWAVES * 64, LDS_BYTES);
        if (per < 1) per = 1;
        grid = cus * per;
        fprintf(stderr, "kernel_launch: grid %d (cus %d x %d), ws %zu\n", grid, cus, per, ws_size);
    }
    if (grid < 0) return;
    Params p{};
    for (int i = 0; i < 25; ++i) p.in[i] = (const float*)d_in[i];
    p.out = (float*)d_out; p.ws = (unsigned char*)d_ws;
    void* args[] = {&p};
    const hipError_t e = hipLaunchCooperativeKernel((const void*)mega_fwd, dim3(grid), dim3(NWAVES * 64), args, LDS_BYTES, stream);
    if (e != hipSuccess) fprintf(stderr, "kernel_launch: cooperative launch failed: %s (grid %d)\n", hipGetErrorString(e), grid);
}
```
